# Optimizing an MI355X kernel written in HIP

```python
import jax
import jax.numpy as jnp
from jax import lax
import numpy as np


D_MODEL = 2048
BATCH = 2
SEQ = 8192
DEPTH = 4

D_FF = 5504
NORM_EPS = 1e-6
ROPE_THETA = 10000.0
N_AB = (DEPTH + 1) // 2
N_C = DEPTH // 2
NEG = -1e30

ML_HEADS = 4
ML_HEAD_DIM = D_MODEL // 2 // ML_HEADS
ML_WIDTH = ML_HEADS * ML_HEAD_DIM
ML_CONV = 4
ML_CHUNK = 128

HG_HEADS = 8
HG_KEY_DIM = 128
HG_VAL_DIM = D_MODEL // 2 // HG_HEADS
HG_KEY_WIDTH = HG_HEADS * HG_KEY_DIM
HG_WIDTH = HG_HEADS * HG_VAL_DIM
HG_CHUNK = 64
HG_MAX_K = 0.999999

AB_SIZES = [ML_WIDTH, ML_WIDTH, ML_WIDTH, ML_HEADS, ML_HEADS, HG_KEY_WIDTH, HG_KEY_WIDTH, HG_WIDTH, HG_WIDTH]
AB_COLS = sum(AB_SIZES)

NSA_HEADS = 16
NSA_KV_GROUPS = 4
NSA_HEAD_DIM = D_MODEL // NSA_HEADS
NSA_KV_WIDTH = NSA_KV_GROUPS * NSA_HEAD_DIM
CMP_BLOCK = 32
CMP_STRIDE = 16
CMP_HIDDEN = 256
SEL_BLOCK = 64
SEL_TOPK = 16
WINDOW = 512
NSA_QBLOCK = 32
FORCE_BONUS = 1e4
C_SIZES = [NSA_HEADS * NSA_HEAD_DIM] + [NSA_KV_WIDTH] * 6 + [3 * NSA_HEADS]
C_COLS = sum(C_SIZES)

kernel_name = 'hybrid_mlstm_hgrn2_nsa_macaron'


def _split(a, sizes):
    offs = np.cumsum(sizes)[:-1].tolist()
    return jnp.split(a, offs, axis=-1)


def rmsnorm(x, w):
    xf = x.astype(jnp.float32)
    y = xf * lax.rsqrt(jnp.mean(xf * xf, axis=-1, keepdims=True) + NORM_EPS)
    return (y * w.astype(jnp.float32)).astype(x.dtype)


def swiglu(x, w_gate, w_up, w_down):
    return (jax.nn.silu(x @ w_gate) * (x @ w_up)) @ w_down


def rope(x, pos):
    half = x.shape[-1] // 2
    inv_freq = jnp.power(ROPE_THETA, -jnp.arange(half, dtype=jnp.float32) / half)
    ang = pos.astype(jnp.float32)[:, None] * inv_freq[None, :]
    cos, sin = jnp.cos(ang), jnp.sin(ang)
    xf = x.astype(jnp.float32)
    x1, x2 = xf[..., :half], xf[..., half:]
    return jnp.concatenate([x1 * cos - x2 * sin, x2 * cos + x1 * sin], axis=-1).astype(x.dtype)


def masked_softmax(s, valid):
    s = jnp.where(valid, s.astype(jnp.float32), NEG)
    m = jnp.max(s, axis=-1, keepdims=True)
    e = jnp.where(valid, jnp.exp(s - m), 0.0)
    z = jnp.sum(e, axis=-1, keepdims=True)
    return e / jnp.where(z > 0, z, 1.0)


def causal_dwconv(u, w, b):
    K, C = w.shape
    y = lax.conv_general_dilated(u, w[:, None, :].astype(u.dtype), window_strides=(1,), padding=[(K - 1, 0)],
                                 dimension_numbers=('NWC', 'WIO', 'NWC'), feature_group_count=C)
    return y + b


def mlstm_chunkwise(q, k, v, i_pre, f_pre):
    B, H, T, dh = q.shape
    L = ML_CHUNK
    nc = T // L
    f32 = jnp.float32
    out_dtype = q.dtype
    q, k, v = (a.astype(f32) for a in (q, k, v))
    log_f = jax.nn.log_sigmoid(f_pre.astype(f32))
    i_pre = i_pre.astype(f32)

    def chunks(a):
        return jnp.moveaxis(a.reshape(B, H, nc, L, *a.shape[3:]), 2, 0)

    causal = jnp.tril(jnp.ones((L, L), dtype=bool))

    def step(carry, xs):
        C, n, m = carry
        qj, kj, vj, ij, fj = xs
        b = jnp.cumsum(fj, axis=-1)
        dlog = jnp.where(causal, b[..., :, None] - b[..., None, :] + ij[..., None, :], NEG)
        inter = b + m[..., None]
        m_t = jnp.maximum(inter, jnp.max(dlog, axis=-1))
        w_intra = jnp.exp(dlog - m_t[..., None])
        w_inter = jnp.exp(inter - m_t)
        qk = jnp.einsum('bhld,bhsd->bhls', qj, kj) * w_intra
        num = jnp.einsum('bhls,bhsd->bhld', qk, vj) + w_inter[..., None] * jnp.einsum('bhvk,bhlk->bhlv', C, qj)
        den = jnp.sum(qk, axis=-1) + w_inter * jnp.einsum('bhk,bhlk->bhl', n, qj)
        h = num / jnp.maximum(jnp.abs(den), jnp.exp(-m_t))[..., None]
        g = b[..., -1]
        upd = g[..., None] - b + ij
        m_new = jnp.maximum(g + m, jnp.max(upd, axis=-1))
        a_prev = jnp.exp(g + m - m_new)
        a_s = jnp.exp(upd - m_new[..., None])
        C = a_prev[..., None, None] * C + jnp.einsum('bhs,bhsv,bhsk->bhvk', a_s, vj, kj)
        n = a_prev[..., None] * n + jnp.einsum('bhs,bhsk->bhk', a_s, kj)
        return (C, n, m_new), h

    init = (jnp.zeros((B, H, dh, dh), f32), jnp.zeros((B, H, dh), f32), jnp.zeros((B, H), f32))
    _, h = lax.scan(step, init, (chunks(q), chunks(k), chunks(v), chunks(i_pre), chunks(log_f)))
    return jnp.moveaxis(h, 0, 2).reshape(B, H, T, dh).astype(out_dtype)


def hgrn2_chunkwise(q, k, v, log_f):
    B, H, T, dk = q.shape
    dv = v.shape[-1]
    L = HG_CHUNK
    nc = T // L
    f32 = jnp.float32

    def chunks(a):
        return jnp.moveaxis(a.astype(f32).reshape(B, H, nc, L, a.shape[-1]), 2, 0)

    causal = jnp.tril(jnp.ones((L, L), dtype=bool))[:, :, None]

    def step(S, xs):
        qj, kj, vj, fj = xs
        b = jnp.cumsum(fj, axis=2)
        decay = jnp.exp(jnp.where(causal, b[:, :, :, None, :] - b[:, :, None, :, :], NEG))
        att = jnp.einsum('bhlc,bhlsc,bhsc->bhls', qj, decay, kj)
        o = jnp.einsum('bhls,bhsv->bhlv', att, vj) + jnp.einsum('bhlc,bhcv->bhlv', qj * jnp.exp(b), S)
        g = b[:, :, -1:, :]
        S = jnp.exp(g[:, :, 0, :])[..., None] * S + jnp.einsum('bhsc,bhsv->bhcv', kj * jnp.exp(g - b), vj)
        return S, o

    S0 = jnp.zeros((B, H, dk, dv), f32)
    _, o = lax.scan(step, S0, (chunks(q), chunks(k), chunks(v), chunks(log_f)))
    return jnp.moveaxis(o, 0, 2).reshape(B, H, T, dv).astype(v.dtype)


def ab_mixer(h, w_in, w_out, conv_w, conv_b, wq, wk, i_bias, f_bias, ml_norm, ml_skip, lb, hg_norm):
    B, T, _ = h.shape
    u, v, o_pre, i_pre, f_pre, hq, hf, hi, hg = _split(h @ w_in, AB_SIZES)
    c = jax.nn.silu(causal_dwconv(u, conv_w, conv_b))
    ch = c.reshape(B, T, ML_HEADS, ML_HEAD_DIM)
    q = jnp.einsum('bthd,hde->bhte', ch, wq)
    k = jnp.einsum('bthd,hde->bhte', ch, wk) * ML_HEAD_DIM ** -0.5
    vm = v.reshape(B, T, ML_HEADS, ML_HEAD_DIM).transpose(0, 2, 1, 3)
    hm = mlstm_chunkwise(q, k, vm, (i_pre + i_bias).transpose(0, 2, 1), (f_pre + f_bias).transpose(0, 2, 1))
    hm = rmsnorm(hm.transpose(0, 2, 1, 3), ml_norm).reshape(B, T, ML_WIDTH)
    y_ml = jax.nn.sigmoid(o_pre) * (hm + ml_skip * c)
    lbf = lb.astype(jnp.float32)
    zf = hf.astype(jnp.float32)
    k2 = (1.0 - lbf) * jax.nn.sigmoid(-zf)
    log_f = jnp.maximum(jnp.log1p(-jnp.minimum(k2, HG_MAX_K)), jax.nn.log_sigmoid(zf))

    def to_heads(a, n):
        return a.reshape(B, T, HG_HEADS, n).transpose(0, 2, 1, 3)

    o2 = hgrn2_chunkwise(to_heads(jax.nn.silu(hq), HG_KEY_DIM), to_heads(k2, HG_KEY_DIM),
                         to_heads(hi, HG_VAL_DIM), to_heads(log_f, HG_KEY_DIM))
    o2 = rmsnorm(o2.transpose(0, 2, 1, 3), hg_norm).reshape(B, T, HG_WIDTH)
    y_hg = o2.astype(h.dtype) * jax.nn.silu(hg)
    return jnp.concatenate([y_ml.astype(h.dtype), y_hg], axis=-1) @ w_out


def compress_blocks(kv, pos_emb, w1, b1, w2):
    B, G, T, d = kv.shape
    nc = (T - CMP_BLOCK) // CMP_STRIDE + 1
    idx = jnp.arange(nc)[:, None] * CMP_STRIDE + jnp.arange(CMP_BLOCK)[None, :]
    blocks = kv[:, :, idx, :] + pos_emb
    flat = blocks.reshape(B, G, nc, CMP_BLOCK * d)
    return jax.nn.silu(flat @ w1 + b1) @ w2


def nsa_attention(q, k_cmp, v_cmp, k_sel, v_sel, k_win, v_win, gates):
    B, G, R, T, d = q.shape
    f32 = jnp.float32
    nc = k_cmp.shape[2]
    ns = T // SEL_BLOCK
    n_sel = min(SEL_TOPK, ns)
    scale = d ** -0.5
    QB = NSA_QBLOCK
    cmp_end = jnp.arange(nc) * CMP_STRIDE + CMP_BLOCK - 1
    ci = jnp.arange(nc)[:, None] * CMP_STRIDE
    sj = jnp.arange(ns)[None, :] * SEL_BLOCK
    cover = ((ci < sj + SEL_BLOCK) & (ci + CMP_BLOCK > sj)).astype(f32)
    ksb = k_sel.reshape(B, G, ns, SEL_BLOCK, d)
    vsb = v_sel.reshape(B, G, ns, SEL_BLOCK, d)
    pad = ((0, 0), (0, 0), (WINDOW, 0), (0, 0))
    kwp, vwp = jnp.pad(k_win, pad), jnp.pad(v_win, pad)
    blk_ids = jnp.arange(ns)
    take = jax.vmap(jax.vmap(lambda blocks, ix: blocks[ix]))

    def one_block(bi):
        q0 = bi * QB
        t = q0 + jnp.arange(QB)
        qb = lax.dynamic_slice_in_dim(q, q0, QB, axis=3)
        gb = lax.dynamic_slice_in_dim(gates, q0, QB, axis=3).astype(f32)
        s_c = jnp.einsum('bgrqd,bgnd->bgrqn', qb, k_cmp, preferred_element_type=f32) * scale
        p_c = masked_softmax(s_c, cmp_end[None, :] <= t[:, None])
        o_c = jnp.einsum('bgrqn,bgnd->bgrqd', p_c, v_cmp.astype(f32))
        imp = jnp.einsum('bgrqn,ns->bgqs', p_c, cover)
        cur = (t // SEL_BLOCK)[:, None]
        forced = (blk_ids[None, :] == 0) | (blk_ids[None, :] == cur) | (blk_ids[None, :] == cur - 1)
        imp = jnp.where(blk_ids[None, :] * SEL_BLOCK <= t[:, None], imp + jnp.where(forced, FORCE_BONUS, 0.0), NEG)
        _, idx = lax.top_k(imp, n_sel)
        kg, vg = take(ksb, idx), take(vsb, idx)
        s_s = jnp.einsum('bgrqd,bgqnkd->bgrqnk', qb, kg, preferred_element_type=f32) * scale
        key_pos = idx[..., None] * SEL_BLOCK + jnp.arange(SEL_BLOCK)
        valid_s = (key_pos <= t[:, None, None])[:, :, None]
        p_s = masked_softmax(s_s.reshape(B, G, R, QB, -1), valid_s.reshape(B, G, 1, QB, -1)).reshape(s_s.shape)
        o_s = jnp.einsum('bgrqnk,bgqnkd->bgrqd', p_s, vg.astype(f32))
        kw = lax.dynamic_slice_in_dim(kwp, q0, WINDOW + QB, axis=2)
        vw = lax.dynamic_slice_in_dim(vwp, q0, WINDOW + QB, axis=2)
        kpos = q0 - WINDOW + jnp.arange(WINDOW + QB)
        valid_w = (kpos[None, :] >= 0) & (kpos[None, :] <= t[:, None]) & (kpos[None, :] > t[:, None] - WINDOW)
        s_w = jnp.einsum('bgrqd,bgkd->bgrqk', qb, kw, preferred_element_type=f32) * scale
        p_w = masked_softmax(s_w, valid_w)
        o_w = jnp.einsum('bgrqk,bgkd->bgrqd', p_w, vw.astype(f32))
        return gb[..., 0:1] * o_c + gb[..., 1:2] * o_s + gb[..., 2:3] * o_w

    out = lax.map(one_block, jnp.arange(T // QB))
    return jnp.moveaxis(out, 0, 3).reshape(B, G, R, T, d).astype(q.dtype)


def nsa_mixer(h, w_in, w_out, q_norm, k_norm, cmp_pos, cmp_w1, cmp_b1, cmp_w2, gate_bias):
    B, T, _ = h.shape
    d, G, R = NSA_HEAD_DIM, NSA_KV_GROUPS, NSA_HEADS // NSA_KV_GROUPS
    q, kc, vc, ks, vs, kw, vw, gp = _split(h @ w_in, C_SIZES)

    def heads(a, n):
        return a.reshape(B, T, n, d).transpose(0, 2, 1, 3)

    pos = jnp.arange(T)
    q = rope(rmsnorm(heads(q, NSA_HEADS), q_norm), pos).reshape(B, G, R, T, d)
    k_sel = rope(rmsnorm(heads(ks, G), k_norm[1]), pos)
    k_win = rope(rmsnorm(heads(kw, G), k_norm[2]), pos)
    k_cmp = compress_blocks(heads(kc, G), cmp_pos[0], cmp_w1[0], cmp_b1[0], cmp_w2[0])
    nc = k_cmp.shape[2]
    k_cmp = rope(rmsnorm(k_cmp, k_norm[0]), jnp.arange(nc) * CMP_STRIDE + CMP_BLOCK - 1)
    v_cmp = compress_blocks(heads(vc, G), cmp_pos[1], cmp_w1[1], cmp_b1[1], cmp_w2[1])
    gates = jax.nn.sigmoid(gp + gate_bias).reshape(B, T, G, R, 3).transpose(0, 2, 3, 1, 4)
    o = nsa_attention(q, k_cmp, v_cmp, k_sel, heads(vs, G), k_win, heads(vw, G), gates)
    o = o.reshape(B, NSA_HEADS, T, d).transpose(0, 2, 1, 3).reshape(B, T, NSA_HEADS * d)
    return o @ w_out


def setup_inputs(seed: int = 0) -> dict:
    key = jax.random.key(seed)
    ks = jax.random.split(key, 40)
    ctr = [0]

    def nrm(shape, scale):
        kk = ks[ctr[0]]
        ctr[0] += 1
        return jax.random.normal(kk, shape, jnp.float32) * scale

    def gain(shape):
        return 1.0 + nrm(shape, 0.02)

    D, F = D_MODEL, D_FF
    d = NSA_HEAD_DIM
    return {
        'x': nrm((BATCH, SEQ, D), 1.0),
        'ffn1_norm': gain((DEPTH, D)),
        'ffn1_w_gate': nrm((DEPTH, D, F), D ** -0.5),
        'ffn1_w_up': nrm((DEPTH, D, F), D ** -0.5),
        'ffn1_w_down': nrm((DEPTH, F, D), F ** -0.5),
        'mix_norm': gain((DEPTH, D)),
        'ffn2_norm': gain((DEPTH, D)),
        'ffn2_w_gate': nrm((DEPTH, D, F), D ** -0.5),
        'ffn2_w_up': nrm((DEPTH, D, F), D ** -0.5),
        'ffn2_w_down': nrm((DEPTH, F, D), F ** -0.5),
        'ab_w_in': nrm((N_AB, D, AB_COLS), D ** -0.5),
        'ab_w_out': nrm((N_AB, ML_WIDTH + HG_WIDTH, D), (ML_WIDTH + HG_WIDTH) ** -0.5),
        'ml_conv_w': nrm((N_AB, ML_CONV, ML_WIDTH), ML_CONV ** -0.5),
        'ml_conv_b': nrm((N_AB, ML_WIDTH), 0.02),
        'ml_wq': nrm((N_AB, ML_HEADS, ML_HEAD_DIM, ML_HEAD_DIM), ML_HEAD_DIM ** -0.5),
        'ml_wk': nrm((N_AB, ML_HEADS, ML_HEAD_DIM, ML_HEAD_DIM), ML_HEAD_DIM ** -0.5),
        'ml_i_bias': nrm((N_AB, ML_HEADS), 0.1),
        'ml_f_bias': jnp.linspace(3.0, 6.0, ML_HEADS, dtype=jnp.float32) + nrm((N_AB, ML_HEADS), 0.1),
        'ml_out_norm': gain((N_AB, ML_HEADS, ML_HEAD_DIM)),
        'ml_skip': gain((N_AB, ML_WIDTH)),
        'hg_lb_logits': nrm((N_AB, HG_KEY_WIDTH), 0.5),
        'hg_out_norm': gain((N_AB, HG_HEADS, HG_VAL_DIM)),
        'c_w_in': nrm((N_C, D, C_COLS), D ** -0.5),
        'c_w_out': nrm((N_C, NSA_HEADS * d, D), (NSA_HEADS * d) ** -0.5),
        'c_q_norm': gain((N_C, d)),
        'c_k_norm': gain((N_C, 3, d)),
        'c_cmp_pos': nrm((N_C, 2, CMP_BLOCK, d), 0.1),
        'c_cmp_w1': nrm((N_C, 2, CMP_BLOCK * d, CMP_HIDDEN), (CMP_BLOCK * d) ** -0.5),
        'c_cmp_b1': nrm((N_C, 2, CMP_HIDDEN), 0.02),
        'c_cmp_w2': nrm((N_C, 2, CMP_HIDDEN, d), CMP_HIDDEN ** -0.5),
        'c_gate_bias': nrm((N_C, 3 * NSA_HEADS), 0.1),
    }


def reference(x, ffn1_norm, ffn1_w_gate, ffn1_w_up, ffn1_w_down, mix_norm, ffn2_norm, ffn2_w_gate, ffn2_w_up,
              ffn2_w_down, ab_w_in, ab_w_out, ml_conv_w, ml_conv_b, ml_wq, ml_wk, ml_i_bias, ml_f_bias, ml_out_norm,
              ml_skip, hg_lb_logits, hg_out_norm, c_w_in, c_w_out, c_q_norm, c_k_norm, c_cmp_pos, c_cmp_w1, c_cmp_b1,
              c_cmp_w2, c_gate_bias):
    lb_soft = jax.nn.softmax(hg_lb_logits.astype(jnp.float32), axis=0)
    lb_all = jnp.cumsum(lb_soft, axis=0) - lb_soft[0]
    h = x
    for layer in range(DEPTH):
        h = h + 0.5 * swiglu(rmsnorm(h, ffn1_norm[layer]), ffn1_w_gate[layer], ffn1_w_up[layer], ffn1_w_down[layer])
        hn = rmsnorm(h, mix_norm[layer])
        j = layer // 2
        if layer % 2 == 0:
            h = h + ab_mixer(hn, ab_w_in[j], ab_w_out[j], ml_conv_w[j], ml_conv_b[j], ml_wq[j], ml_wk[j],
                             ml_i_bias[j], ml_f_bias[j], ml_out_norm[j], ml_skip[j], lb_all[j], hg_out_norm[j])
        else:
            h = h + nsa_mixer(hn, c_w_in[j], c_w_out[j], c_q_norm[j], c_k_norm[j], c_cmp_pos[j], c_cmp_w1[j],
                              c_cmp_b1[j], c_cmp_w2[j], c_gate_bias[j])
        h = h + 0.5 * swiglu(rmsnorm(h, ffn2_norm[layer]), ffn2_w_gate[layer], ffn2_w_up[layer], ffn2_w_down[layer])
    return h
```

```cpp
#include <hip/hip_runtime.h>
#include <cstdio>
#include <cstdint>

constexpr int BATCH = 2, SEQ = 8192, T = BATCH * SEQ, D = 2048, FF = 5504, DEPTH = 4;
constexpr int AB_COLS = 7176, AB_N = 7168;
constexpr int C_COLS = 5168, C_N = 5120;
constexpr int NSLOT = 40;
constexpr int NCMP = 512;
constexpr float NORM_EPS = 1e-6f;

#define GAS __attribute__((address_space(1)))
#define LAS __attribute__((address_space(3)))
typedef unsigned short bf16_t;
typedef unsigned v4u __attribute__((ext_vector_type(4)));
typedef unsigned v2u __attribute__((ext_vector_type(2)));
typedef float f32x4 __attribute__((ext_vector_type(4)));
typedef float f32x2 __attribute__((ext_vector_type(2)));
typedef short bf16x8 __attribute__((ext_vector_type(8)));

__device__ __forceinline__ unsigned f2bf(float f) { unsigned u = __builtin_bit_cast(unsigned, f); return (u + 0x7fffu + ((u >> 16) & 1u)) >> 16; }
__device__ __forceinline__ unsigned pk2(float lo, float hi) { return f2bf(lo) | (f2bf(hi) << 16); }
__device__ __forceinline__ float bf2f(unsigned short b) { return __builtin_bit_cast(float, ((unsigned)b) << 16); }
__device__ __forceinline__ float bflo(unsigned w) { return __builtin_bit_cast(float, w << 16); }
__device__ __forceinline__ float bfhi(unsigned w) { return __builtin_bit_cast(float, w & 0xffff0000u); }
__device__ __forceinline__ float wave_sum(float v) {
#pragma unroll
    for (int o = 1; o < 64; o <<= 1) v += __shfl_xor(v, o);
    return v;
}
__device__ __forceinline__ float wave_max(float v) {
#pragma unroll
    for (int o = 1; o < 64; o <<= 1) v = fmaxf(v, __shfl_xor(v, o));
    return v;
}
__device__ __forceinline__ float sigmoidf_(float x) { return 1.0f / (1.0f + __expf(-x)); }
__device__ __forceinline__ float siluf_(float x) { return x / (1.0f + __expf(-x)); }
__device__ __forceinline__ float row16_sum(float v) {
    v += __builtin_bit_cast(float, __builtin_amdgcn_mov_dpp(__builtin_bit_cast(int, v), 0xB1, 0xf, 0xf, true));
    v += __builtin_bit_cast(float, __builtin_amdgcn_mov_dpp(__builtin_bit_cast(int, v), 0x4E, 0xf, 0xf, true));
    v += __builtin_bit_cast(float, __builtin_amdgcn_mov_dpp(__builtin_bit_cast(int, v), 0x124, 0xf, 0xf, true));
    v += __builtin_bit_cast(float, __builtin_amdgcn_mov_dpp(__builtin_bit_cast(int, v), 0x128, 0xf, 0xf, true));
    return v;
}
#define XB_TMO      128
#define XB_XCNT(j)  (256  + 64 * (j))
#define XB_XSUB(j)  (1280 + 64 * (j))
#define XB_XGEN(j)  (2304 + 64 * (j))
#define XB_TOP      3328
#define XB_TOPGEN   3392
#define XCD_BAR_WORDS 3456
#define XB_SPIN_CAP (1u << 18)

__device__ __forceinline__ unsigned xb_ld(unsigned* p)              { return __hip_atomic_load(p, __ATOMIC_RELAXED, __HIP_MEMORY_SCOPE_AGENT); }
__device__ __forceinline__ unsigned xb_add(unsigned* p, unsigned v) { return __hip_atomic_fetch_add(p, v, __ATOMIC_RELAXED, __HIP_MEMORY_SCOPE_AGENT); }
__device__ __forceinline__ unsigned xb_xcc_id() { return (unsigned)__builtin_amdgcn_s_getreg((3 << 11) | 20) & 0xFu; }
#define XB_SPIN(cond, bar) do { unsigned _sp = 0; while (cond) { __builtin_amdgcn_s_sleep(1); \
    if ((++_sp & 255u) == 0u) { if (xb_ld(&(bar)[XB_TMO])) break; if (_sp > XB_SPIN_CAP) { atomicAdd(&(bar)[XB_TMO], 1u); break; } } } } while (0)

struct XcdBarrier {
    unsigned* bar; unsigned x;
    volatile LAS unsigned* st;
};

__device__ __forceinline__ XcdBarrier xcd_barrier_post(unsigned* bar, volatile LAS unsigned* st) {
    XcdBarrier b; b.bar = bar; b.x = xb_xcc_id(); b.st = st;
    if (threadIdx.x == 0) (void)xb_add(&bar[XB_XCNT(b.x)], 1u);
    return b;
}
__device__ __forceinline__ void xcd_barrier_complete(unsigned* bar, unsigned x, unsigned& nloc, unsigned& nx) {
    const unsigned G = gridDim.x * gridDim.y * gridDim.z;
    unsigned sum, cnt, mine, sp = 0u;
    for (;;) {
        sum = 0u; cnt = 0u; mine = 0u;
#pragma unroll
        for (unsigned j = 0; j < 16; ++j) { const unsigned c = xb_ld(&bar[XB_XCNT(j)]); sum += c; cnt += (c > 0u) ? 1u : 0u; mine = (j == x) ? c : mine; }
        if (sum == G) break;
        __builtin_amdgcn_s_sleep(1);
        if ((++sp & 255u) == 0u) { if (xb_ld(&bar[XB_TMO])) break; if (sp > XB_SPIN_CAP) { atomicAdd(&bar[XB_TMO], 1u); break; } }
    }
    nloc = mine > 0u ? mine : 1u; nx = cnt > 0u ? cnt : 1u;
}

__device__ __forceinline__ void xcd_barrier(const XcdBarrier& b) {
    asm volatile("s_waitcnt vmcnt(0)" ::: "memory");
    __syncthreads();
    if (threadIdx.x == 0) {
        unsigned* bar = b.bar;
        __builtin_amdgcn_s_waitcnt(0);
        unsigned nloc = b.st[0], nx = b.st[1];
        if (nloc == 0u) { xcd_barrier_complete(bar, b.x, nloc, nx); b.st[0] = nloc; b.st[1] = nx; }
        const unsigned old = xb_add(&bar[XB_XSUB(b.x)], 1u);
        const unsigned gen = old / nloc;
        if (old + 1u == (gen + 1u) * nloc) {
            __builtin_amdgcn_fence(__ATOMIC_RELEASE, "agent");
            asm volatile("s_waitcnt vmcnt(0)" ::: "memory");
            const unsigned og = xb_add(&bar[XB_TOP], 1u);
            const unsigned tg = og / nx;
            if (og + 1u == (tg + 1u) * nx) xb_add(&bar[XB_TOPGEN], 1u);
            else XB_SPIN(xb_ld(&bar[XB_TOPGEN]) == tg, bar);
            __builtin_amdgcn_fence(__ATOMIC_ACQUIRE, "agent");
            xb_add(&bar[XB_XGEN(b.x)], 1u);
            asm volatile("s_waitcnt vmcnt(0)" ::: "memory");
        } else {
            XB_SPIN(xb_ld(&bar[XB_XGEN(b.x)]) == gen, bar);
            __builtin_amdgcn_fence(__ATOMIC_ACQUIRE, "agent");
            asm volatile("s_waitcnt vmcnt(0)" ::: "memory");
        }
    }
    __syncthreads();
}
namespace pg8 {
#define PG8_LAS __attribute__((address_space(3)))
typedef unsigned short bf16_t;
typedef short bf16x8 __attribute__((ext_vector_type(8)));
typedef float f32x4 __attribute__((ext_vector_type(4)));
typedef unsigned u32x4 __attribute__((ext_vector_type(4)));
constexpr int BM = 256, BK = 64, HALF = 128, HTB = HALF * BK * 2  , STAGE_BYTES = 8 * HTB, NXCD = 8, WGM = 8;

__host__ __device__ __forceinline__ int lds_byte(int r, int c) { const int st = (r >> 4) * 2 + (c >> 5), rr = r & 15, cc = c & 31, ob = rr * 64 + cc * 2; return st * 1024 + (ob ^ (((ob >> 9) & 1) << 5)); }
__host__ __device__ __forceinline__ void stage_rc(int b, int& R, int& C) { const int st = b / 1024, sb = b % 1024, swz = sb ^ (((sb >> 9) & 1) << 5); R = (st >> 1) * 16 + swz / 64; C = (st & 1) * 32 + (swz % 64) / 2; }
__host__ __device__ __forceinline__ int perm32(int rho) { const int n = rho >> 4, i = rho & 15; return 8 * (i >> 2) + 4 * n + (i & 3); }

struct Unit { int pm, pn; };
struct Gemm { const bf16_t* A; const bf16_t* Bt; int M, N, K; int lda, ldb; int amask; int astride; };

struct StaticOrder {
    int nM, nN, nwg, G, c;
    __host__ __device__ void init(int M, int N, int G_, int c_) { nM = M / BM; nN = N / BM; nwg = nM * nN; G = G_; c = c_; }
    __host__ __device__ bool next(int i, Unit& u) const {
        const long L = (long)i * G + c; if (L >= nwg) return false;
        int wgid = (int)L; { const int q = nwg / NXCD, r = nwg % NXCD, xcd = wgid % NXCD, off = wgid / NXCD; wgid = (xcd < r ? xcd * (q + 1) : r * (q + 1) + (xcd - r) * q) + off; }
        const int nig = WGM * nN, gid = wgid / nig, fm = gid * WGM, gsz = (nM - fm) < WGM ? (nM - fm) : WGM;
        u.pm = fm + ((wgid % nig) % gsz); u.pn = (wgid % nig) / gsz; return true;
    }
    __device__ __forceinline__ void a_ready(const Unit&) const {}
    __device__ __forceinline__ void done(const Unit&) const {}
};
struct CountedOrder : StaticOrder {
    const unsigned* ready; unsigned need; unsigned* tmo;
    __device__ __forceinline__ void a_ready(const Unit& u) const {
        if (threadIdx.x < 64) {
            const unsigned long long t0 = __builtin_amdgcn_s_memrealtime(); unsigned polls = 0;
            while ((unsigned)__builtin_amdgcn_readfirstlane(__hip_atomic_load(ready + 64 * u.pm, __ATOMIC_RELAXED, __HIP_MEMORY_SCOPE_AGENT)) < need) {
                if ((++polls & 255u) == 0u && __builtin_amdgcn_readfirstlane(__hip_atomic_load(tmo, __ATOMIC_RELAXED, __HIP_MEMORY_SCOPE_AGENT)) != 0u) break;
                if (__builtin_amdgcn_s_memrealtime() - t0 > 2000000ull) {
                    if (threadIdx.x == 0) { unsigned expect = 0u; __hip_atomic_compare_exchange_strong(tmo + 1, &expect, 0x600u | (unsigned)(u.pm & 0xff), __ATOMIC_RELAXED, __ATOMIC_RELAXED, __HIP_MEMORY_SCOPE_AGENT); __hip_atomic_store(tmo, 1u, __ATOMIC_RELAXED, __HIP_MEMORY_SCOPE_AGENT); }
                    break; }
                __builtin_amdgcn_s_sleep(2); }
            __builtin_amdgcn_fence(__ATOMIC_ACQUIRE, "agent");
            asm volatile("s_waitcnt vmcnt(0)" ::: "memory");
        }
#if !defined(BROKEN_HOOK_NO_BARRIER)
        asm volatile("" ::: "memory"); __builtin_amdgcn_s_barrier(); asm volatile("" ::: "memory");
#endif
    }
};

__device__ __forceinline__ unsigned cvt_pk_bf16(float lo, float hi) { unsigned r; asm volatile("v_cvt_pk_bf16_f32 %0, %1, %2" : "=v"(r) : "v"(lo), "v"(hi)); return r; }
typedef float f32x2 __attribute__((ext_vector_type(2)));
__device__ __forceinline__ f32x2 gelu_pk(f32x2 v) {
    const f32x2 av = __builtin_elementwise_abs(v), d = av * 0.2316418882f + 1.0f;
    f32x2 t; t.x = __builtin_amdgcn_rcpf(d.x); t.y = __builtin_amdgcn_rcpf(d.y);
    f32x2 q = t * 0.5307027145f + (-0.7265760135f); q = q * t + 0.7107068705f; q = q * t + (-0.142248368f); q = q * t + 0.127414796f; q = q * t;
    const f32x2 s = (v * v) * (-0.72134752044f);
    f32x2 e; e.x = __builtin_amdgcn_exp2f(s.x); e.y = __builtin_amdgcn_exp2f(s.y);
    const f32x2 m = v * (q * e), r = v - m;
    f32x2 o; o.x = v.x < 0.f ? m.x : r.x; o.y = v.y < 0.f ? m.y : r.y; return o;
}

struct EpiF32 {
    static constexpr bool PERM = false, AFTER_DRAIN = false;
    float* C; int ldc; const float* bias;
    __device__ __forceinline__ void operator()(const f32x4 (&acc)[2][2][4][2], const Unit& u, int wr, int wc, int fr, int fq) const {
        const int row0 = u.pm * BM + wr * 64 + fr, col0 = u.pn * BM + wc * 32 + 4 * fq;
        f32x4 bv[2][2];
#pragma unroll
        for (int bj = 0; bj < 2; ++bj)
#pragma unroll
            for (int n = 0; n < 2; ++n) bv[bj][n] = bias ? *(const f32x4*)(bias + col0 + bj * HALF + n * 16) : (f32x4){0.f, 0.f, 0.f, 0.f};
#pragma unroll
        for (int ai = 0; ai < 2; ++ai)
#pragma unroll
            for (int m = 0; m < 4; ++m) { float* rowp = C + (size_t)(row0 + ai * HALF + m * 16) * ldc + col0;
#pragma unroll
                for (int bj = 0; bj < 2; ++bj)
#pragma unroll
                    for (int n = 0; n < 2; ++n) *(f32x4*)(rowp + bj * HALF + n * 16) = acc[ai][bj][m][n] + bv[bj][n]; }
    }
};
template <int ACT  > struct EpiBf16 {
    static constexpr bool PERM = true, AFTER_DRAIN = false;
    bf16_t* O; int ldc; const float* bias; int split_cols; size_t split_stride;
    __device__ __forceinline__ void operator()(const f32x4 (&acc)[2][2][4][2], const Unit& u, int wr, int wc, int fr, int fq) const {
        const int row0 = u.pm * BM + wr * 64 + fr; int colt = u.pn * BM; bf16_t* base = O;
        if (split_cols) { const int t = colt / split_cols; base += (size_t)t * split_stride; colt -= t * split_cols; }
        const int col0 = colt + wc * 32 + 8 * fq, bcol0 = u.pn * BM + wc * 32 + 8 * fq;
        f32x4 bv[2][2];
#pragma unroll
        for (int bj = 0; bj < 2; ++bj)
#pragma unroll
            for (int n = 0; n < 2; ++n) bv[bj][n] = bias ? *(const f32x4*)(bias + bcol0 + bj * HALF + 4 * n) : (f32x4){0.f, 0.f, 0.f, 0.f};
#pragma unroll
        for (int ai = 0; ai < 2; ++ai)
#pragma unroll
            for (int m = 0; m < 4; ++m) { bf16_t* rowp = base + (size_t)(row0 + ai * HALF + m * 16) * ldc + col0;
#pragma unroll
                for (int bj = 0; bj < 2; ++bj) { f32x4 v0 = acc[ai][bj][m][0] + bv[bj][0], v1 = acc[ai][bj][m][1] + bv[bj][1];
                    if (ACT == 1) { f32x2 a = gelu_pk((f32x2){v0[0], v0[1]}), b = gelu_pk((f32x2){v0[2], v0[3]}), c = gelu_pk((f32x2){v1[0], v1[1]}), d = gelu_pk((f32x2){v1[2], v1[3]});
                        v0 = (f32x4){a.x, a.y, b.x, b.y}; v1 = (f32x4){c.x, c.y, d.x, d.y}; }
                    if (ACT == 2) {
#pragma unroll
                        for (int j = 0; j < 4; ++j) { v0[j] = 0.5f * v0[j] * (1.0f + erff(v0[j] * 0.70710678f)); v1[j] = 0.5f * v1[j] * (1.0f + erff(v1[j] * 0.70710678f)); } }
                    u32x4 w; w.x = cvt_pk_bf16(v0[0], v0[1]); w.y = cvt_pk_bf16(v0[2], v0[3]); w.z = cvt_pk_bf16(v1[0], v1[1]); w.w = cvt_pk_bf16(v1[2], v1[3]);
                    *(u32x4*)(rowp + bj * HALF) = w; } }
    }
};

__device__ __forceinline__ float silu_f(float x) { return x * __builtin_amdgcn_rcpf(1.0f + __expf(-x)); }
struct EpiSwiGLU {
    static constexpr bool PERM = true, AFTER_DRAIN = false;
    bf16_t* O; int ldc;
    __device__ __forceinline__ void operator()(const f32x4 (&acc)[2][2][4][2], const Unit& u, int wr, int wc, int fr, int fq) const {
        const int row0 = u.pm * BM + wr * 64 + fr, col0 = u.pn * HALF + wc * 32 + 8 * fq;
#pragma unroll
        for (int ai = 0; ai < 2; ++ai)
#pragma unroll
            for (int m = 0; m < 4; ++m) { bf16_t* rowp = O + (size_t)(row0 + ai * HALF + m * 16) * ldc + col0;
                const f32x4 g0 = acc[ai][0][m][0], g1 = acc[ai][0][m][1], u0 = acc[ai][1][m][0], u1 = acc[ai][1][m][1];
                float r[8];
#pragma unroll
                for (int j = 0; j < 4; ++j) { r[j] = silu_f(g0[j]) * u0[j]; r[4 + j] = silu_f(g1[j]) * u1[j]; }
                u32x4 w; w.x = cvt_pk_bf16(r[0], r[1]); w.y = cvt_pk_bf16(r[2], r[3]); w.z = cvt_pk_bf16(r[4], r[5]); w.w = cvt_pk_bf16(r[6], r[7]);
                *(u32x4*)rowp = w; }
    }
};
struct EpiResid {
    static constexpr bool PERM = false, AFTER_DRAIN = false;
    float* H; int ldc; float alpha;
    __device__ __forceinline__ void operator()(const f32x4 (&acc)[2][2][4][2], const Unit& u, int wr, int wc, int fr, int fq) const {
        const int row0 = u.pm * BM + wr * 64 + fr, col0 = u.pn * BM + wc * 32 + 4 * fq;
#pragma unroll
        for (int ai = 0; ai < 2; ++ai)
#pragma unroll
            for (int m = 0; m < 4; ++m) { float* rowp = H + (size_t)(row0 + ai * HALF + m * 16) * ldc + col0;
#pragma unroll
                for (int bj = 0; bj < 2; ++bj)
#pragma unroll
                    for (int n = 0; n < 2; ++n) { f32x4* p = (f32x4*)(rowp + bj * HALF + n * 16); *p = *p + acc[ai][bj][m][n] * alpha; } }
    }
};
struct EpiPlainBf16 {
    static constexpr bool PERM = true, AFTER_DRAIN = false;
    bf16_t* O; int ldc;
    __device__ __forceinline__ void operator()(const f32x4 (&acc)[2][2][4][2], const Unit& u, int wr, int wc, int fr, int fq) const {
        const int row0 = u.pm * BM + wr * 64 + fr, col0 = u.pn * BM + wc * 32 + 8 * fq;
#pragma unroll
        for (int ai = 0; ai < 2; ++ai)
#pragma unroll
            for (int m = 0; m < 4; ++m) { bf16_t* rowp = O + (size_t)(row0 + ai * HALF + m * 16) * ldc + col0;
#pragma unroll
                for (int bj = 0; bj < 2; ++bj) { const f32x4 v0 = acc[ai][bj][m][0], v1 = acc[ai][bj][m][1];
                    u32x4 w; w.x = cvt_pk_bf16(v0[0], v0[1]); w.y = cvt_pk_bf16(v0[2], v0[3]); w.z = cvt_pk_bf16(v1[0], v1[1]); w.w = cvt_pk_bf16(v1[2], v1[3]);
                    *(u32x4*)(rowp + bj * HALF) = w; } }
    }
};
struct EpiSlots {
    static constexpr bool PERM = true, AFTER_DRAIN = false;
    bf16_t* O; int Mrows;
    __device__ __forceinline__ void operator()(const f32x4 (&acc)[2][2][4][2], const Unit& u, int wr, int wc, int fr, int fq) const {
        const int row0 = u.pm * BM + wr * 64 + fr, d0 = wc * 32 + 8 * fq;
#pragma unroll
        for (int ai = 0; ai < 2; ++ai)
#pragma unroll
            for (int m = 0; m < 4; ++m) {
#pragma unroll
                for (int bj = 0; bj < 2; ++bj) { const f32x4 v0 = acc[ai][bj][m][0], v1 = acc[ai][bj][m][1];
                    bf16_t* p = O + ((size_t)(2 * u.pn + bj) * Mrows + (row0 + ai * HALF + m * 16)) * 128 + d0;
                    u32x4 w; w.x = cvt_pk_bf16(v0[0], v0[1]); w.y = cvt_pk_bf16(v0[2], v0[3]); w.z = cvt_pk_bf16(v1[0], v1[1]); w.w = cvt_pk_bf16(v1[2], v1[3]);
                    *(u32x4*)p = w; } }
    }
};
struct EpiSiluBias {
    static constexpr bool PERM = true, AFTER_DRAIN = false;
    bf16_t* O; int ldc; const float* bias;
    __device__ __forceinline__ void operator()(const f32x4 (&acc)[2][2][4][2], const Unit& u, int wr, int wc, int fr, int fq) const {
        const int row0 = u.pm * BM + wr * 64 + fr, col0 = u.pn * BM + wc * 32 + 8 * fq;
        f32x4 bv[2][2];
#pragma unroll
        for (int bj = 0; bj < 2; ++bj)
#pragma unroll
            for (int n = 0; n < 2; ++n) bv[bj][n] = *(const f32x4*)(bias + col0 + bj * HALF + 4 * n);
#pragma unroll
        for (int ai = 0; ai < 2; ++ai)
#pragma unroll
            for (int m = 0; m < 4; ++m) { bf16_t* rowp = O + (size_t)(row0 + ai * HALF + m * 16) * ldc + col0;
#pragma unroll
                for (int bj = 0; bj < 2; ++bj) { const f32x4 v0 = acc[ai][bj][m][0] + bv[bj][0], v1 = acc[ai][bj][m][1] + bv[bj][1];
                    u32x4 w; w.x = cvt_pk_bf16(silu_f(v0[0]), silu_f(v0[1])); w.y = cvt_pk_bf16(silu_f(v0[2]), silu_f(v0[3])); w.z = cvt_pk_bf16(silu_f(v1[0]), silu_f(v1[1])); w.w = cvt_pk_bf16(silu_f(v1[2]), silu_f(v1[3]));
                    *(u32x4*)(rowp + bj * HALF) = w; } }
    }
};

template <class Epi, class Sched, bool STAMP = false>
__device__ __forceinline__ void gemm_phase(PG8_LAS unsigned char* lds, const Gemm g, const Sched& S, const Epi& E, unsigned long long* stamps) {
    int tid_ = threadIdx.x; asm volatile("" : "+v"(tid_));
    const int tid = tid_, wid = __builtin_amdgcn_readfirstlane(tid >> 6), lane = tid & 63, wr = wid >> 2, wc = wid & 3, fr = lane & 15, fq = lane >> 4;
    const int K = g.K, nt = K / BK;
    int ts_lo = 0, ts_hi = 0, nts = 0; const unsigned long long rt_entry = STAMP ? (unsigned long long)wall_clock64() : 0ull;
#define PG8_STAMP() do { if (STAMP && wid == 0 && nts < 64) { const unsigned long long _c = (unsigned long long)clock64(); \
        ts_lo = (lane == nts) ? (int)(unsigned)_c : ts_lo; ts_hi = (lane == nts) ? (int)(unsigned)(_c >> 32) : ts_hi; ++nts; } } while (0)
    PG8_STAMP();
    unsigned voffA[2], voffB[2];
#pragma unroll
    for (int i = 0; i < 2; ++i) { int R, C; stage_rc(tid * 16 + i * 8192, R, C); const int Rb = Epi::PERM ? ((R & ~31) + perm32(R & 31)) : R;
        voffA[i] = (unsigned)(R * g.lda + C) * 2u; voffB[i] = (unsigned)(Rb * g.ldb + C) * 2u; }
    const size_t kstep = (size_t)(BK * 2);
    const size_t hstepA = (size_t)HALF * g.lda * 2, hstepB = (size_t)HALF * g.ldb * 2;
    const size_t tstepA = 2 * hstepA, tstepB = 2 * hstepB;
    const unsigned ldsw = (unsigned)wid * 1024u;
    const int aoff = lds_byte(wr * 64 + fr, fq * 8), boff = lds_byte(wc * 32 + fr, fq * 8);
#define PG8_SA(b, h) (((b) * 2 + (h)) * HTB)
#define PG8_SB(b, h) ((4 + (b) * 2 + (h)) * HTB)
#define PG8_STAGE(bufoff, gbase, voff) do { _Pragma("unroll") for (int _i = 0; _i < 2; ++_i) \
        __builtin_amdgcn_global_load_lds((const unsigned*)((const char*)(gbase) + (voff)[_i]), (PG8_LAS unsigned*)(lds + (bufoff) + ldsw + _i * 8192), 16, 0, 0); } while (0)
#define PG8_LDA(dst, b, h) do { _Pragma("unroll") for (int m = 0; m < 4; ++m) _Pragma("unroll") for (int k = 0; k < 2; ++k) dst[m][k] = *(const PG8_LAS bf16x8*)(lds + PG8_SA(b, h) + aoff + m * 2048 + k * 1024); } while (0)
#define PG8_LDB(dst, b, h) do { _Pragma("unroll") for (int n = 0; n < 2; ++n) _Pragma("unroll") for (int k = 0; k < 2; ++k) dst[n][k] = *(const PG8_LAS bf16x8*)(lds + PG8_SB(b, h) + boff + n * 2048 + k * 1024); } while (0)
#define PG8_MMA(ai, bj, At, Bt) do { __builtin_amdgcn_s_setprio(1); _Pragma("unroll") for (int m = 0; m < 4; ++m) _Pragma("unroll") for (int n = 0; n < 2; ++n) _Pragma("unroll") for (int k = 0; k < 2; ++k) \
        acc[ai][bj][m][n] = __builtin_amdgcn_mfma_f32_16x16x32_bf16(Bt[n][k], At[m][k], acc[ai][bj][m][n], 0, 0, 0); __builtin_amdgcn_s_setprio(0); } while (0)
#define PG8_WAIT_V(n) asm volatile("s_waitcnt vmcnt(" #n ")" ::: "memory")
#define PG8_WAIT_L(n) asm volatile("s_waitcnt lgkmcnt(" #n ")" ::: "memory")
#define PG8_BAR __builtin_amdgcn_s_barrier()
#define PG8_SCHED __builtin_amdgcn_sched_barrier(0)
    Unit cur, nxt; int ui = 0;
    if (!S.next(0, cur)) return;
    f32x4 acc[2][2][4][2];
#pragma unroll
    for (int a = 0; a < 2; ++a)
#pragma unroll
        for (int b = 0; b < 2; ++b)
#pragma unroll
            for (int m = 0; m < 4; ++m)
#pragma unroll
                for (int n = 0; n < 2; ++n) acc[a][b][m][n] = (f32x4){0.f, 0.f, 0.f, 0.f};
    bf16x8 At[4][2], B0[2][2], B1[2][2];
    const char* cA = (const char*)g.A + (size_t)cur.pm * tstepA + (size_t)((cur.pn & g.amask) * g.astride) * 2; const char* cB = (const char*)g.Bt + (size_t)cur.pn * tstepB;
    S.a_ready(cur);
    PG8_STAGE(PG8_SB(0, 0), cB, voffB); PG8_STAGE(PG8_SA(0, 0), cA, voffA); PG8_STAGE(PG8_SB(0, 1), cB + hstepB, voffB); PG8_STAGE(PG8_SA(0, 1), cA + hstepA, voffA);
    if (wr == 1) PG8_BAR;
    PG8_WAIT_V(4); PG8_BAR;
    PG8_STAGE(PG8_SB(1, 0), cB + kstep, voffB); PG8_STAGE(PG8_SA(1, 0), cA + kstep, voffA); PG8_STAGE(PG8_SB(1, 1), cB + hstepB + kstep, voffB);
    PG8_WAIT_V(6); PG8_BAR;
    PG8_STAMP();
    for (;;) {
        const bool has_next = S.next(ui + 1, nxt);
        const char* nA = has_next ? (const char*)g.A + (size_t)nxt.pm * tstepA + (size_t)((nxt.pn & g.amask) * g.astride) * 2 : cA; const char* nB = has_next ? (const char*)g.Bt + (size_t)nxt.pn * tstepB : cB;
        for (int t = 0; t < nt; t += 2) {
            const bool last = (t == nt - 2);
            const char* a1 = cA + (size_t)(t + 1) * kstep;
            const char* a2 = last ? nA : cA + (size_t)(t + 2) * kstep; const char* b2 = last ? nB : cB + (size_t)(t + 2) * kstep;
            const char* a3 = a2 + kstep; const char* b3 = b2 + kstep;
            if (last && has_next) S.a_ready(nxt);
            PG8_LDB(B0, 0, 0); PG8_SCHED; PG8_LDA(At, 0, 0); PG8_STAGE(PG8_SA(1, 1), a1 + hstepA, voffA);
            PG8_WAIT_L(8); PG8_BAR; PG8_WAIT_L(0); PG8_MMA(0, 0, At, B0); PG8_BAR; PG8_SCHED;
            PG8_LDB(B1, 0, 1); PG8_STAGE(PG8_SB(0, 0), b2, voffB);
            PG8_BAR; PG8_WAIT_L(0); PG8_MMA(0, 1, At, B1); PG8_BAR;
            PG8_LDA(At, 0, 1); PG8_STAGE(PG8_SA(0, 0), a2, voffA);
            PG8_BAR; PG8_WAIT_L(0); PG8_MMA(1, 0, At, B0); PG8_BAR; PG8_SCHED;
            PG8_STAGE(PG8_SB(0, 1), b2 + hstepB, voffB);
            PG8_WAIT_V(6); PG8_BAR; PG8_MMA(1, 1, At, B1); PG8_BAR;
            PG8_LDB(B0, 1, 0); PG8_SCHED; PG8_LDA(At, 1, 0); PG8_STAGE(PG8_SA(0, 1), a2 + hstepA, voffA);
            PG8_WAIT_L(8); PG8_BAR; PG8_WAIT_L(0); PG8_MMA(0, 0, At, B0); PG8_BAR; PG8_SCHED;
            PG8_LDB(B1, 1, 1); PG8_STAGE(PG8_SB(1, 0), b3, voffB);
            PG8_BAR; PG8_WAIT_L(0); PG8_MMA(0, 1, At, B1); PG8_BAR;
            PG8_LDA(At, 1, 1); PG8_STAGE(PG8_SA(1, 0), a3, voffA);
            PG8_BAR; PG8_WAIT_L(0); PG8_MMA(1, 0, At, B0); PG8_BAR; PG8_SCHED;
            PG8_STAGE(PG8_SB(1, 1), b3 + hstepB, voffB);
            PG8_WAIT_V(6); PG8_BAR; PG8_MMA(1, 1, At, B1); PG8_BAR;
        }
        PG8_STAMP();
        if constexpr (!Epi::AFTER_DRAIN) { E(acc, cur, wr, wc, fr, fq); S.done(cur); }
        PG8_STAMP();
        if (!has_next) break;
#pragma unroll
        for (int a = 0; a < 2; ++a)
#pragma unroll
            for (int b = 0; b < 2; ++b)
#pragma unroll
                for (int m = 0; m < 4; ++m)
#pragma unroll
                    for (int n = 0; n < 2; ++n) acc[a][b][m][n] = (f32x4){0.f, 0.f, 0.f, 0.f};
        cur = nxt; cA = nA; cB = nB; ++ui;
    }
    PG8_WAIT_V(0);
    if (wr == 0) PG8_BAR;
    PG8_BAR;
    if constexpr (Epi::AFTER_DRAIN) { E.fused(acc, cur, wr, wc, fr, fq, lds, wid, lane); S.done(cur); }
    PG8_STAMP();
    if (STAMP && wid == 0) { stamps[lane] = lane < nts ? (((unsigned long long)(unsigned)ts_hi << 32) | (unsigned)ts_lo) : 0ull;
        if (lane == 62) stamps[62] = rt_entry; if (lane == 63) stamps[63] = (unsigned long long)wall_clock64(); }
#undef PG8_STAMP
#undef PG8_SA
#undef PG8_SB
#undef PG8_STAGE
#undef PG8_LDA
#undef PG8_LDB
#undef PG8_MMA
#undef PG8_WAIT_V
#undef PG8_WAIT_L
#undef PG8_BAR
#undef PG8_SCHED
}
}

using pg8::Gemm; using pg8::StaticOrder; using pg8::gemm_phase;

constexpr size_t MiB = 1u << 20;
constexpr size_t WS_CTL = 0, CTL_ZERO_BYTES = 1 * MiB;
constexpr int CW_BAR = 4096;
constexpr size_t GU_BYTES = (size_t)2 * FF * D * 2, DN_BYTES = (size_t)D * FF * 2, ABIN_BYTES = (size_t)AB_N * D * 2, SQ_BYTES = (size_t)D * D * 2, CIN_BYTES = (size_t)C_N * D * 2;
constexpr size_t CMP1_BYTES = (size_t)256 * 4096 * 2, WQK_BYTES = (size_t)2048 * 256 * 2;
constexpr size_t WS_WGU = 1 * MiB;
constexpr size_t WS_WD = WS_WGU + 8 * GU_BYTES;
constexpr size_t WS_WABIN = WS_WD + 8 * DN_BYTES;
constexpr size_t WS_WABOUT = WS_WABIN + 2 * ABIN_BYTES;
constexpr size_t WS_WCIN = WS_WABOUT + 2 * SQ_BYTES;
constexpr size_t WS_WCOUT = WS_WCIN + 2 * CIN_BYTES;
constexpr size_t WS_WCMP1 = WS_WCOUT + 2 * SQ_BYTES;
constexpr size_t WS_WQK = WS_WCMP1 + 4 * CMP1_BYTES;
constexpr int ROPE_ROWS = 8208;
constexpr size_t WS_ROPE = WS_WQK + 2 * WQK_BYTES;
constexpr size_t WS_CB = WS_ROPE + 5 * MiB;
constexpr size_t WS_HN = WS_CB + 1 * MiB;
constexpr size_t WS_ACT = WS_HN + 64 * MiB;
constexpr size_t WS_MIX = WS_ACT + 224 * MiB;
constexpr size_t MX_C = 0, MX_QK = 32 * MiB, MX_HM = 96 * MiB, MX_O2 = 160 * MiB, MX_GIF = 224 * MiB, MX_Y = 225 * MiB;
constexpr size_t MX_GP = 0, MX_HID = 4 * MiB, MX_KCMP = 8 * MiB, MX_VCMP = 9 * MiB, MX_O = 225 * MiB;
constexpr size_t WS_END = WS_MIX + 290 * MiB;
static_assert(WS_ROPE + (size_t)ROPE_ROWS * 64 * 2 * 4 <= WS_CB, "rope table");

constexpr int NWAVES = 8, NTHREADS = 512;
constexpr int LDS_BYTES = 147456;
constexpr int RING_BYTES = 131072, MISC_OFF = RING_BYTES + 320;

struct Args { const float* in[31]; float* out; unsigned char* ws; int ph_lo, ph_hi; };
static_assert(sizeof(Args) == 31 * 8 + 8 + 8 + 8, "Args has no padding");

typedef const Args __attribute__((address_space(4)))* CArgsP;
struct Frame {
    LAS unsigned char* lds;
    int tid, lane, wave, G, bx, gw, NGW;
};
__device__ __forceinline__ Frame make_frame(unsigned char* lds_raw) {
    Frame F; int tid = threadIdx.x, bx = blockIdx.x, G = gridDim.x;
    asm volatile("" : "+v"(tid)); asm volatile("" : "+s"(bx)); asm volatile("" : "+s"(G));
    F.lds = (LAS unsigned char*)lds_raw; F.tid = tid; F.lane = tid & 63; F.wave = __builtin_amdgcn_readfirstlane(tid >> 6);
    F.G = G; F.bx = bx; F.gw = bx * NWAVES + F.wave; F.NGW = G * NWAVES;
    return F;
}
__device__ __forceinline__ CArgsP get_args() { CArgsP p = (CArgsP)__builtin_amdgcn_kernarg_segment_ptr(); asm volatile("" : "+s"(p)); return p; }
#define LDS_WAIT() asm volatile("s_waitcnt lgkmcnt(0)" ::: "memory")

struct Job { const float* src; int ldn, K, col0, ncols; bf16_t* dst; int dst_ld, row0, mode; float scale; };
constexpr int NJOBS = 64;
__device__ __forceinline__ Job make_job(int j, CArgsP ap) {
    Job J; J.scale = 1.0f; J.row0 = 0; J.mode = 0; J.col0 = 0;
    unsigned char* ws = ap->ws;
    if (j < 24) { const int f = j / 3, kind = j % 3, layer = f >> 1, half = f & 1;
        if (kind < 2) { J.src = ap->in[(half ? 7 : 2) + kind] + (size_t)layer * D * FF; J.ldn = FF; J.K = D; J.ncols = FF; J.dst = (bf16_t*)(ws + WS_WGU + (size_t)f * GU_BYTES); J.dst_ld = D; J.mode = 1 + kind; }
        else { J.src = ap->in[half ? 9 : 4] + (size_t)layer * FF * D; J.ldn = D; J.K = FF; J.ncols = D; J.dst = (bf16_t*)(ws + WS_WD + (size_t)f * DN_BYTES); J.dst_ld = FF; }
    } else if (j < 38) { const int q = j - 24, l = q / 7, seg = q % 7;
        J.src = ap->in[10] + (size_t)l * D * AB_COLS; J.ldn = AB_COLS; J.K = D; J.col0 = seg < 3 ? seg * 1024 : 3080 + (seg - 3) * 1024; J.ncols = 1024;
        J.dst = (bf16_t*)(ws + WS_WABIN + (size_t)l * ABIN_BYTES); J.dst_ld = D; J.row0 = seg * 1024;
    } else if (j < 40) { const int l = j - 38; J.src = ap->in[11] + (size_t)l * D * D; J.ldn = D; J.K = D; J.ncols = D; J.dst = (bf16_t*)(ws + WS_WABOUT + (size_t)l * SQ_BYTES); J.dst_ld = D;
    } else if (j < 42) { const int l = j - 40; J.src = ap->in[22] + (size_t)l * D * C_COLS; J.ldn = C_COLS; J.K = D; J.ncols = C_N; J.dst = (bf16_t*)(ws + WS_WCIN + (size_t)l * CIN_BYTES); J.dst_ld = D;
    } else if (j < 44) { const int l = j - 42; J.src = ap->in[23] + (size_t)l * D * D; J.ldn = D; J.K = D; J.ncols = D; J.dst = (bf16_t*)(ws + WS_WCOUT + (size_t)l * SQ_BYTES); J.dst_ld = D;
    } else if (j < 48) { const int q = j - 44; J.src = ap->in[27] + (size_t)q * 4096 * 256; J.ldn = 256; J.K = 4096; J.ncols = 256; J.dst = (bf16_t*)(ws + WS_WCMP1 + (size_t)q * CMP1_BYTES); J.dst_ld = 4096;
    } else { const int q = j - 48, l = q / 8, r = q % 8, isk = r / 4, hh = r % 4;
        J.src = ap->in[isk ? 15 : 14] + (size_t)(l * 4 + hh) * 65536; J.ldn = 256; J.K = 256; J.ncols = 256; J.dst = (bf16_t*)(ws + WS_WQK + (size_t)l * WQK_BYTES); J.dst_ld = 256; J.row0 = isk * 1024 + hh * 256; J.scale = isk ? 0.0625f : 1.0f; }
    return J;
}
__device__ __forceinline__ void transpose_item(const Job& J, LAS float* scr, int item, int lane) {
    const int nblk = J.ncols / 32, kb = item / nblk, nb = item % nblk, k0 = 64 * kb, n0 = 32 * nb;
    const float* W = J.src + J.col0 + n0;
#pragma unroll 8
    for (int i = 0; i < 32; ++i) { const int kk = 2 * i + (lane >> 5); scr[kk * 33 + (lane & 31)] = W[(size_t)(k0 + kk) * J.ldn + (lane & 31)]; }
    LDS_WAIT();
    const int c = lane & 7;
    const int drow0 = J.mode == 0 ? J.row0 + n0 : (n0 >> 7) * 256 + (n0 & 127) + (J.mode == 2 ? 128 : 0);
    const float sc = J.scale;
#pragma unroll
    for (int jj = 0; jj < 4; ++jj) { const int n = (lane >> 3) + 8 * jj; const LAS float* s = scr + (8 * c) * 33 + n;
        v4u o; o.x = pk2(s[0 * 33] * sc, s[1 * 33] * sc); o.y = pk2(s[2 * 33] * sc, s[3 * 33] * sc); o.z = pk2(s[4 * 33] * sc, s[5 * 33] * sc); o.w = pk2(s[6 * 33] * sc, s[7 * 33] * sc);
        *(v4u*)(J.dst + (size_t)(drow0 + n) * J.dst_ld + k0 + 8 * c) = o; }
    LDS_WAIT();
}
__device__ __forceinline__ void ph_prologue(Frame& F, CArgsP ap) {
    LAS float* scr = (LAS float*)(F.lds + F.wave * 16384);
    for (int j = 0; j < NJOBS; ++j) {
        const Job J = make_job(j, ap);
        const int nitems = (J.K / 64) * (J.ncols / 32);
        for (int it = F.gw; it < nitems; it += F.NGW) transpose_item(J, scr, it, F.lane);
    }
    float* rope = (float*)(ap->ws + WS_ROPE);
    for (int idx = F.bx * NTHREADS + F.tid; idx < ROPE_ROWS * 64; idx += F.G * NTHREADS) {
        const int p = idx >> 6, i = idx & 63;
        const float inv = powf(10000.0f, -(float)i / 64.0f), ang = (float)p * inv;
        float sn, cs; sincosf(ang, &sn, &cs);
        rope[2 * idx] = cs; rope[2 * idx + 1] = sn;
    }
    float* cb = (float*)(ap->ws + WS_CB);
    for (int idx = F.bx * NTHREADS + F.tid; idx < 4 * 256; idx += F.G * NTHREADS) {
        const int q = idx >> 8, c = idx & 255;
        const float* pos = ap->in[26] + (size_t)q * 4096; const float* w1 = ap->in[27] + (size_t)q * 4096 * 256 + c;
        float s = 0.f;
        for (int f = 0; f < 4096; ++f) s += pos[f] * w1[(size_t)f * 256];
        cb[idx] = s + ap->in[28][idx];
    }
    { const f32x4* x = (const f32x4*)ap->in[0]; f32x4* o = (f32x4*)ap->out;
      for (size_t i = (size_t)F.bx * NTHREADS + F.tid; i < (size_t)T * D / 4; i += (size_t)F.G * NTHREADS) o[i] = x[i]; }
}

template <int NJ>
__device__ __forceinline__ void ph_norm(Frame& F, const float* h, const float* w, bf16_t* hn, const float* Wp, int ldw, int col0, float* outp) {
    LAS float* xs = (LAS float*)F.lds;
    LAS float* rs = xs + 8 * 2048;
    LAS float* red = rs + 64;
    for (int g = F.bx; g < T / 8; g += F.G) {
        const int row = g * 8 + F.wave;
        const f32x4* xr = (const f32x4*)(h + (size_t)row * D) + F.lane;
        const f32x4* wv = (const f32x4*)w + F.lane;
        f32x4 v[8]; float s = 0.f;
#pragma unroll
        for (int j = 0; j < 8; ++j) { v[j] = xr[64 * j]; s += (v[j].x * v[j].x + v[j].y * v[j].y) + (v[j].z * v[j].z + v[j].w * v[j].w); }
        s = wave_sum(s);
        const float rstd = 1.0f / sqrtf(s * (1.0f / D) + NORM_EPS);
        v2u* o8 = (v2u*)(hn + (size_t)row * D) + F.lane;
#pragma unroll
        for (int j = 0; j < 8; ++j) { const f32x4 xw = v[j] * wv[64 * j];
            v2u o; o.x = pk2(xw.x * rstd, xw.y * rstd); o.y = pk2(xw.z * rstd, xw.w * rstd); o8[64 * j] = o;
            if (NJ > 0) *(LAS f32x4*)(xs + F.wave * 2048 + 4 * (F.lane + 64 * j)) = xw; }
        if (NJ > 0) {
            if (F.lane == 0) rs[F.wave] = rstd;
            __syncthreads();
            float acc[8];
#pragma unroll
            for (int r = 0; r < 8; ++r) acc[r] = 0.f;
            if (F.lane < NJ) {
                const float* wp = Wp + col0 + F.lane;
                for (int k = 256 * F.wave; k < 256 * F.wave + 256; ++k) { const float wk = wp[(size_t)k * ldw];
#pragma unroll
                    for (int r = 0; r < 8; ++r) acc[r] += xs[r * 2048 + k] * wk; }
            }
#pragma unroll
            for (int r = 0; r < 8; ++r) red[(F.wave * 8 + r) * 64 + F.lane] = acc[r];
            __syncthreads();
            if (F.lane < NJ) { float t = 0.f;
#pragma unroll
                for (int ww = 0; ww < 8; ++ww) t += red[(ww * 8 + F.wave) * 64 + F.lane];
                outp[(size_t)(g * 8 + F.wave) * NJ + F.lane] = t * rs[F.wave]; }
            __syncthreads();
        }
    }
}

__device__ __forceinline__ void unpack8(const v4u u, float (&f)[8]) { f[0] = bflo(u.x); f[1] = bfhi(u.x); f[2] = bflo(u.y); f[3] = bfhi(u.y); f[4] = bflo(u.z); f[5] = bfhi(u.z); f[6] = bflo(u.w); f[7] = bfhi(u.w); }
__device__ __forceinline__ void ph_conv(Frame& F, const bf16_t* P, const float* cw, const float* cbias, bf16_t* cbuf) {
    for (int idx = F.bx * NTHREADS + F.tid; idx < T * 128; idx += F.G * NTHREADS) {
        const int t = idx >> 7, c0 = (idx & 127) * 8, tl = t & (SEQ - 1);
        float acc[8];
#pragma unroll
        for (int e = 0; e < 8; ++e) acc[e] = cbias[c0 + e];
#pragma unroll
        for (int jj = 0; jj < 4; ++jj) { if (tl - 3 + jj >= 0) { float uf[8]; unpack8(*(const v4u*)(P + (size_t)(t - 3 + jj) * AB_N + c0), uf);
#pragma unroll
                for (int e = 0; e < 8; ++e) acc[e] += uf[e] * cw[jj * 1024 + c0 + e]; } }
        v4u o; o.x = pk2(siluf_(acc[0]), siluf_(acc[1])); o.y = pk2(siluf_(acc[2]), siluf_(acc[3])); o.z = pk2(siluf_(acc[4]), siluf_(acc[5])); o.w = pk2(siluf_(acc[6]), siluf_(acc[7]));
        *(v4u*)(cbuf + (size_t)t * 1024 + c0) = o;
    }
}
__device__ __forceinline__ float log_sigmoid_(float x) { return fminf(x, 0.f) - log1pf(expf(-fabsf(x))); }

__device__ __forceinline__ void ph_recurrent(Frame& F, const bf16_t* P, const bf16_t* qk, const float* gif, const float* i_bias, const float* f_bias, const float* lb_logits, int jpair, float* hm, float* o2) {
    constexpr int TC = 32;
    const int grp = F.lane >> 4, ks = F.lane & 15;
    for (int vb = F.bx; vb < 128; vb += F.G) {
        if (vb < 64) {
            const int bh = vb >> 3, b = bh >> 2, hh = bh & 3, r0 = (vb & 7) * 32, rl = F.wave * 4 + grp;
            LAS float* qs = (LAS float*)F.lds;
            LAS float* kss = qs + TC * 256;
            LAS float* vs = kss + TC * 256;
            LAS float* is = vs + TC * 32;
            LAS float* fs = is + TC;
            float C[16], n[16], m = 0.f;
#pragma unroll
            for (int e = 0; e < 16; ++e) { C[e] = 0.f; n[e] = 0.f; }
            const float ib = i_bias[hh], fb = f_bias[hh];
            for (int ch = 0; ch < SEQ / TC; ++ch) {
                const int tok0 = b * SEQ + ch * TC;
                { const int tt = F.tid >> 4, seg = F.tid & 15;
                  const bf16_t* qp = qk + (size_t)(tok0 + tt) * 2048 + hh * 256 + seg * 16;
                  float f0[8], f1[8];
                  unpack8(*(const v4u*)qp, f0); unpack8(*(const v4u*)(qp + 8), f1);
#pragma unroll
                  for (int e = 0; e < 8; ++e) { qs[tt * 256 + seg * 16 + e] = f0[e]; qs[tt * 256 + seg * 16 + 8 + e] = f1[e]; }
                  unpack8(*(const v4u*)(qp + 1024), f0); unpack8(*(const v4u*)(qp + 1024 + 8), f1);
#pragma unroll
                  for (int e = 0; e < 8; ++e) { kss[tt * 256 + seg * 16 + e] = f0[e]; kss[tt * 256 + seg * 16 + 8 + e] = f1[e]; }
#pragma unroll
                  for (int rep = 0; rep < 2; ++rep) { const int id = F.tid + rep * NTHREADS, t2 = id >> 5, rr = id & 31;
                      vs[t2 * 32 + rr] = bf2f(P[(size_t)(tok0 + t2) * AB_N + 1024 + hh * 256 + r0 + rr]); }
                  if (F.tid < TC) { is[F.tid] = gif[(size_t)(tok0 + F.tid) * 8 + hh] + ib; fs[F.tid] = log_sigmoid_(gif[(size_t)(tok0 + F.tid) * 8 + 4 + hh] + fb); }
                }
                __syncthreads();
                for (int tt = 0; tt < TC; ++tt) {
                    const float ig = is[tt], lf = fs[tt];
                    const float m_new = fmaxf(lf + m, ig), a = expf(lf + m - m_new), bc = expf(ig - m_new);
                    const float vv = vs[tt * 32 + rl] * bc;
                    float num = 0.f, dn = 0.f;
#pragma unroll
                    for (int e4 = 0; e4 < 4; ++e4) { const f32x4 k4 = *(const LAS f32x4*)(kss + tt * 256 + ks * 16 + e4 * 4), q4 = *(const LAS f32x4*)(qs + tt * 256 + ks * 16 + e4 * 4);
#pragma unroll
                        for (int e = 0; e < 4; ++e) { const int i = e4 * 4 + e; C[i] = a * C[i] + vv * k4[e]; n[i] = a * n[i] + bc * k4[e]; num += C[i] * q4[e]; dn += n[i] * q4[e]; } }
                    num = row16_sum(num); dn = row16_sum(dn);
                    m = m_new;
                    if (ks == 0) hm[(size_t)(tok0 + tt) * 1024 + hh * 256 + r0 + rl] = num / fmaxf(fabsf(dn), expf(-m_new));
                }
                __syncthreads();
            }
        } else {
            const int ix = vb - 64, bh = ix >> 2, b = bh >> 3, hh = bh & 7, c0 = (ix & 3) * 32, cl = F.wave * 4 + grp;
            LAS float* qs = (LAS float*)F.lds;
            LAS float* kss = qs + TC * 128;
            LAS float* fss = kss + TC * 128;
            LAS float* vs = fss + TC * 128;
            float S[8];
#pragma unroll
            for (int e = 0; e < 8; ++e) S[e] = 0.f;
            for (int ch = 0; ch < SEQ / TC; ++ch) {
                const int tok0 = b * SEQ + ch * TC;
                { const int tt = F.tid >> 4, seg = F.tid & 15;
                  const bf16_t* pp = P + (size_t)(tok0 + tt) * AB_N + hh * 128 + seg * 8;
                  float hq[8], hf[8];
                  unpack8(*(const v4u*)(pp + 3072), hq); unpack8(*(const v4u*)(pp + 4096), hf);
#pragma unroll
                  for (int e = 0; e < 8; ++e) { const int cg = hh * 128 + seg * 8 + e;
                      const float lbv = jpair == 0 ? 0.f : sigmoidf_(lb_logits[1024 + cg] - lb_logits[cg]);
                      const float z = hf[e], k2 = (1.0f - lbv) * (1.0f / (1.0f + expf(z)));
                      const float lf = fmaxf(log1pf(-fminf(k2, 0.999999f)), log_sigmoid_(z));
                      qs[tt * 128 + seg * 8 + e] = hq[e] / (1.0f + expf(-hq[e])); kss[tt * 128 + seg * 8 + e] = k2; fss[tt * 128 + seg * 8 + e] = expf(lf); }
#pragma unroll
                  for (int rep = 0; rep < 2; ++rep) { const int id = F.tid + rep * NTHREADS, t2 = id >> 5, rr = id & 31;
                      vs[t2 * 32 + rr] = bf2f(P[(size_t)(tok0 + t2) * AB_N + 5120 + hh * 128 + c0 + rr]); }
                }
                __syncthreads();
                for (int tt = 0; tt < TC; ++tt) {
                    const float vv = vs[tt * 32 + cl];
                    float o = 0.f;
#pragma unroll
                    for (int e4 = 0; e4 < 2; ++e4) { const f32x4 k4 = *(const LAS f32x4*)(kss + tt * 128 + ks * 8 + e4 * 4), q4 = *(const LAS f32x4*)(qs + tt * 128 + ks * 8 + e4 * 4), f4 = *(const LAS f32x4*)(fss + tt * 128 + ks * 8 + e4 * 4);
#pragma unroll
                        for (int e = 0; e < 4; ++e) { const int i = e4 * 4 + e; S[i] = f4[e] * S[i] + k4[e] * vv; o += S[i] * q4[e]; } }
                    o = row16_sum(o);
                    if (ks == 0) o2[(size_t)(tok0 + tt) * 1024 + hh * 128 + c0 + cl] = o;
                }
                __syncthreads();
            }
        }
    }
}
__device__ __forceinline__ void ph_ab_final(Frame& F, const bf16_t* P, const bf16_t* cbuf, const float* hm, const float* o2, const float* ml_norm, const float* ml_skip, const float* hg_norm, bf16_t* Y) {
    for (int t = F.gw; t < T; t += F.NGW) {
#pragma unroll
        for (int hh = 0; hh < 4; ++hh) { const int col = hh * 256 + 4 * F.lane;
            const f32x4 x = *(const f32x4*)(hm + (size_t)t * 1024 + col);
            const float ss = wave_sum((x.x * x.x + x.y * x.y) + (x.z * x.z + x.w * x.w));
            const float rstd = 1.0f / sqrtf(ss * (1.0f / 256.0f) + NORM_EPS);
            const f32x4 g = *(const f32x4*)(ml_norm + col), sk = *(const f32x4*)(ml_skip + col);
            const v2u cu = *(const v2u*)(cbuf + (size_t)t * 1024 + col), ou = *(const v2u*)(P + (size_t)t * AB_N + 2048 + col);
            const float c0 = bflo(cu.x), c1 = bfhi(cu.x), c2 = bflo(cu.y), c3 = bfhi(cu.y);
            const float r0 = sigmoidf_(bflo(ou.x)) * (x.x * rstd * g.x + sk.x * c0), r1 = sigmoidf_(bfhi(ou.x)) * (x.y * rstd * g.y + sk.y * c1);
            const float r2 = sigmoidf_(bflo(ou.y)) * (x.z * rstd * g.z + sk.z * c2), r3 = sigmoidf_(bfhi(ou.y)) * (x.w * rstd * g.w + sk.w * c3);
            v2u o; o.x = pk2(r0, r1); o.y = pk2(r2, r3); *(v2u*)(Y + (size_t)t * 2048 + col) = o; }
#pragma unroll
        for (int hh = 0; hh < 8; ++hh) { const int col = hh * 128 + 2 * F.lane;
            const f32x2 x = *(const f32x2*)(o2 + (size_t)t * 1024 + col);
            const float ss = wave_sum(x.x * x.x + x.y * x.y);
            const float rstd = 1.0f / sqrtf(ss * (1.0f / 128.0f) + NORM_EPS);
            const f32x2 g = *(const f32x2*)(hg_norm + col);
            const unsigned gu = *(const unsigned*)(P + (size_t)t * AB_N + 6144 + col);
            const float r0 = x.x * rstd * g.x * siluf_(bflo(gu)), r1 = x.y * rstd * g.y * siluf_(bfhi(gu));
            *(unsigned*)(Y + (size_t)t * 2048 + 1024 + col) = pk2(r0, r1); }
    }
}

__device__ __forceinline__ void ph_qknorm_rope(Frame& F, bf16_t* slots, const float* q_norm, const float* k_norm, const float* rope) {
    for (int item = F.gw; item < 24 * T; item += F.NGW) {
        const int sl = item / T, m = item - sl * T, pos = m & (SEQ - 1);
        const int slot = sl < 16 ? sl : (sl < 20 ? 24 + (sl - 16) : 32 + (sl - 20));
        const float* w = sl < 16 ? q_norm : (sl < 20 ? k_norm + 128 : k_norm + 256);
        bf16_t* p = slots + ((size_t)slot * T + m) * 128;
        const float x1 = bf2f(p[F.lane]), x2 = bf2f(p[64 + F.lane]);
        const float rstd = 1.0f / sqrtf(wave_sum(x1 * x1 + x2 * x2) * (1.0f / 128.0f) + NORM_EPS);
        const float a = x1 * rstd * w[F.lane], b = x2 * rstd * w[64 + F.lane];
        const f32x2 cs = *(const f32x2*)(rope + ((size_t)pos * 64 + F.lane) * 2);
        p[F.lane] = (bf16_t)f2bf(a * cs.x - b * cs.y); p[64 + F.lane] = (bf16_t)f2bf(b * cs.x + a * cs.y);
    }
}
__device__ __forceinline__ void ph_compress2(Frame& F, const bf16_t* hid, const float* w2  , const float* k_norm0, const float* rope, bf16_t* kcmp, bf16_t* vcmp) {
    for (int item = F.gw; item < 2 * 4096; item += F.NGW) {
        const int kv = item >> 12, r = item & 4095;
        const v2u hu = *(const v2u*)(hid + ((size_t)kv * 4096 + r) * 256 + 4 * F.lane);
        const float h0 = bflo(hu.x), h1 = bfhi(hu.x), h2 = bflo(hu.y), h3 = bfhi(hu.y);
        const float* w = w2 + (size_t)kv * 256 * 128;
        float a0 = 0.f, a1 = 0.f;
        for (int c4 = 0; c4 < 64; ++c4) {
            const float x0 = __builtin_bit_cast(float, __builtin_amdgcn_readlane(__builtin_bit_cast(int, h0), c4)), x1 = __builtin_bit_cast(float, __builtin_amdgcn_readlane(__builtin_bit_cast(int, h1), c4));
            const float x2 = __builtin_bit_cast(float, __builtin_amdgcn_readlane(__builtin_bit_cast(int, h2), c4)), x3 = __builtin_bit_cast(float, __builtin_amdgcn_readlane(__builtin_bit_cast(int, h3), c4));
            const float* wr = w + (size_t)(4 * c4) * 128 + F.lane;
            a0 += x0 * wr[0] + x1 * wr[128] + x2 * wr[256] + x3 * wr[384];
            a1 += x0 * wr[64] + x1 * wr[192] + x2 * wr[320] + x3 * wr[448];
        }
        if (kv == 0) {
            const float rstd = 1.0f / sqrtf(wave_sum(a0 * a0 + a1 * a1) * (1.0f / 128.0f) + NORM_EPS);
            const float a = a0 * rstd * k_norm0[F.lane], b = a1 * rstd * k_norm0[64 + F.lane];
            const int pos = 16 * (r & 511) + 31;
            const f32x2 cs = *(const f32x2*)(rope + ((size_t)pos * 64 + F.lane) * 2);
            kcmp[(size_t)r * 128 + F.lane] = (bf16_t)f2bf(a * cs.x - b * cs.y); kcmp[(size_t)r * 128 + 64 + F.lane] = (bf16_t)f2bf(b * cs.x + a * cs.y);
        } else { vcmp[(size_t)r * 128 + F.lane] = (bf16_t)f2bf(a0); vcmp[(size_t)r * 128 + 64 + F.lane] = (bf16_t)f2bf(a1); }
    }
}
__device__ __forceinline__ void dot4(const LAS float* qs, const bf16_t* krow, float (&s)[4]) {
    s[0] = s[1] = s[2] = s[3] = 0.f;
#pragma unroll 4
    for (int c = 0; c < 16; ++c) { float kf[8]; unpack8(*(const v4u*)(krow + 8 * c), kf);
#pragma unroll
        for (int r = 0; r < 4; ++r) { const f32x4 qa = *(const LAS f32x4*)(qs + r * 128 + 8 * c), qb = *(const LAS f32x4*)(qs + r * 128 + 8 * c + 4);
            s[r] += (kf[0] * qa.x + kf[1] * qa.y) + (kf[2] * qa.z + kf[3] * qa.w) + (kf[4] * qb.x + kf[5] * qb.y) + (kf[6] * qb.z + kf[7] * qb.w); } }
}
struct SoftAcc { float m[4], l[4], a0[4], a1[4]; };
__device__ __forceinline__ void attn_tile(const LAS float* qs, LAS float* pb, const bf16_t* krow, const bf16_t* vtile, bool valid, float scale, int lane, SoftAcc& A) {
    float s[4]; dot4(qs, krow, s);
#pragma unroll
    for (int r = 0; r < 4; ++r) {
        const float sv = valid ? s[r] * scale : -INFINITY;
        const float m_new = fmaxf(A.m[r], wave_max(sv));
        const float corr = __expf(A.m[r] - m_new), p = valid ? __expf(sv - m_new) : 0.f;
        A.l[r] = A.l[r] * corr + wave_sum(p); A.a0[r] *= corr; A.a1[r] *= corr; A.m[r] = m_new;
        pb[r * 64 + lane] = p;
    }
    LDS_WAIT();
    for (int kk = 0; kk < 64; ++kk) { const unsigned vv = *(const unsigned*)(vtile + (size_t)kk * 128 + 2 * lane); const float v0 = bflo(vv), v1 = bfhi(vv);
#pragma unroll
        for (int r = 0; r < 4; ++r) { const float p = pb[r * 64 + kk]; A.a0[r] += p * v0; A.a1[r] += p * v1; } }
    LDS_WAIT();
}
__device__ __forceinline__ void ph_attn_naive(Frame& F, const bf16_t* slots, const float* gp, const float* gbias, const bf16_t* kcmp, const bf16_t* vcmp, bf16_t* O) {
    const float scale = 0.08838834764831845f;
    const int lane = F.lane;
    LAS float* qs = (LAS float*)(F.lds + F.wave * 12288);
    LAS float* sc = qs + 512;
    LAS float* pb = sc + 2048;
    for (int item = F.gw; item < BATCH * 4 * SEQ; item += F.NGW) {
        const int bg = item & 7, t = item >> 3, b = bg >> 2, g = bg & 3, m = b * SEQ + t;
#pragma unroll
        for (int r = 0; r < 4; ++r) { const bf16_t* qp = slots + ((size_t)(g * 4 + r) * T + m) * 128; qs[r * 128 + lane] = bf2f(qp[lane]); qs[r * 128 + 64 + lane] = bf2f(qp[64 + lane]); }
        LDS_WAIT();
        const int nv = t >= 31 ? ((t - 31) >> 4) + 1 : 0;
        const bf16_t* kc = kcmp + (size_t)(g * 1024 + b * 512) * 128; const bf16_t* vc = vcmp + (size_t)(g * 1024 + b * 512) * 128;
        float mx[4] = {-INFINITY, -INFINITY, -INFINITY, -INFINITY};
        for (int n0 = 0; n0 < nv; n0 += 64) { const int n = n0 + lane; if (n < nv) { float s[4]; dot4(qs, kc + (size_t)n * 128, s);
#pragma unroll
                for (int r = 0; r < 4; ++r) { s[r] *= scale; sc[r * 512 + n] = s[r]; mx[r] = fmaxf(mx[r], s[r]); } } }
        float inv[4];
#pragma unroll
        for (int r = 0; r < 4; ++r) mx[r] = wave_max(mx[r]);
        { float sm[4] = {0.f, 0.f, 0.f, 0.f};
          for (int n0 = 0; n0 < nv; n0 += 64) { const int n = n0 + lane; if (n < nv) {
#pragma unroll
                  for (int r = 0; r < 4; ++r) { const float e = __expf(sc[r * 512 + n] - mx[r]); sc[r * 512 + n] = e; sm[r] += e; } } }
#pragma unroll
          for (int r = 0; r < 4; ++r) { sm[r] = wave_sum(sm[r]); inv[r] = sm[r] > 0.f ? 1.0f / sm[r] : 0.f; } }
        LDS_WAIT();
        float oc0[4] = {0.f, 0.f, 0.f, 0.f}, oc1[4] = {0.f, 0.f, 0.f, 0.f};
        for (int n = 0; n < nv; ++n) { const unsigned vv = *(const unsigned*)(vc + (size_t)n * 128 + 2 * lane); const float v0 = bflo(vv), v1 = bfhi(vv);
#pragma unroll
            for (int r = 0; r < 4; ++r) { const float p = sc[r * 512 + n]; oc0[r] += p * v0; oc1[r] += p * v1; } }
#pragma unroll
        for (int r = 0; r < 4; ++r) { oc0[r] *= inv[r]; oc1[r] *= inv[r]; }
        const int cur = t >> 6;
        float iv0, iv1;
        { float im[2];
#pragma unroll
          for (int h2 = 0; h2 < 2; ++h2) { const int s = lane + 64 * h2; float acc = 0.f;
              const int lo = 4 * s - 1 < 0 ? 0 : 4 * s - 1, hi = 4 * s + 3 < nv - 1 ? 4 * s + 3 : nv - 1;
              for (int n = lo; n <= hi; ++n) acc += (sc[n] * inv[0] + sc[512 + n] * inv[1]) + (sc[1024 + n] * inv[2] + sc[1536 + n] * inv[3]);
              const bool forced = (s == 0) || (s == cur) || (s == cur - 1);
              im[h2] = s <= cur ? acc + (forced ? 1e4f : 0.f) : -1e30f; }
          iv0 = im[0]; iv1 = im[1]; }
        int myidx = 0;
        for (int k = 0; k < 16; ++k) {
            float bv = iv0; int bi = lane; if (iv1 > bv) { bv = iv1; bi = lane + 64; }
#pragma unroll
            for (int o = 1; o < 64; o <<= 1) { const float ov = __shfl_xor(bv, o); const int oi = __shfl_xor(bi, o); if (ov > bv || (ov == bv && oi < bi)) { bv = ov; bi = oi; } }
            if (lane == k) myidx = bi;
            if (bi == lane) iv0 = -INFINITY; if (bi == lane + 64) iv1 = -INFINITY;
        }
        SoftAcc S;
#pragma unroll
        for (int r = 0; r < 4; ++r) { S.m[r] = -INFINITY; S.l[r] = 0.f; S.a0[r] = 0.f; S.a1[r] = 0.f; }
        const bf16_t* ksel = slots + ((size_t)(24 + g) * T + b * SEQ) * 128; const bf16_t* vsel = slots + ((size_t)(28 + g) * T + b * SEQ) * 128;
        for (int k = 0; k < 16; ++k) { const int blk = __builtin_amdgcn_readlane(myidx, k); if (blk * 64 > t) continue;
            const int key = blk * 64 + lane;
            attn_tile(qs, pb, ksel + (size_t)key * 128, vsel + (size_t)blk * 64 * 128, key <= t, scale, lane, S); }
        SoftAcc W;
#pragma unroll
        for (int r = 0; r < 4; ++r) { W.m[r] = -INFINITY; W.l[r] = 0.f; W.a0[r] = 0.f; W.a1[r] = 0.f; }
        const bf16_t* kwin = slots + ((size_t)(32 + g) * T + b * SEQ) * 128; const bf16_t* vwin = slots + ((size_t)(36 + g) * T + b * SEQ) * 128;
        for (int k0 = t - 511 < 0 ? 0 : t - 511; k0 <= t; k0 += 64) { const int key = k0 + lane; const int kr = key < SEQ ? key : SEQ - 1;
            attn_tile(qs, pb, kwin + (size_t)kr * 128, vwin + (size_t)k0 * 128, key <= t, scale, lane, W); }
#pragma unroll
        for (int r = 0; r < 4; ++r) { const int hd = g * 4 + r;
            const float g0 = sigmoidf_(gp[(size_t)m * 48 + hd * 3 + 0] + gbias[hd * 3 + 0]), g1 = sigmoidf_(gp[(size_t)m * 48 + hd * 3 + 1] + gbias[hd * 3 + 1]), g2 = sigmoidf_(gp[(size_t)m * 48 + hd * 3 + 2] + gbias[hd * 3 + 2]);
            const float is = 1.0f / S.l[r], iw = 1.0f / W.l[r];
            const float r0 = g0 * oc0[r] + g1 * S.a0[r] * is + g2 * W.a0[r] * iw, r1 = g0 * oc1[r] + g1 * S.a1[r] * is + g2 * W.a1[r] * iw;
            *(unsigned*)(O + (size_t)m * 2048 + hd * 128 + 2 * lane) = pk2(r0, r1); }
    }
}

#ifndef MK_MULTI_LAUNCH
#define MK_MULTI_LAUNCH 1
#endif
constexpr int NPS = 7, NSLOTS_PH = 1 + 12 * NPS;
__global__ void __launch_bounds__(NTHREADS, 2) fwd_kernel(Args a) {
    extern __shared__ __attribute__((aligned(16))) unsigned char lds_raw[];
    volatile LAS unsigned* MISC = (volatile LAS unsigned*)((LAS unsigned char*)lds_raw + MISC_OFF);
    if (threadIdx.x < 32) MISC[threadIdx.x] = 0u;
    __syncthreads();
    const int lo = a.ph_lo, hi = a.ph_hi;
    const bool use_bar = (hi - lo) > 1;
    XcdBarrier bar; bar.bar = (unsigned*)(a.ws + WS_CTL) + CW_BAR; bar.x = 0; bar.st = MISC + 8;
    if (use_bar) bar = xcd_barrier_post((unsigned*)(a.ws + WS_CTL) + CW_BAR, MISC + 8);
#define IN(k) (lo <= (k) && (k) < hi)
#define SEAM(k) do { if (IN((k) + 1) && use_bar) xcd_barrier(bar); } while (0)
#define PH_ENTER() Frame F = make_frame(lds_raw); CArgsP ap = get_args(); unsigned char* ws = ap->ws; float* h = ap->out; bf16_t* HN = (bf16_t*)(ws + WS_HN); bf16_t* ACT = (bf16_t*)(ws + WS_ACT); (void)h; (void)HN; (void)ACT

    if (IN(0)) { PH_ENTER(); ph_prologue(F, ap); }
    SEAM(0);

    for (int step = 0; step < 12; ++step) {
        const int layer = step / 3, sub = step - 3 * layer, base = 1 + NPS * step, jp = layer >> 1;
        if (sub != 1) {
            const int half = sub >> 1, f = layer * 2 + half;
            if (IN(base + 0)) { PH_ENTER(); ph_norm<0>(F, h, ap->in[half ? 6 : 1] + (size_t)layer * D, HN, nullptr, 0, 0, nullptr); }
            SEAM(base + 0);
            if (IN(base + 1)) { PH_ENTER(); Gemm g{HN, (const bf16_t*)(ws + WS_WGU + (size_t)f * GU_BYTES), T, 2 * FF, D, D, D, 0, 0}; StaticOrder S; S.init(T, 2 * FF, F.G, F.bx);
                pg8::EpiSwiGLU E{ACT, FF}; gemm_phase<pg8::EpiSwiGLU, StaticOrder>(F.lds, g, S, E, nullptr); }
            SEAM(base + 1);
            if (IN(base + 2)) { PH_ENTER(); Gemm g{ACT, (const bf16_t*)(ws + WS_WD + (size_t)f * DN_BYTES), T, D, FF, FF, FF, 0, 0}; StaticOrder S; S.init(T, D, F.G, F.bx);
                pg8::EpiResid E{h, D, 0.5f}; gemm_phase<pg8::EpiResid, StaticOrder>(F.lds, g, S, E, nullptr); }
            SEAM(base + 2);
        } else if ((layer & 1) == 0) {
#define AB_PTRS() bf16_t* P = ACT; unsigned char* mx = ws + WS_MIX; bf16_t* CB = (bf16_t*)(mx + MX_C); bf16_t* QK = (bf16_t*)(mx + MX_QK); float* HM = (float*)(mx + MX_HM); float* O2 = (float*)(mx + MX_O2); float* GIF = (float*)(mx + MX_GIF); bf16_t* Y = (bf16_t*)(mx + MX_Y); (void)P; (void)CB; (void)QK; (void)HM; (void)O2; (void)GIF; (void)Y
            if (IN(base + 0)) { PH_ENTER(); AB_PTRS(); ph_norm<8>(F, h, ap->in[5] + (size_t)layer * D, HN, ap->in[10] + (size_t)jp * D * AB_COLS, AB_COLS, 3072, GIF); }
            SEAM(base + 0);
            if (IN(base + 1)) { PH_ENTER(); AB_PTRS(); Gemm g{HN, (const bf16_t*)(ws + WS_WABIN + (size_t)jp * ABIN_BYTES), T, AB_N, D, D, D, 0, 0}; StaticOrder S; S.init(T, AB_N, F.G, F.bx);
                pg8::EpiPlainBf16 E{P, AB_N}; gemm_phase<pg8::EpiPlainBf16, StaticOrder>(F.lds, g, S, E, nullptr); }
            SEAM(base + 1);
            if (IN(base + 2)) { PH_ENTER(); AB_PTRS(); ph_conv(F, P, ap->in[12] + (size_t)jp * 4096, ap->in[13] + (size_t)jp * 1024, CB); }
            SEAM(base + 2);
            if (IN(base + 3)) { PH_ENTER(); AB_PTRS(); Gemm g{CB, (const bf16_t*)(ws + WS_WQK + (size_t)jp * WQK_BYTES), T, 2048, 256, 1024, 256, 3, 256}; StaticOrder S; S.init(T, 2048, F.G, F.bx);
                pg8::EpiPlainBf16 E{QK, 2048}; gemm_phase<pg8::EpiPlainBf16, StaticOrder>(F.lds, g, S, E, nullptr); }
            SEAM(base + 3);
            if (IN(base + 4)) { PH_ENTER(); AB_PTRS(); ph_recurrent(F, P, QK, GIF, ap->in[16] + jp * 4, ap->in[17] + jp * 4, ap->in[20], jp, HM, O2); }
            SEAM(base + 4);
            if (IN(base + 5)) { PH_ENTER(); AB_PTRS(); ph_ab_final(F, P, CB, HM, O2, ap->in[18] + (size_t)jp * 1024, ap->in[19] + (size_t)jp * 1024, ap->in[21] + (size_t)jp * 1024, Y); }
            SEAM(base + 5);
            if (IN(base + 6)) { PH_ENTER(); AB_PTRS(); Gemm g{Y, (const bf16_t*)(ws + WS_WABOUT + (size_t)jp * SQ_BYTES), T, D, D, D, D, 0, 0}; StaticOrder S; S.init(T, D, F.G, F.bx);
                pg8::EpiResid E{h, D, 1.0f}; gemm_phase<pg8::EpiResid, StaticOrder>(F.lds, g, S, E, nullptr); }
            SEAM(base + 6);
        } else {
#define C_PTRS() bf16_t* SL = ACT; unsigned char* mx = ws + WS_MIX; float* GP = (float*)(mx + MX_GP); bf16_t* HID = (bf16_t*)(mx + MX_HID); bf16_t* KC = (bf16_t*)(mx + MX_KCMP); bf16_t* VC = (bf16_t*)(mx + MX_VCMP); bf16_t* O = (bf16_t*)(mx + MX_O); const float* rope = (const float*)(ws + WS_ROPE); (void)SL; (void)GP; (void)HID; (void)KC; (void)VC; (void)O; (void)rope
            if (IN(base + 0)) { PH_ENTER(); C_PTRS(); ph_norm<48>(F, h, ap->in[5] + (size_t)layer * D, HN, ap->in[22] + (size_t)jp * D * C_COLS, C_COLS, 5120, GP); }
            SEAM(base + 0);
            if (IN(base + 1)) { PH_ENTER(); C_PTRS(); Gemm g{HN, (const bf16_t*)(ws + WS_WCIN + (size_t)jp * CIN_BYTES), T, C_N, D, D, D, 0, 0}; StaticOrder S; S.init(T, C_N, F.G, F.bx);
                pg8::EpiSlots E{SL, T}; gemm_phase<pg8::EpiSlots, StaticOrder>(F.lds, g, S, E, nullptr); }
            SEAM(base + 1);
            if (IN(base + 2)) {
                { PH_ENTER(); C_PTRS(); const int kv = F.bx >= 16 ? 1 : 0;
                  const float* cbias = (const float*)(ws + WS_CB) + (size_t)jp * 512 + kv * 256;
                  Gemm g{SL + (size_t)(16 + 4 * kv) * T * 128, (const bf16_t*)(ws + WS_WCMP1 + (size_t)(jp * 2 + kv) * CMP1_BYTES), 4096, 256, 4096, 2048, 4096, 0, 0};
                  StaticOrder S; S.init(4096, 256, F.G, kv ? F.bx - 16 : F.bx);
                  pg8::EpiSiluBias E{HID + (size_t)kv * 4096 * 256, 256, cbias}; gemm_phase<pg8::EpiSiluBias, StaticOrder>(F.lds, g, S, E, nullptr); }
                { PH_ENTER(); C_PTRS(); ph_qknorm_rope(F, SL, ap->in[24] + (size_t)jp * 128, ap->in[25] + (size_t)jp * 384, rope); } }
            SEAM(base + 2);
            if (IN(base + 3)) { PH_ENTER(); C_PTRS(); ph_compress2(F, HID, ap->in[29] + (size_t)jp * 2 * 256 * 128, ap->in[25] + (size_t)jp * 384, rope, KC, VC); }
            SEAM(base + 3);
            if (IN(base + 4)) { PH_ENTER(); C_PTRS(); ph_attn_naive(F, SL, GP, ap->in[30] + (size_t)jp * 48, KC, VC, O); }
            SEAM(base + 4);
            if (IN(base + 6)) { PH_ENTER(); C_PTRS(); Gemm g{O, (const bf16_t*)(ws + WS_WCOUT + (size_t)jp * SQ_BYTES), T, D, D, D, D, 0, 0}; StaticOrder S; S.init(T, D, F.G, F.bx);
                pg8::EpiResid E{h, D, 1.0f}; gemm_phase<pg8::EpiResid, StaticOrder>(F.lds, g, S, E, nullptr); }
            SEAM(base + 6);
        }
    }
#undef IN
#undef SEAM
}

extern "C" void kernel_launch(void* const* d_in, const int* in_sizes, int n_in, void* d_out, int out_size, void* d_ws, size_t ws_size, hipStream_t stream) {
    static int grid = 0;
    if (grid == 0) {
        if (n_in != 31 || in_sizes[0] != T * D || out_size != T * D || ws_size < WS_END) { fprintf(stderr, "kernel_launch: unexpected problem shape (n_in %d, in0 %d, out %d, ws %zu < %zu)\n", n_in, n_in > 0 ? in_sizes[0] : -1, out_size, ws_size, (size_t)WS_END); grid = -1; return; }
        int dev = 0, cus = 0, per_cu = 0;
        if (hipGetDevice(&dev) != hipSuccess || hipDeviceGetAttribute(&cus, hipDeviceAttributeMultiprocessorCount, dev) != hipSuccess) { grid = -1; return; }
        if (hipFuncSetAttribute((const void*)fwd_kernel, hipFuncAttributeMaxDynamicSharedMemorySize, LDS_BYTES) != hipSuccess) { fprintf(stderr, "kernel_launch: hipFuncSetAttribute failed\n"); grid = -1; return; }
        if (hipOccupancyMaxActiveBlocksPerMultiprocessor(&per_cu, (const void*)fwd_kernel, NTHREADS, LDS_BYTES) != hipSuccess || per_cu < 1) { fprintf(stderr, "kernel_launch: occupancy query reports %d workgroups per CU\n", per_cu); }
        (void)hipGetLastError();
        grid = cus;
    }
    if (grid < 0) return;
    if (hipMemsetAsync((char*)d_ws + WS_CTL, 0, CTL_ZERO_BYTES, stream) != hipSuccess) return;
    Args a{};
    for (int i = 0; i < 31; ++i) a.in[i] = (const float*)d_in[i];
    a.out = (float*)d_out; a.ws = (unsigned char*)d_ws;
#if MK_MULTI_LAUNCH
    for (int p = 0; p < NSLOTS_PH; ++p) {
        if (p > 0) { const int step = (p - 1) / NPS, q = (p - 1) % NPS, sub = step % 3, layer = step / 3;
            if (sub != 1 && q > 2) continue; if (sub == 1 && (layer & 1) == 1 && q == 5) continue; }
        a.ph_lo = p; a.ph_hi = p + 1;
        hipLaunchKernelGGL(fwd_kernel, dim3(grid), dim3(NTHREADS), LDS_BYTES, stream, a);
    }
#else
    a.ph_lo = 0; a.ph_hi = NSLOTS_PH;
    hipLaunchKernelGGL(fwd_kernel, dim3(grid), dim3(NTHREADS), LDS_BYTES, stream, a);
#endif
}
```

```cpp
#include <hip/hip_runtime.h>
#include <cstdio>
#include <cstdint>

constexpr int BATCH = 2, SEQ = 8192, T = BATCH * SEQ, D = 2048, FF = 5504, DEPTH = 4;
constexpr int AB_COLS = 7176, AB_N = 7168;
constexpr int C_COLS = 5168, C_N = 5120;
constexpr int NSLOT = 40;
constexpr int NCMP = 512;
constexpr float NORM_EPS = 1e-6f;

#define GAS __attribute__((address_space(1)))
#define LAS __attribute__((address_space(3)))
typedef unsigned short bf16_t;
typedef unsigned v4u __attribute__((ext_vector_type(4)));
typedef unsigned v2u __attribute__((ext_vector_type(2)));
typedef float f32x4 __attribute__((ext_vector_type(4)));
typedef float f32x2 __attribute__((ext_vector_type(2)));
typedef short bf16x8 __attribute__((ext_vector_type(8)));

__device__ __forceinline__ unsigned f2bf(float f) { return (unsigned)__builtin_bit_cast(unsigned short, (__bf16)f); }
typedef float pk_f2_t __attribute__((ext_vector_type(2)));
typedef __bf16 pk_b2_t __attribute__((ext_vector_type(2)));
__device__ __forceinline__ unsigned pk2(float lo, float hi) { const pk_f2_t v = {lo, hi}; return __builtin_bit_cast(unsigned, __builtin_convertvector(v, pk_b2_t)); }
__device__ __forceinline__ float bf2f(unsigned short b) { return __builtin_bit_cast(float, ((unsigned)b) << 16); }
__device__ __forceinline__ float bflo(unsigned w) { return __builtin_bit_cast(float, w << 16); }
__device__ __forceinline__ float bfhi(unsigned w) { return __builtin_bit_cast(float, w & 0xffff0000u); }
#define DPP_F(v, ctrl) __builtin_bit_cast(float, __builtin_amdgcn_mov_dpp(__builtin_bit_cast(int, (v)), (ctrl), 0xf, 0xf, true))
__device__ __forceinline__ float wave_sum(float v) {
    v += DPP_F(v, 0xB1); v += DPP_F(v, 0x4E); v += DPP_F(v, 0x124); v += DPP_F(v, 0x128);
    const int b = __builtin_bit_cast(int, v);
    return (__builtin_bit_cast(float, __builtin_amdgcn_readlane(b, 0)) + __builtin_bit_cast(float, __builtin_amdgcn_readlane(b, 16))) + (__builtin_bit_cast(float, __builtin_amdgcn_readlane(b, 32)) + __builtin_bit_cast(float, __builtin_amdgcn_readlane(b, 48)));
}
__device__ __forceinline__ float wave_max(float v) {
    v = fmaxf(v, DPP_F(v, 0xB1)); v = fmaxf(v, DPP_F(v, 0x4E)); v = fmaxf(v, DPP_F(v, 0x124)); v = fmaxf(v, DPP_F(v, 0x128));
    const int b = __builtin_bit_cast(int, v);
    return fmaxf(fmaxf(__builtin_bit_cast(float, __builtin_amdgcn_readlane(b, 0)), __builtin_bit_cast(float, __builtin_amdgcn_readlane(b, 16))), fmaxf(__builtin_bit_cast(float, __builtin_amdgcn_readlane(b, 32)), __builtin_bit_cast(float, __builtin_amdgcn_readlane(b, 48))));
}
__device__ __forceinline__ float half_swap_sum(float x, LAS float* scr64, int lane) {
    scr64[lane] = x; asm volatile("s_waitcnt lgkmcnt(0)" ::: "memory"); const float y = scr64[lane ^ 32]; asm volatile("s_waitcnt lgkmcnt(0)" ::: "memory"); return x + y; }
__device__ __forceinline__ float opaque_one() { float one = 1.0f; asm volatile("" : "+v"(one)); return one; }
__device__ __forceinline__ float sigmoidf_(float x) { return __builtin_amdgcn_rcpf(1.0f + __expf(-x)); }
__device__ __forceinline__ float siluf_(float x) { return x * __builtin_amdgcn_rcpf(1.0f + __expf(-x)); }
__device__ __forceinline__ float row16_sum(float v) {
    v += __builtin_bit_cast(float, __builtin_amdgcn_mov_dpp(__builtin_bit_cast(int, v), 0xB1, 0xf, 0xf, true));
    v += __builtin_bit_cast(float, __builtin_amdgcn_mov_dpp(__builtin_bit_cast(int, v), 0x4E, 0xf, 0xf, true));
    v += __builtin_bit_cast(float, __builtin_amdgcn_mov_dpp(__builtin_bit_cast(int, v), 0x124, 0xf, 0xf, true));
    v += __builtin_bit_cast(float, __builtin_amdgcn_mov_dpp(__builtin_bit_cast(int, v), 0x128, 0xf, 0xf, true));
    return v;
}

__device__ __forceinline__ int lane_id() { int l; asm volatile("v_mbcnt_lo_u32_b32 %0, -1, 0\n\tv_mbcnt_hi_u32_b32 %0, -1, %0" : "=v"(l)); return l; }
#define XB_TMO      128
#define XB_XCNT(j)  (256  + 64 * (j))
#define XB_XSUB(j)  (1280 + 64 * (j))
#define XB_XGEN(j)  (2304 + 64 * (j))
#define XB_TOP      3328
#define XB_TOPGEN   3392
#define XCD_BAR_WORDS 3456
#define XB_SPIN_CAP (1u << 18)

__device__ __forceinline__ unsigned xb_ld(unsigned* p)              { return __hip_atomic_load(p, __ATOMIC_RELAXED, __HIP_MEMORY_SCOPE_AGENT); }
__device__ __forceinline__ unsigned xb_add(unsigned* p, unsigned v) { return __hip_atomic_fetch_add(p, v, __ATOMIC_RELAXED, __HIP_MEMORY_SCOPE_AGENT); }
__device__ __forceinline__ unsigned xb_xcc_id() { return (unsigned)__builtin_amdgcn_s_getreg((3 << 11) | 20) & 0xFu; }
#define XB_SPIN(cond, bar) do { unsigned _sp = 0; while (cond) { __builtin_amdgcn_s_sleep(1); \
    if ((++_sp & 255u) == 0u) { if (xb_ld(&(bar)[XB_TMO])) break; if (_sp > XB_SPIN_CAP) { atomicAdd(&(bar)[XB_TMO], 1u); break; } } } } while (0)

struct XcdBarrier {
    unsigned* bar; unsigned x;
    volatile LAS unsigned* st;
    int wv;
};
__device__ __forceinline__ bool xb_leader(const XcdBarrier& b) { int l; asm volatile("v_mbcnt_lo_u32_b32 %0, -1, 0\n\tv_mbcnt_hi_u32_b32 %0, -1, %0" : "=v"(l)); return b.wv == 0 && l == 0; }

__device__ __forceinline__ XcdBarrier xcd_barrier_post(unsigned* bar, volatile LAS unsigned* st, int wv) {
    XcdBarrier b; b.bar = bar; b.x = xb_xcc_id(); b.st = st; b.wv = wv;
    if (xb_leader(b)) (void)xb_add(&bar[XB_XCNT(b.x)], 1u);
    return b;
}
__device__ __forceinline__ void xcd_barrier_complete(unsigned* bar, unsigned x, unsigned& nloc, unsigned& nx) {
    const unsigned G = gridDim.x * gridDim.y * gridDim.z;
    unsigned sum, cnt, mine, sp = 0u;
    for (;;) {
        sum = 0u; cnt = 0u; mine = 0u;
#pragma unroll
        for (unsigned j = 0; j < 16; ++j) { const unsigned c = xb_ld(&bar[XB_XCNT(j)]); sum += c; cnt += (c > 0u) ? 1u : 0u; mine = (j == x) ? c : mine; }
        if (sum == G) break;
        __builtin_amdgcn_s_sleep(1);
        if ((++sp & 255u) == 0u) { if (xb_ld(&bar[XB_TMO])) break; if (sp > XB_SPIN_CAP) { atomicAdd(&bar[XB_TMO], 1u); break; } }
    }
    nloc = mine > 0u ? mine : 1u; nx = cnt > 0u ? cnt : 1u;
}

__device__ __forceinline__ void xcd_barrier(const XcdBarrier& b) {
    asm volatile("s_waitcnt vmcnt(0)" ::: "memory");
    __syncthreads();
    if (xb_leader(b)) {
        unsigned* bar = b.bar; asm volatile("" : "+s"(bar));
        __builtin_amdgcn_s_waitcnt(0);
        unsigned nloc = b.st[0], nx = b.st[1];
        if (nloc == 0u) { xcd_barrier_complete(bar, b.x, nloc, nx); b.st[0] = nloc; b.st[1] = nx; }
        const unsigned old = xb_add(&bar[XB_XSUB(b.x)], 1u);
        const unsigned gen = old / nloc;
        if (old + 1u == (gen + 1u) * nloc) {
            __builtin_amdgcn_fence(__ATOMIC_RELEASE, "agent");
            asm volatile("s_waitcnt vmcnt(0)" ::: "memory");
            const unsigned og = xb_add(&bar[XB_TOP], 1u);
            const unsigned tg = og / nx;
            if (og + 1u == (tg + 1u) * nx) xb_add(&bar[XB_TOPGEN], 1u);
            else XB_SPIN(xb_ld(&bar[XB_TOPGEN]) == tg, bar);
            __builtin_amdgcn_fence(__ATOMIC_ACQUIRE, "agent");
            xb_add(&bar[XB_XGEN(b.x)], 1u);
            asm volatile("s_waitcnt vmcnt(0)" ::: "memory");
        } else {
            XB_SPIN(xb_ld(&bar[XB_XGEN(b.x)]) == gen, bar);
            __builtin_amdgcn_fence(__ATOMIC_ACQUIRE, "agent");
            asm volatile("s_waitcnt vmcnt(0)" ::: "memory");
        }
    }
    __syncthreads();
}
namespace pg8 {
#define PG8_LAS __attribute__((address_space(3)))
typedef unsigned short bf16_t;
typedef short bf16x8 __attribute__((ext_vector_type(8)));
typedef float f32x4 __attribute__((ext_vector_type(4)));
typedef unsigned u32x4 __attribute__((ext_vector_type(4)));
constexpr int BM = 256, BK = 64, HALF = 128, HTB = HALF * BK * 2  , STAGE_BYTES = 8 * HTB, NXCD = 8, WGM = 8;

__host__ __device__ __forceinline__ int lds_byte(int r, int c) { const int st = (r >> 4) * 2 + (c >> 5), rr = r & 15, cc = c & 31, ob = rr * 64 + cc * 2; return st * 1024 + (ob ^ (((ob >> 9) & 1) << 5)); }
__host__ __device__ __forceinline__ void stage_rc(int b, int& R, int& C) { const int st = b / 1024, sb = b % 1024, swz = sb ^ (((sb >> 9) & 1) << 5); R = (st >> 1) * 16 + swz / 64; C = (st & 1) * 32 + (swz % 64) / 2; }
__host__ __device__ __forceinline__ int perm32(int rho) { const int n = rho >> 4, i = rho & 15; return 8 * (i >> 2) + 4 * n + (i & 3); }

struct Unit { int pm, pn; };
struct Gemm { const bf16_t* A; const bf16_t* Bt; int M, N, K; int lda, ldb; int amask; int astride; };

struct StaticOrder {
    int nM, nN, nwg, G, c;
    __host__ __device__ __forceinline__ void init(int M, int N, int G_, int c_) { nM = M / BM; nN = N / BM; nwg = nM * nN; G = G_; c = c_; }
    __host__ __device__ __forceinline__ bool next(int i, Unit& u) const {
        const long L = (long)i * G + c; if (L >= nwg) return false;
        int wgid = (int)L; { const int q = nwg / NXCD, r = nwg % NXCD, xcd = wgid % NXCD, off = wgid / NXCD; wgid = (xcd < r ? xcd * (q + 1) : r * (q + 1) + (xcd - r) * q) + off; }
        const int nig = WGM * nN, gid = wgid / nig, fm = gid * WGM, gsz = (nM - fm) < WGM ? (nM - fm) : WGM;
        u.pm = fm + ((wgid % nig) % gsz); u.pn = (wgid % nig) / gsz; return true;
    }
    __device__ __forceinline__ void a_ready(const Unit&) const {}
    __device__ __forceinline__ void done(const Unit&) const {}
};
struct CountedOrder : StaticOrder {
    const unsigned* ready; unsigned need; unsigned* tmo;
    __device__ __forceinline__ void a_ready(const Unit& u) const {
        if (threadIdx.x < 64) {
            const unsigned long long t0 = __builtin_amdgcn_s_memrealtime(); unsigned polls = 0;
            while ((unsigned)__builtin_amdgcn_readfirstlane(__hip_atomic_load(ready + 64 * u.pm, __ATOMIC_RELAXED, __HIP_MEMORY_SCOPE_AGENT)) < need) {
                if ((++polls & 255u) == 0u && __builtin_amdgcn_readfirstlane(__hip_atomic_load(tmo, __ATOMIC_RELAXED, __HIP_MEMORY_SCOPE_AGENT)) != 0u) break;
                if (__builtin_amdgcn_s_memrealtime() - t0 > 2000000ull) {
                    if (threadIdx.x == 0) { unsigned expect = 0u; __hip_atomic_compare_exchange_strong(tmo + 1, &expect, 0x600u | (unsigned)(u.pm & 0xff), __ATOMIC_RELAXED, __ATOMIC_RELAXED, __HIP_MEMORY_SCOPE_AGENT); __hip_atomic_store(tmo, 1u, __ATOMIC_RELAXED, __HIP_MEMORY_SCOPE_AGENT); }
                    break; }
                __builtin_amdgcn_s_sleep(2); }
            __builtin_amdgcn_fence(__ATOMIC_ACQUIRE, "agent");
            asm volatile("s_waitcnt vmcnt(0)" ::: "memory");
        }
#if !defined(BROKEN_HOOK_NO_BARRIER)
        asm volatile("" ::: "memory"); __builtin_amdgcn_s_barrier(); asm volatile("" ::: "memory");
#endif
    }
};

__device__ __forceinline__ unsigned cvt_pk_bf16(float lo, float hi) { unsigned r; asm volatile("v_cvt_pk_bf16_f32 %0, %1, %2" : "=v"(r) : "v"(lo), "v"(hi)); return r; }
typedef float f32x2 __attribute__((ext_vector_type(2)));
__device__ __forceinline__ f32x2 gelu_pk(f32x2 v) {
    const f32x2 av = __builtin_elementwise_abs(v), d = av * 0.2316418882f + 1.0f;
    f32x2 t; t.x = __builtin_amdgcn_rcpf(d.x); t.y = __builtin_amdgcn_rcpf(d.y);
    f32x2 q = t * 0.5307027145f + (-0.7265760135f); q = q * t + 0.7107068705f; q = q * t + (-0.142248368f); q = q * t + 0.127414796f; q = q * t;
    const f32x2 s = (v * v) * (-0.72134752044f);
    f32x2 e; e.x = __builtin_amdgcn_exp2f(s.x); e.y = __builtin_amdgcn_exp2f(s.y);
    const f32x2 m = v * (q * e), r = v - m;
    f32x2 o; o.x = v.x < 0.f ? m.x : r.x; o.y = v.y < 0.f ? m.y : r.y; return o;
}

struct EpiF32 {
    static constexpr bool PERM = false, AFTER_DRAIN = false;
    float* C; int ldc; const float* bias;
    __device__ __forceinline__ void operator()(const f32x4 (&acc)[2][2][4][2], const Unit& u, int wr, int wc, int fr, int fq) const {
        const int row0 = u.pm * BM + wr * 64 + fr, col0 = u.pn * BM + wc * 32 + 4 * fq;
        f32x4 bv[2][2];
#pragma unroll
        for (int bj = 0; bj < 2; ++bj)
#pragma unroll
            for (int n = 0; n < 2; ++n) bv[bj][n] = bias ? *(const f32x4*)(bias + col0 + bj * HALF + n * 16) : (f32x4){0.f, 0.f, 0.f, 0.f};
#pragma unroll
        for (int ai = 0; ai < 2; ++ai)
#pragma unroll
            for (int m = 0; m < 4; ++m) { float* rowp = C + (size_t)(row0 + ai * HALF + m * 16) * ldc + col0;
#pragma unroll
                for (int bj = 0; bj < 2; ++bj)
#pragma unroll
                    for (int n = 0; n < 2; ++n) *(f32x4*)(rowp + bj * HALF + n * 16) = acc[ai][bj][m][n] + bv[bj][n]; }
    }
};
template <int ACT  > struct EpiBf16 {
    static constexpr bool PERM = true, AFTER_DRAIN = false;
    bf16_t* O; int ldc; const float* bias; int split_cols; size_t split_stride;
    __device__ __forceinline__ void operator()(const f32x4 (&acc)[2][2][4][2], const Unit& u, int wr, int wc, int fr, int fq) const {
        const int row0 = u.pm * BM + wr * 64 + fr; int colt = u.pn * BM; bf16_t* base = O;
        if (split_cols) { const int t = colt / split_cols; base += (size_t)t * split_stride; colt -= t * split_cols; }
        const int col0 = colt + wc * 32 + 8 * fq, bcol0 = u.pn * BM + wc * 32 + 8 * fq;
        f32x4 bv[2][2];
#pragma unroll
        for (int bj = 0; bj < 2; ++bj)
#pragma unroll
            for (int n = 0; n < 2; ++n) bv[bj][n] = bias ? *(const f32x4*)(bias + bcol0 + bj * HALF + 4 * n) : (f32x4){0.f, 0.f, 0.f, 0.f};
#pragma unroll
        for (int ai = 0; ai < 2; ++ai)
#pragma unroll
            for (int m = 0; m < 4; ++m) { bf16_t* rowp = base + (size_t)(row0 + ai * HALF + m * 16) * ldc + col0;
#pragma unroll
                for (int bj = 0; bj < 2; ++bj) { f32x4 v0 = acc[ai][bj][m][0] + bv[bj][0], v1 = acc[ai][bj][m][1] + bv[bj][1];
                    if (ACT == 1) { f32x2 a = gelu_pk((f32x2){v0[0], v0[1]}), b = gelu_pk((f32x2){v0[2], v0[3]}), c = gelu_pk((f32x2){v1[0], v1[1]}), d = gelu_pk((f32x2){v1[2], v1[3]});
                        v0 = (f32x4){a.x, a.y, b.x, b.y}; v1 = (f32x4){c.x, c.y, d.x, d.y}; }
                    if (ACT == 2) {
#pragma unroll
                        for (int j = 0; j < 4; ++j) { v0[j] = 0.5f * v0[j] * (1.0f + erff(v0[j] * 0.70710678f)); v1[j] = 0.5f * v1[j] * (1.0f + erff(v1[j] * 0.70710678f)); } }
                    u32x4 w; w.x = cvt_pk_bf16(v0[0], v0[1]); w.y = cvt_pk_bf16(v0[2], v0[3]); w.z = cvt_pk_bf16(v1[0], v1[1]); w.w = cvt_pk_bf16(v1[2], v1[3]);
                    *(u32x4*)(rowp + bj * HALF) = w; } }
    }
};

struct RowScale { PG8_LAS const float* rsl; int pm0; const float* ssqp;
    __device__ __forceinline__ float operator()(int row) const { if ((row >> 8) == pm0) return rsl[row & 255];
        const f32x4* p = (const f32x4*)(ssqp + (size_t)row * 32); float s = 0.f;
#pragma unroll
        for (int q = 0; q < 8; ++q) { const f32x4 v = p[q]; s += (v.x + v.y) + (v.z + v.w); }
        return __builtin_amdgcn_rsqf(s * (1.0f / 2048.0f) + 1e-6f); } };
__device__ __forceinline__ float silu_f(float x) { return x * __builtin_amdgcn_rcpf(1.0f + __expf(-x)); }
struct EpiSwiGLU {
    static constexpr bool PERM = true, AFTER_DRAIN = false;
    bf16_t* O; int ldc; RowScale rsc;
    __device__ __forceinline__ void operator()(const f32x4 (&acc)[2][2][4][2], const Unit& u, int wr, int wc, int fr, int fq) const {
        const int row0 = u.pm * BM + wr * 64 + fr, col0 = u.pn * HALF + wc * 32 + 8 * fq;
#pragma unroll
        for (int ai = 0; ai < 2; ++ai)
#pragma unroll
            for (int m = 0; m < 4; ++m) { const int row = row0 + ai * HALF + m * 16; bf16_t* rowp = O + (size_t)row * ldc + col0;
                const float rs = rsc(row);
                const f32x4 g0 = acc[ai][0][m][0] * rs, g1 = acc[ai][0][m][1] * rs, u0 = acc[ai][1][m][0] * rs, u1 = acc[ai][1][m][1] * rs;
                float r[8];
#pragma unroll
                for (int j = 0; j < 4; ++j) { r[j] = silu_f(g0[j]) * u0[j]; r[4 + j] = silu_f(g1[j]) * u1[j]; }
                u32x4 w; w.x = cvt_pk_bf16(r[0], r[1]); w.y = cvt_pk_bf16(r[2], r[3]); w.z = cvt_pk_bf16(r[4], r[5]); w.w = cvt_pk_bf16(r[6], r[7]);
                *(u32x4*)rowp = w; }
    }
};
struct EpiResid {
    static constexpr bool PERM = true, AFTER_DRAIN = false;
    float* H; int ldc; bf16_t* HB; float* ssqp; PG8_LAS float* red; bool last;
    __device__ __forceinline__ void operator()(const f32x4 (&acc)[2][2][4][2], const Unit& u, int wr, int wc, int fr, int fq) const {
        const int row0 = u.pm * BM + wr * 64 + fr, col0 = u.pn * BM + wc * 32 + 8 * fq;
        PG8_LAS float* myred = red + (wr * 4 + wc) * 384;
        float part[8];
#pragma unroll
        for (int ai = 0; ai < 2; ++ai) {
            u32x4 t[4][2];
#pragma unroll
            for (int m = 0; m < 4; ++m) { const bf16_t* rowp = HB + (size_t)(row0 + ai * HALF + m * 16) * ldc + col0;
#pragma unroll
                for (int bj = 0; bj < 2; ++bj) t[m][bj] = *(const u32x4*)(rowp + bj * HALF); }
            asm volatile("" ::: "memory");
#pragma unroll
            for (int m = 0; m < 4; ++m) { const size_t off = (size_t)(row0 + ai * HALF + m * 16) * ldc + col0; float s = 0.f;
#pragma unroll
                for (int bj = 0; bj < 2; ++bj) { const u32x4 w0 = t[m][bj];
                    const f32x4 h0 = {__builtin_bit_cast(float, w0.x << 16), __builtin_bit_cast(float, w0.x & 0xFFFF0000u), __builtin_bit_cast(float, w0.y << 16), __builtin_bit_cast(float, w0.y & 0xFFFF0000u)};
                    const f32x4 h1 = {__builtin_bit_cast(float, w0.z << 16), __builtin_bit_cast(float, w0.z & 0xFFFF0000u), __builtin_bit_cast(float, w0.w << 16), __builtin_bit_cast(float, w0.w & 0xFFFF0000u)};
                    const f32x4 v0 = h0 + acc[ai][bj][m][0], v1 = h1 + acc[ai][bj][m][1];
                    if (last) { __builtin_nontemporal_store(v0, (f32x4*)(H + off + bj * HALF)); __builtin_nontemporal_store(v1, (f32x4*)(H + off + bj * HALF + 4)); }
                    else { u32x4 w; w.x = cvt_pk_bf16(v0[0], v0[1]); w.y = cvt_pk_bf16(v0[2], v0[3]); w.z = cvt_pk_bf16(v1[0], v1[1]); w.w = cvt_pk_bf16(v1[2], v1[3]); *(u32x4*)(HB + off + bj * HALF) = w; }
                    s += ((v0[0] * v0[0] + v0[1] * v0[1]) + (v0[2] * v0[2] + v0[3] * v0[3])) + ((v1[0] * v1[0] + v1[1] * v1[1]) + (v1[2] * v1[2] + v1[3] * v1[3])); }
                part[ai * 4 + m] = s; }
            asm volatile("" ::: "memory");
        }
        if (last) return;
#pragma unroll
        for (int r = 0; r < 8; ++r) if (fq > 0) myred[(r * 16 + fr) * 3 + (fq - 1)] = part[r];
        asm volatile("s_waitcnt lgkmcnt(0)" ::: "memory");
        if (fq == 0) {
#pragma unroll
            for (int r = 0; r < 8; ++r) { const float s = part[r] + (myred[(r * 16 + fr) * 3 + 0] + myred[(r * 16 + fr) * 3 + 1]) + myred[(r * 16 + fr) * 3 + 2];
                ssqp[(size_t)(row0 + (r >> 2) * HALF + (r & 3) * 16) * 32 + u.pn * 4 + wc] = s; } }
        asm volatile("s_waitcnt lgkmcnt(0)" ::: "memory");
    }
};
struct EpiPlainBf16 {
    static constexpr bool PERM = true, AFTER_DRAIN = false;
    bf16_t* O; int ldc; RowScale rsc; bool scaled;
    __device__ __forceinline__ void operator()(const f32x4 (&acc)[2][2][4][2], const Unit& u, int wr, int wc, int fr, int fq) const {
        const int row0 = u.pm * BM + wr * 64 + fr, col0 = u.pn * BM + wc * 32 + 8 * fq;
#pragma unroll
        for (int ai = 0; ai < 2; ++ai)
#pragma unroll
            for (int m = 0; m < 4; ++m) { const int row = row0 + ai * HALF + m * 16; bf16_t* rowp = O + (size_t)row * ldc + col0;
                const float rs = scaled ? rsc(row) : 1.0f;
#pragma unroll
                for (int bj = 0; bj < 2; ++bj) { const f32x4 v0 = acc[ai][bj][m][0] * rs, v1 = acc[ai][bj][m][1] * rs;
                    u32x4 w; w.x = cvt_pk_bf16(v0[0], v0[1]); w.y = cvt_pk_bf16(v0[2], v0[3]); w.z = cvt_pk_bf16(v1[0], v1[1]); w.w = cvt_pk_bf16(v1[2], v1[3]);
                    *(u32x4*)(rowp + bj * HALF) = w; } }
    }
};
struct EpiSlots {
    static constexpr bool PERM = true, AFTER_DRAIN = false;
    bf16_t* O; int Mrows; RowScale rsc;
    __device__ __forceinline__ void operator()(const f32x4 (&acc)[2][2][4][2], const Unit& u, int wr, int wc, int fr, int fq) const {
        const int row0 = u.pm * BM + wr * 64 + fr, d0 = wc * 32 + 8 * fq;
#pragma unroll
        for (int ai = 0; ai < 2; ++ai)
#pragma unroll
            for (int m = 0; m < 4; ++m) { const float rs = rsc(row0 + ai * HALF + m * 16);
#pragma unroll
                for (int bj = 0; bj < 2; ++bj) { const f32x4 v0 = acc[ai][bj][m][0] * rs, v1 = acc[ai][bj][m][1] * rs;
                    bf16_t* p = O + ((size_t)(2 * u.pn + bj) * Mrows + (row0 + ai * HALF + m * 16)) * 128 + d0;
                    u32x4 w; w.x = cvt_pk_bf16(v0[0], v0[1]); w.y = cvt_pk_bf16(v0[2], v0[3]); w.z = cvt_pk_bf16(v1[0], v1[1]); w.w = cvt_pk_bf16(v1[2], v1[3]);
                    *(u32x4*)p = w; } }
    }
};
struct EpiSiluBias {
    static constexpr bool PERM = true, AFTER_DRAIN = false;
    bf16_t* O; int ldc; const float* bias;
    __device__ __forceinline__ void operator()(const f32x4 (&acc)[2][2][4][2], const Unit& u, int wr, int wc, int fr, int fq) const {
        const int row0 = u.pm * BM + wr * 64 + fr, col0 = u.pn * BM + wc * 32 + 8 * fq;
        f32x4 bv[2][2];
#pragma unroll
        for (int bj = 0; bj < 2; ++bj)
#pragma unroll
            for (int n = 0; n < 2; ++n) bv[bj][n] = *(const f32x4*)(bias + col0 + bj * HALF + 4 * n);
#pragma unroll
        for (int ai = 0; ai < 2; ++ai)
#pragma unroll
            for (int m = 0; m < 4; ++m) { bf16_t* rowp = O + (size_t)(row0 + ai * HALF + m * 16) * ldc + col0;
#pragma unroll
                for (int bj = 0; bj < 2; ++bj) { const f32x4 v0 = acc[ai][bj][m][0] + bv[bj][0], v1 = acc[ai][bj][m][1] + bv[bj][1];
                    u32x4 w; w.x = cvt_pk_bf16(silu_f(v0[0]), silu_f(v0[1])); w.y = cvt_pk_bf16(silu_f(v0[2]), silu_f(v0[3])); w.z = cvt_pk_bf16(silu_f(v1[0]), silu_f(v1[1])); w.w = cvt_pk_bf16(silu_f(v1[2]), silu_f(v1[3]));
                    *(u32x4*)(rowp + bj * HALF) = w; } }
    }
};

template <class Epi, class Sched, bool STAMP = false>
__device__ __forceinline__ void gemm_phase(PG8_LAS unsigned char* lds, const Gemm g, const Sched& S, const Epi& E, unsigned long long* stamps, int tid_in) {
    int tid_ = tid_in; asm volatile("" : "+v"(tid_));
    const int tid = tid_, wid = __builtin_amdgcn_readfirstlane(tid >> 6), lane = tid & 63, wr = wid >> 2, wc = wid & 3, fr = lane & 15, fq = lane >> 4;
    const int K = g.K, nt = K / BK;
    int ts_lo = 0, ts_hi = 0, nts = 0; const unsigned long long rt_entry = STAMP ? (unsigned long long)wall_clock64() : 0ull;
#define PG8_STAMP() do { if (STAMP && wid == 0 && nts < 64) { const unsigned long long _c = (unsigned long long)clock64(); \
        ts_lo = (lane == nts) ? (int)(unsigned)_c : ts_lo; ts_hi = (lane == nts) ? (int)(unsigned)(_c >> 32) : ts_hi; ++nts; } } while (0)
    PG8_STAMP();
    unsigned voffA[2], voffB[2];
#pragma unroll
    for (int i = 0; i < 2; ++i) { int R, C; stage_rc(tid * 16 + i * 8192, R, C); const int Rb = Epi::PERM ? ((R & ~31) + perm32(R & 31)) : R;
        voffA[i] = (unsigned)(R * g.lda + C) * 2u; voffB[i] = (unsigned)(Rb * g.ldb + C) * 2u; }
    const size_t kstep = (size_t)(BK * 2);
    const size_t hstepA = (size_t)HALF * g.lda * 2, hstepB = (size_t)HALF * g.ldb * 2;
    const size_t tstepA = 2 * hstepA, tstepB = 2 * hstepB;
    const unsigned ldsw = (unsigned)wid * 1024u;
    const int aoff = lds_byte(wr * 64 + fr, fq * 8), boff = lds_byte(wc * 32 + fr, fq * 8);
#define PG8_SA(b, h) (((b) * 2 + (h)) * HTB)
#define PG8_SB(b, h) ((4 + (b) * 2 + (h)) * HTB)
#define PG8_STAGE(bufoff, gbase, voff) do { _Pragma("unroll") for (int _i = 0; _i < 2; ++_i) \
        __builtin_amdgcn_global_load_lds((const unsigned*)((const char*)(gbase) + (voff)[_i]), (PG8_LAS unsigned*)(lds + (bufoff) + ldsw + _i * 8192), 16, 0, 0); } while (0)
#define PG8_LDA(dst, b, h) do { _Pragma("unroll") for (int m = 0; m < 4; ++m) _Pragma("unroll") for (int k = 0; k < 2; ++k) dst[m][k] = *(const PG8_LAS bf16x8*)(lds + PG8_SA(b, h) + aoff + m * 2048 + k * 1024); } while (0)
#define PG8_LDB(dst, b, h) do { _Pragma("unroll") for (int n = 0; n < 2; ++n) _Pragma("unroll") for (int k = 0; k < 2; ++k) dst[n][k] = *(const PG8_LAS bf16x8*)(lds + PG8_SB(b, h) + boff + n * 2048 + k * 1024); } while (0)
#define PG8_MMA(ai, bj, At, Bt) do { __builtin_amdgcn_s_setprio(1); _Pragma("unroll") for (int m = 0; m < 4; ++m) _Pragma("unroll") for (int n = 0; n < 2; ++n) _Pragma("unroll") for (int k = 0; k < 2; ++k) \
        acc[ai][bj][m][n] = __builtin_amdgcn_mfma_f32_16x16x32_bf16(Bt[n][k], At[m][k], acc[ai][bj][m][n], 0, 0, 0); __builtin_amdgcn_s_setprio(0); } while (0)
#define PG8_WAIT_V(n) asm volatile("s_waitcnt vmcnt(" #n ")" ::: "memory")
#define PG8_WAIT_L(n) asm volatile("s_waitcnt lgkmcnt(" #n ")" ::: "memory")
#define PG8_BAR __builtin_amdgcn_s_barrier()
#define PG8_SCHED __builtin_amdgcn_sched_barrier(0)
    Unit cur, nxt; int ui = 0;
    if (!S.next(0, cur)) return;
    f32x4 acc[2][2][4][2];
#pragma unroll
    for (int a = 0; a < 2; ++a)
#pragma unroll
        for (int b = 0; b < 2; ++b)
#pragma unroll
            for (int m = 0; m < 4; ++m)
#pragma unroll
                for (int n = 0; n < 2; ++n) acc[a][b][m][n] = (f32x4){0.f, 0.f, 0.f, 0.f};
    bf16x8 At[4][2], B0[2][2], B1[2][2];
    const char* cA = (const char*)g.A + (size_t)cur.pm * tstepA + (size_t)((cur.pn & g.amask) * g.astride) * 2; const char* cB = (const char*)g.Bt + (size_t)cur.pn * tstepB;
    S.a_ready(cur);
    PG8_STAGE(PG8_SB(0, 0), cB, voffB); PG8_STAGE(PG8_SA(0, 0), cA, voffA); PG8_STAGE(PG8_SB(0, 1), cB + hstepB, voffB); PG8_STAGE(PG8_SA(0, 1), cA + hstepA, voffA);
    if (wr == 1) PG8_BAR;
    PG8_WAIT_V(4); PG8_BAR;
    PG8_STAGE(PG8_SB(1, 0), cB + kstep, voffB); PG8_STAGE(PG8_SA(1, 0), cA + kstep, voffA); PG8_STAGE(PG8_SB(1, 1), cB + hstepB + kstep, voffB);
    PG8_WAIT_V(6); PG8_BAR;
    PG8_STAMP();
    for (;;) {
        const bool has_next = S.next(ui + 1, nxt);
        const char* nA = has_next ? (const char*)g.A + (size_t)nxt.pm * tstepA + (size_t)((nxt.pn & g.amask) * g.astride) * 2 : cA; const char* nB = has_next ? (const char*)g.Bt + (size_t)nxt.pn * tstepB : cB;
        for (int t = 0; t < nt; t += 2) {
            const bool last = (t == nt - 2);
            const char* a1 = cA + (size_t)(t + 1) * kstep;
            const char* a2 = last ? nA : cA + (size_t)(t + 2) * kstep; const char* b2 = last ? nB : cB + (size_t)(t + 2) * kstep;
            const char* a3 = a2 + kstep; const char* b3 = b2 + kstep;
            if (last && has_next) S.a_ready(nxt);
            PG8_LDB(B0, 0, 0); PG8_SCHED; PG8_LDA(At, 0, 0); PG8_STAGE(PG8_SA(1, 1), a1 + hstepA, voffA);
            PG8_WAIT_L(8); PG8_BAR; PG8_WAIT_L(0); PG8_MMA(0, 0, At, B0); PG8_BAR; PG8_SCHED;
            PG8_LDB(B1, 0, 1); PG8_STAGE(PG8_SB(0, 0), b2, voffB);
            PG8_BAR; PG8_WAIT_L(0); PG8_MMA(0, 1, At, B1); PG8_BAR;
            PG8_LDA(At, 0, 1); PG8_STAGE(PG8_SA(0, 0), a2, voffA);
            PG8_BAR; PG8_WAIT_L(0); PG8_MMA(1, 0, At, B0); PG8_BAR; PG8_SCHED;
            PG8_STAGE(PG8_SB(0, 1), b2 + hstepB, voffB);
            PG8_WAIT_V(6); PG8_BAR; PG8_MMA(1, 1, At, B1); PG8_BAR;
            PG8_LDB(B0, 1, 0); PG8_SCHED; PG8_LDA(At, 1, 0); PG8_STAGE(PG8_SA(0, 1), a2 + hstepA, voffA);
            PG8_WAIT_L(8); PG8_BAR; PG8_WAIT_L(0); PG8_MMA(0, 0, At, B0); PG8_BAR; PG8_SCHED;
            PG8_LDB(B1, 1, 1); PG8_STAGE(PG8_SB(1, 0), b3, voffB);
            PG8_BAR; PG8_WAIT_L(0); PG8_MMA(0, 1, At, B1); PG8_BAR;
            PG8_LDA(At, 1, 1); PG8_STAGE(PG8_SA(1, 0), a3, voffA);
            PG8_BAR; PG8_WAIT_L(0); PG8_MMA(1, 0, At, B0); PG8_BAR; PG8_SCHED;
            PG8_STAGE(PG8_SB(1, 1), b3 + hstepB, voffB);
            PG8_WAIT_V(6); PG8_BAR; PG8_MMA(1, 1, At, B1); PG8_BAR;
        }
        PG8_STAMP();
        if constexpr (!Epi::AFTER_DRAIN) { E(acc, cur, wr, wc, fr, fq); S.done(cur); }
        PG8_STAMP();
        if (!has_next) break;
#pragma unroll
        for (int a = 0; a < 2; ++a)
#pragma unroll
            for (int b = 0; b < 2; ++b)
#pragma unroll
                for (int m = 0; m < 4; ++m)
#pragma unroll
                    for (int n = 0; n < 2; ++n) acc[a][b][m][n] = (f32x4){0.f, 0.f, 0.f, 0.f};
        cur = nxt; cA = nA; cB = nB; ++ui;
    }
    PG8_WAIT_V(0);
    if (wr == 0) PG8_BAR;
    PG8_BAR;
    if constexpr (Epi::AFTER_DRAIN) { E.fused(acc, cur, wr, wc, fr, fq, lds, wid, lane); S.done(cur); }
    PG8_STAMP();
    if (STAMP && wid == 0) { stamps[lane] = lane < nts ? (((unsigned long long)(unsigned)ts_hi << 32) | (unsigned)ts_lo) : 0ull;
        if (lane == 62) stamps[62] = rt_entry; if (lane == 63) stamps[63] = (unsigned long long)wall_clock64(); }
#undef PG8_STAMP
#undef PG8_SA
#undef PG8_SB
#undef PG8_STAGE
#undef PG8_LDA
#undef PG8_LDB
#undef PG8_MMA
#undef PG8_WAIT_V
#undef PG8_WAIT_L
#undef PG8_BAR
#undef PG8_SCHED
}
}

using pg8::Gemm; using pg8::StaticOrder; using pg8::gemm_phase;

constexpr size_t MiB = 1u << 20;
constexpr size_t WS_CTL = 0, CTL_ZERO_BYTES = 1 * MiB;
constexpr int CW_BAR = 4096;
constexpr size_t GU_BYTES = (size_t)2 * FF * D * 2, DN_BYTES = (size_t)D * FF * 2, ABIN_BYTES = (size_t)AB_N * D * 2, SQ_BYTES = (size_t)D * D * 2, CIN_BYTES = (size_t)C_N * D * 2;
constexpr size_t CMP1_BYTES = (size_t)256 * 4096 * 2, WQK_BYTES = (size_t)2048 * 256 * 2;
constexpr size_t WS_WGU = 1 * MiB;
constexpr size_t WS_WD = WS_WGU + 8 * GU_BYTES;
constexpr size_t WS_WABIN = WS_WD + 8 * DN_BYTES;
constexpr size_t WS_WABOUT = WS_WABIN + 2 * ABIN_BYTES;
constexpr size_t WS_WCIN = WS_WABOUT + 2 * SQ_BYTES;
constexpr size_t WS_WCOUT = WS_WCIN + 2 * CIN_BYTES;
constexpr size_t WS_WCMP1 = WS_WCOUT + 2 * SQ_BYTES;
constexpr size_t WS_WQK = WS_WCMP1 + 4 * CMP1_BYTES;
constexpr int ROPE_ROWS = 8208;
constexpr size_t WS_ROPE = WS_WQK + 2 * WQK_BYTES;
constexpr size_t WS_CB = WS_ROPE + 5 * MiB;
constexpr size_t WS_WSK = WS_CB + 64 * 1024;
constexpr size_t WS_HN = WS_CB + 2 * MiB;
static_assert(WS_WSK + (size_t)4 * 64 * D * 2 <= WS_HN, "skinny weights");
constexpr size_t WS_ACT = WS_HN + 64 * MiB;
constexpr size_t WS_MIX = WS_ACT + 224 * MiB;
constexpr size_t MX_C = 0, MX_QK = 32 * MiB, MX_CST = 96 * MiB, MX_SST = 224 * MiB, MX_Y = 288 * MiB, MX_GIF = 352 * MiB, MX_NST = 353 * MiB, MX_SCL = 354 * MiB, MX_HDEC = 355 * MiB;
constexpr size_t MX_GP = 0, MX_HID = 4 * MiB, MX_KCMP = 8 * MiB, MX_VCMP = 9 * MiB, MX_O = 288 * MiB;
constexpr size_t WS_SSQP = WS_MIX + 356 * MiB;
constexpr size_t SSQP_V = (size_t)T * 32 * 4;
constexpr size_t WS_END = WS_SSQP + 28 * MiB;
static_assert(WS_ROPE + (size_t)ROPE_ROWS * 64 * 2 * 4 <= WS_CB, "rope table");

__device__ __forceinline__ float ssqp_rstd(const float* ssqp, int row) {
    const f32x4* p = (const f32x4*)(ssqp + (size_t)row * 32); float s = 0.f;
#pragma unroll
    for (int q = 0; q < 8; ++q) { const f32x4 v = p[q]; s += (v.x + v.y) + (v.z + v.w); }
    return __builtin_amdgcn_rsqf(s * (1.0f / 2048.0f) + 1e-6f);
}
constexpr int NWAVES = 8, NTHREADS = 512;
constexpr int LDS_BYTES = 147456;
constexpr int RING_BYTES = 131072, MISC_OFF = RING_BYTES + 320, RED_OFF = RING_BYTES + 1024;

struct Args { const float* in[31]; float* out; unsigned char* ws; int ph_lo, ph_hi; };
static_assert(sizeof(Args) == 31 * 8 + 8 + 8 + 8, "Args has no padding");

typedef const Args __attribute__((address_space(4)))* CArgsP;
struct Frame {
    LAS unsigned char* lds;
    int tid, lane, wave, G, bx, gw, NGW;
};
__device__ __forceinline__ Frame make_frame(unsigned char* lds_raw, int wave_s) {
    Frame F; int w = wave_s, bx = blockIdx.x, G = gridDim.x;
    asm volatile("" : "+s"(w)); asm volatile("" : "+s"(bx)); asm volatile("" : "+s"(G));
    int tid = w * 64 + lane_id(); asm volatile("" : "+v"(tid));
    F.lds = (LAS unsigned char*)lds_raw; F.tid = tid; F.lane = tid & 63; F.wave = w;
    F.G = G; F.bx = bx; F.gw = bx * NWAVES + F.wave; F.NGW = G * NWAVES;
    return F;
}
__device__ __forceinline__ CArgsP get_args() { CArgsP p = (CArgsP)__builtin_amdgcn_kernarg_segment_ptr(); asm volatile("" : "+s"(p)); return p; }
#define LDS_WAIT() asm volatile("s_waitcnt lgkmcnt(0)" ::: "memory")

struct Job { const float* src; int ldn, K, col0, ncols; bf16_t* dst; int dst_ld, row0, mode; float scale; const float* kgain; };
constexpr int NJOBS = 64;
__device__ __forceinline__ Job make_job(int j, CArgsP ap) {
    Job J; J.scale = 1.0f; J.row0 = 0; J.mode = 0; J.col0 = 0; J.kgain = nullptr;
    unsigned char* ws = ap->ws;
    if (j < 24) { const int f = j / 3, kind = j % 3, layer = f >> 1, half = f & 1;
        if (kind < 2) { J.src = ap->in[(half ? 7 : 2) + kind] + (size_t)layer * D * FF; J.ldn = FF; J.K = D; J.ncols = FF; J.dst = (bf16_t*)(ws + WS_WGU + (size_t)f * GU_BYTES); J.dst_ld = D; J.mode = 1 + kind; J.kgain = ap->in[half ? 6 : 1] + (size_t)layer * D; }
        else { J.src = ap->in[half ? 9 : 4] + (size_t)layer * FF * D; J.ldn = D; J.K = FF; J.ncols = D; J.dst = (bf16_t*)(ws + WS_WD + (size_t)f * DN_BYTES); J.dst_ld = FF; J.scale = 0.5f; }
    } else if (j < 38) { const int q = j - 24, l = q / 7, seg = q % 7;
        J.src = ap->in[10] + (size_t)l * D * AB_COLS; J.ldn = AB_COLS; J.K = D; J.col0 = seg < 3 ? seg * 1024 : 3080 + (seg - 3) * 1024; J.ncols = 1024;
        J.dst = (bf16_t*)(ws + WS_WABIN + (size_t)l * ABIN_BYTES); J.dst_ld = D; J.row0 = seg * 1024; J.kgain = ap->in[5] + (size_t)(2 * l) * D;
    } else if (j < 40) { const int l = j - 38; J.src = ap->in[11] + (size_t)l * D * D; J.ldn = D; J.K = D; J.ncols = D; J.dst = (bf16_t*)(ws + WS_WABOUT + (size_t)l * SQ_BYTES); J.dst_ld = D;
    } else if (j < 42) { const int l = j - 40; J.src = ap->in[22] + (size_t)l * D * C_COLS; J.ldn = C_COLS; J.K = D; J.ncols = C_N; J.dst = (bf16_t*)(ws + WS_WCIN + (size_t)l * CIN_BYTES); J.dst_ld = D; J.kgain = ap->in[5] + (size_t)(2 * l + 1) * D;
    } else if (j < 44) { const int l = j - 42; J.src = ap->in[23] + (size_t)l * D * D; J.ldn = D; J.K = D; J.ncols = D; J.dst = (bf16_t*)(ws + WS_WCOUT + (size_t)l * SQ_BYTES); J.dst_ld = D;
    } else if (j < 48) { const int q = j - 44; J.src = ap->in[27] + (size_t)q * 4096 * 256; J.ldn = 256; J.K = 4096; J.ncols = 256; J.dst = (bf16_t*)(ws + WS_WCMP1 + (size_t)q * CMP1_BYTES); J.dst_ld = 4096;
    } else { const int q = j - 48, l = q / 8, r = q % 8, isk = r / 4, hh = r % 4;
        J.src = ap->in[isk ? 15 : 14] + (size_t)(l * 4 + hh) * 65536; J.ldn = 256; J.K = 256; J.ncols = 256; J.dst = (bf16_t*)(ws + WS_WQK + (size_t)l * WQK_BYTES); J.dst_ld = 256; J.row0 = isk * 1024 + hh * 256; J.scale = isk ? 0.0625f : 1.0f; }
    return J;
}
__device__ __forceinline__ void transpose_item(const Job& J, LAS float* scr, int item, int lane) {
    const int nblk = J.ncols / 64, kb = item / nblk, nb = item % nblk, k0 = 64 * kb, n0 = 64 * nb;
    const float* W = J.src + J.col0 + n0 + 4 * (lane & 15);
    f32x4 wv[16];
#pragma unroll
    for (int i = 0; i < 16; ++i) { const int kk = 4 * i + (lane >> 4); wv[i] = __builtin_nontemporal_load((const f32x4*)(W + (size_t)(k0 + kk) * J.ldn)); }
#pragma unroll
    for (int i = 0; i < 16; ++i) { const int kk = 4 * i + (lane >> 4); *(LAS f32x4*)(scr + kk * 64 + (((lane & 15) ^ ((kk >> 3) & 7)) << 2)) = wv[i]; }
    LDS_WAIT();
    const int c = lane & 7;
    const int drow0 = J.mode == 0 ? J.row0 + n0 : (n0 >> 7) * 256 + (n0 & 127) + (J.mode == 2 ? 128 : 0);
    const float sc = J.scale;
    f32x4 g0 = (f32x4){sc, sc, sc, sc}, g1 = g0;
    if (J.kgain) { g0 = *(const f32x4*)(J.kgain + k0 + 8 * c) * sc; g1 = *(const f32x4*)(J.kgain + k0 + 8 * c + 4) * sc; }
#pragma unroll
    for (int jj = 0; jj < 8; ++jj) { const int n = (lane >> 3) + 8 * jj; const LAS float* s = scr + (8 * c) * 64 + ((((n >> 2) ^ c) << 2) | (n & 3));
        v4u o; o.x = pk2(s[0 * 64] * g0.x, s[1 * 64] * g0.y); o.y = pk2(s[2 * 64] * g0.z, s[3 * 64] * g0.w); o.z = pk2(s[4 * 64] * g1.x, s[5 * 64] * g1.y); o.w = pk2(s[6 * 64] * g1.z, s[7 * 64] * g1.w);
        __builtin_nontemporal_store(o, (v4u*)(J.dst + (size_t)(drow0 + n) * J.dst_ld + k0 + 8 * c)); }
    LDS_WAIT();
}
__device__ __forceinline__ void ph_prologue(Frame& F, CArgsP ap) {
    LAS float* scr = (LAS float*)(F.lds + F.wave * 16384);
    for (int j = 0; j < NJOBS; ++j) {
        const Job J = make_job(j, ap);
        const int nitems = (J.K / 64) * (J.ncols / 64);
        for (int it = F.gw; it < nitems; it += F.NGW) transpose_item(J, scr, it, F.lane);
    }
    float* rope = (float*)(ap->ws + WS_ROPE);
    for (int idx = F.bx * NTHREADS + F.tid; idx < ROPE_ROWS * 64; idx += F.G * NTHREADS) {
        const int p = idx >> 6, i = idx & 63;
        const float inv = powf(10000.0f, -(float)i / 64.0f), ang = (float)p * inv;
        float sn, cs; sincosf(ang, &sn, &cs);
        rope[2 * idx] = cs; rope[2 * idx + 1] = sn;
    }
    float* cb = (float*)(ap->ws + WS_CB);
    for (int idx = F.gw; idx < 4 * 256; idx += F.NGW) {
        const int q = idx >> 8, c = idx & 255;
        const float* pos = ap->in[26] + (size_t)q * 4096; const float* w1 = ap->in[27] + (size_t)q * 4096 * 256 + c;
        float s = 0.f;
#pragma unroll 16
        for (int f = F.lane; f < 4096; f += 64) s += pos[f] * w1[(size_t)f * 256];
        s = wave_sum(s);
        if (F.lane == 0) cb[idx] = s + ap->in[28][idx];
    }
    { bf16_t* wsk = (bf16_t*)(ap->ws + WS_WSK);
      for (int idx = F.bx * NTHREADS + F.tid; idx < 4 * 64 * D; idx += F.G * NTHREADS) {
          const int q = idx / (64 * D), r = idx - q * 64 * D, n = r / D, k = r - n * D;
          const float* src = q < 2 ? ap->in[10] + (size_t)q * D * AB_COLS + (size_t)k * AB_COLS + 3072 : ap->in[22] + (size_t)(q - 2) * D * C_COLS + (size_t)k * C_COLS + 5120;
          const int nj = q < 2 ? 8 : 48;
          const float gk = ap->in[5][(size_t)(q < 2 ? 2 * q : 2 * (q - 2) + 1) * D + k];
          wsk[idx] = n < nj ? (bf16_t)f2bf(src[n] * gk) : (bf16_t)0; } }
    { bf16_t* HB = (bf16_t*)(ap->ws + WS_HN); float* ssq0 = (float*)(ap->ws + WS_SSQP);
      for (int row = F.gw; row < T; row += F.NGW) {
          const f32x4* xr = (const f32x4*)(ap->in[0] + (size_t)row * D) + F.lane; v2u* o8 = (v2u*)(HB + (size_t)row * D) + F.lane;
          float s = 0.f;
#pragma unroll
          for (int j = 0; j < 8; ++j) { const f32x4 v = __builtin_nontemporal_load(xr + 64 * j); v2u o; o.x = pk2(v.x, v.y); o.y = pk2(v.z, v.w); o8[64 * j] = o; s += (v.x * v.x + v.y * v.y) + (v.z * v.z + v.w * v.w); }
          s = wave_sum(s);
          if (F.lane < 32) ssq0[(size_t)row * 32 + F.lane] = F.lane == 0 ? s : 0.f; } }
}

template <int NJ>
__device__ __forceinline__ void ph_skinny(Frame& F, const bf16_t* HB, const float* ssqp, const bf16_t* Wsk, float* outp) {
    for (int blk = F.bx; blk < T / 64; blk += F.G) {
        const int lane = F.lane, l15 = lane & 15, quad = lane >> 4, mt = F.wave >> 1, nt0 = (F.wave & 1) * 2;
        const bf16_t* ap_ = HB + (size_t)(blk * 64 + mt * 16 + l15) * D + 8 * quad;
        const bf16_t* b0p = Wsk + (size_t)(nt0 * 16 + l15) * D + 8 * quad; const bf16_t* b1p = b0p + (size_t)16 * D;
        f32x4 a0 = (f32x4){0.f, 0.f, 0.f, 0.f}, a1 = (f32x4){0.f, 0.f, 0.f, 0.f};
        const bool t0on = nt0 * 16 < NJ, t1on = (nt0 + 1) * 16 < NJ;
        if (t0on && t1on) {
#pragma unroll 8
            for (int ks = 0; ks < D / 32; ++ks) { const bf16x8 a = *(const bf16x8*)(ap_ + 32 * ks), b0 = *(const bf16x8*)(b0p + 32 * ks), b1 = *(const bf16x8*)(b1p + 32 * ks);
                a0 = __builtin_amdgcn_mfma_f32_16x16x32_bf16(a, b0, a0, 0, 0, 0); a1 = __builtin_amdgcn_mfma_f32_16x16x32_bf16(a, b1, a1, 0, 0, 0); }
        } else if (t0on) {
#pragma unroll 8
            for (int ks = 0; ks < D / 32; ++ks) { const bf16x8 a = *(const bf16x8*)(ap_ + 32 * ks), b0 = *(const bf16x8*)(b0p + 32 * ks);
                a0 = __builtin_amdgcn_mfma_f32_16x16x32_bf16(a, b0, a0, 0, 0, 0); }
        }
#pragma unroll
        for (int e = 0; e < 4; ++e) { const int row = blk * 64 + mt * 16 + 4 * quad + e; const int c0 = nt0 * 16 + l15, c1 = c0 + 16;
            const float rs = ssqp_rstd(ssqp, row);
            if (c0 < NJ) outp[(size_t)row * NJ + c0] = a0[e] * rs; if (c1 < NJ) outp[(size_t)row * NJ + c1] = a1[e] * rs; }
    }
}

__device__ __forceinline__ void panel_rstd(Frame& F, const float* ssqp, int pm, LAS float* rsl) {
    const int row = pm * 256 + (F.tid >> 1); const f32x4* p = (const f32x4*)(ssqp + (size_t)row * 32 + (F.tid & 1) * 16); float s = 0.f;
#pragma unroll
    for (int q = 0; q < 4; ++q) { const f32x4 v = p[q]; s += (v.x + v.y) + (v.z + v.w); }
    const float o = DPP_F(s, 0xB1);
    const float t = (F.tid & 1) ? o + s : s + o;
    if ((F.tid & 1) == 0) rsl[F.tid >> 1] = __builtin_amdgcn_rsqf(t * (1.0f / 2048.0f) + 1e-6f);
    __syncthreads();
}

__device__ __forceinline__ void unpack8(const v4u u, float (&f)[8]) { f[0] = bflo(u.x); f[1] = bfhi(u.x); f[2] = bflo(u.y); f[3] = bfhi(u.y); f[4] = bflo(u.z); f[5] = bfhi(u.z); f[6] = bflo(u.w); f[7] = bfhi(u.w); }
__device__ __forceinline__ void ph_conv(Frame& F, const bf16_t* P, const float* cw, const float* cbias, bf16_t* cbuf) {
    const int idx0 = F.bx * NTHREADS + F.tid, c0 = (idx0 & 127) * 8, stride = F.G * NTHREADS;
    if ((stride & 127) != 0) {
        for (int idx = idx0; idx < T * 128; idx += stride) { const int t = idx >> 7, cc = (idx & 127) * 8, tl = t & (SEQ - 1); float acc[8];
#pragma unroll
            for (int e = 0; e < 8; ++e) acc[e] = cbias[cc + e];
#pragma unroll
            for (int jj = 0; jj < 4; ++jj) { if (tl - 3 + jj >= 0) { float uf[8]; unpack8(*(const v4u*)(P + (size_t)(t - 3 + jj) * AB_N + cc), uf);
#pragma unroll
                    for (int e = 0; e < 8; ++e) acc[e] += uf[e] * cw[jj * 1024 + cc + e]; } }
            v4u o; o.x = pk2(siluf_(acc[0]), siluf_(acc[1])); o.y = pk2(siluf_(acc[2]), siluf_(acc[3])); o.z = pk2(siluf_(acc[4]), siluf_(acc[5])); o.w = pk2(siluf_(acc[6]), siluf_(acc[7]));
            *(v4u*)(cbuf + (size_t)t * 1024 + cc) = o; }
        return; }
    float wt[4][8], bs[8];
#pragma unroll
    for (int e = 0; e < 8; ++e) { bs[e] = cbias[c0 + e];
#pragma unroll
        for (int jj = 0; jj < 4; ++jj) wt[jj][e] = cw[jj * 1024 + c0 + e]; }
    const int tstride = stride >> 7;
    for (int t0 = idx0 >> 7; t0 < T; t0 += 4 * tstride) {
        v4u in[4][4];
#pragma unroll
        for (int u = 0; u < 4; ++u) { const int t = t0 + u * tstride, tl = t & (SEQ - 1);
#pragma unroll
            for (int jj = 0; jj < 4; ++jj) { in[u][jj] = (v4u){0u, 0u, 0u, 0u}; if (t < T && tl - 3 + jj >= 0) in[u][jj] = *(const v4u*)(P + (size_t)(t - 3 + jj) * AB_N + c0); } }
#pragma unroll
        for (int u = 0; u < 4; ++u) { const int t = t0 + u * tstride;
            if (t < T) { float acc[8];
#pragma unroll
                for (int e = 0; e < 8; ++e) acc[e] = bs[e];
#pragma unroll
                for (int jj = 0; jj < 4; ++jj) { float uf[8]; unpack8(in[u][jj], uf);
#pragma unroll
                    for (int e = 0; e < 8; ++e) acc[e] += uf[e] * wt[jj][e]; }
                v4u o; o.x = pk2(siluf_(acc[0]), siluf_(acc[1])); o.y = pk2(siluf_(acc[2]), siluf_(acc[3])); o.z = pk2(siluf_(acc[4]), siluf_(acc[5])); o.w = pk2(siluf_(acc[6]), siluf_(acc[7]));
                *(v4u*)(cbuf + (size_t)t * 1024 + c0) = o; } }
    }
}

#ifndef CK_DUP_ML3
#define CK_DUP_ML3 0
#endif
#ifndef CK_DUP_HG3
#define CK_DUP_HG3 0
#endif
namespace ck {
typedef short s16x4 __attribute__((ext_vector_type(4)));
constexpr int CL = 64;
constexpr int NCH = SEQ / CL;
constexpr int NU_ML = BATCH * 4 * NCH, NU_HG = BATCH * 8 * NCH;
__device__ __forceinline__ bf16x8 frag_rowk(const LAS bf16_t* base, int pitch, int r0, int k0, int lane) { return *(const LAS bf16x8*)(base + (r0 + (lane & 15)) * pitch + k0 + 8 * (lane >> 4)); }
__device__ __forceinline__ bf16x8 frag_rowk_g(const bf16_t* base, int ld, int r0, int k0, int lane) { return *(const bf16x8*)(base + (size_t)(r0 + (lane & 15)) * ld + k0 + 8 * (lane >> 4)); }
__device__ __forceinline__ bf16x8 frag_tr(const LAS bf16_t* base, int pitch, int k0, int c0, int lane) {
    const int i = lane & 15, quad = lane >> 4;
    const unsigned a0 = (unsigned)(uintptr_t)(base + (k0 + 8 * quad + (i >> 2)) * pitch + c0 + 4 * (i & 3));
    s16x4 lo, hi;
    asm volatile("ds_read_b64_tr_b16 %0, %1" : "=&v"(lo) : "v"(a0) : "memory");
    asm volatile("ds_read_b64_tr_b16 %0, %1" : "=&v"(hi) : "v"(a0 + (unsigned)(4 * pitch * 2)) : "memory");
    asm volatile("s_waitcnt lgkmcnt(0)" : "+v"(lo), "+v"(hi) :: "memory");
    return (bf16x8){lo[0], lo[1], lo[2], lo[3], hi[0], hi[1], hi[2], hi[3]};
}
#define MMA16(a, b, c) __builtin_amdgcn_mfma_f32_16x16x32_bf16((a), (b), (c), 0, 0, 0)
__device__ __forceinline__ float log_sig(float x) { return fminf(x, 0.f) - log1pf(expf(-fabsf(x))); }
__device__ __forceinline__ void hg_gate(float z, float one_minus_lb, float& k2, float& lf) {
    const float e = __expf(-fabsf(z)), r = __builtin_amdgcn_rcpf(1.0f + e), sp = __logf(1.0f + e);
    k2 = one_minus_lb * (z >= 0.f ? e * r : r);
    const float t = fminf(k2, 0.999999f);
    const float la = t < 0.0625f ? -t * (1.0f + t * (0.5f + t * (0.33333334f + t * 0.25f))) : __logf(1.0f - t);
    lf = fmaxf(la, fminf(z, 0.f) - sp);
}
__device__ __forceinline__ float wave_scan_add(float x, LAS float* sc, int lane) {
#pragma unroll
    for (int o = 1; o < 64; o <<= 1) { sc[lane] = x; asm volatile("s_waitcnt lgkmcnt(0)" ::: "memory"); const float y = sc[lane >= o ? lane - o : lane]; asm volatile("s_waitcnt lgkmcnt(0)" ::: "memory"); x += lane >= o ? y : 0.f; }
    return x;
}
__device__ __forceinline__ float wave_scan_max(float x, LAS float* sc, int lane) {
#pragma unroll
    for (int o = 1; o < 64; o <<= 1) { sc[lane] = x; asm volatile("s_waitcnt lgkmcnt(0)" ::: "memory"); const float y = sc[lane >= o ? lane - o : lane]; asm volatile("s_waitcnt lgkmcnt(0)" ::: "memory"); x = lane >= o ? fmaxf(x, y) : x; }
    return x;
}
}

__device__ __forceinline__ void ph_chunk_r1(Frame& F, const bf16_t* P, const bf16_t* QK, const float* gif, const float* i_bias, const float* f_bias, const float* lb_logits, int jpair,
                                            bf16_t* CST, float* NST, float* SCL  , bf16_t* SST, float* HDEC) {
    using namespace ck;
    LAS unsigned char* lds = F.lds;
    for (int u = F.bx; u < NU_ML + NU_HG; u += F.G) {
        int tid = F.tid; asm volatile("" : "+v"(tid));
        const int lane = tid & 63, w = __builtin_amdgcn_readfirstlane(tid >> 6);
        if (u < NU_ML) {
            const int bh = u / NCH, j = u - bh * NCH, b = bh >> 2, hh = bh & 3, t0 = b * SEQ + j * CL;
            constexpr int PT = 264;
            LAS bf16_t* Vs = (LAS bf16_t*)lds;
            LAS bf16_t* Ks = Vs + 64 * PT;
            LAS float* av = (LAS float*)(Ks + 64 * PT);
            v4u kq[4], vq[4];
            { const int s = tid >> 3, c0 = (tid & 7) * 32;
              const bf16_t* kp = QK + (size_t)(t0 + s) * 2048 + 1024 + hh * 256 + c0; const bf16_t* vp = P + (size_t)(t0 + s) * AB_N + 1024 + hh * 256 + c0;
#pragma unroll
              for (int q = 0; q < 4; ++q) { kq[q] = *(const v4u*)(kp + 8 * q); vq[q] = *(const v4u*)(vp + 8 * q); } }
            if (w == 0) {
                const float ig = gif[(size_t)(t0 + lane) * 8 + hh] + i_bias[hh];
                const float lf = log_sig(gif[(size_t)(t0 + lane) * 8 + 4 + hh] + f_bias[hh]);
                const float bsum = wave_scan_add(lf, av, lane);
                av[lane] = bsum; LDS_WAIT(); const float g = av[63]; LDS_WAIT();
                const float upd = g - bsum + ig, mloc = wave_max(upd);
                av[lane] = expf(upd - mloc);
                if (lane == 0) { SCL[u * 4 + 0] = g; SCL[u * 4 + 1] = mloc; }
            }
            __syncthreads();
            { const int s = tid >> 3, c0 = (tid & 7) * 32; const float a = av[s];
#pragma unroll
              for (int q = 0; q < 4; ++q) { *(LAS v4u*)(Ks + s * PT + c0 + 8 * q) = kq[q];
                  float f[8]; unpack8(vq[q], f); v4u o; o.x = pk2(f[0] * a, f[1] * a); o.y = pk2(f[2] * a, f[3] * a); o.z = pk2(f[4] * a, f[5] * a); o.w = pk2(f[6] * a, f[7] * a);
                  *(LAS v4u*)(Vs + s * PT + c0 + 8 * q) = o; } }
            __syncthreads();
            if (tid < 256) { float s = 0.f;
                for (int ss = 0; ss < 64; ++ss) s += av[ss] * bf2f(Ks[ss * PT + tid]);
                NST[(size_t)u * 256 + tid] = s; }
            f32x4 acc[16][2];
#pragma unroll
            for (int m = 0; m < 16; ++m) { acc[m][0] = (f32x4){0.f, 0.f, 0.f, 0.f}; acc[m][1] = (f32x4){0.f, 0.f, 0.f, 0.f}; }
#pragma unroll
            for (int ks = 0; ks < 2; ++ks) {
                const bf16x8 b0 = frag_tr(Vs, PT, 32 * ks, 32 * w, lane), b1 = frag_tr(Vs, PT, 32 * ks, 32 * w + 16, lane);
#pragma unroll
                for (int m = 0; m < 16; ++m) { const bf16x8 a = frag_tr(Ks, PT, 32 * ks, 16 * m, lane); acc[m][0] = MMA16(a, b0, acc[m][0]); acc[m][1] = MMA16(a, b1, acc[m][1]); }
            }
            { char* cp = (char*)(CST + (size_t)u * 65536 + (size_t)(32 * w) * 256);
              const unsigned lo0 = (unsigned)(((lane & 15) * 256 + 4 * (lane >> 4)) * 2);
#pragma unroll
              for (int m = 0; m < 16; ++m)
#pragma unroll
                  for (int n = 0; n < 2; ++n) { v2u o; o.x = pk2(acc[m][n][0], acc[m][n][1]); o.y = pk2(acc[m][n][2], acc[m][n][3]); *(v2u*)(cp + (lo0 + (unsigned)((16 * n * 256 + 16 * m) * 2))) = o; } }
            __syncthreads();
        } else {
            const int uu = u - NU_ML, bh = uu / NCH, j = uu - bh * NCH, b = bh >> 3, hh = bh & 7, t0 = b * SEQ + j * CL;
            constexpr int PT = 136;
            LAS float* bS = (LAS float*)lds;
            LAS bf16_t* Kt = (LAS bf16_t*)(bS + 64 * 128);
            LAS bf16_t* Vt = Kt + 64 * PT;
            float k2r[16];
            { const int s = tid >> 3, c0 = (tid & 7) * 16; const bf16_t* pp = P + (size_t)(t0 + s) * AB_N + hh * 128 + c0;
#pragma unroll
              for (int q = 0; q < 2; ++q) { float hf[8]; unpack8(*(const v4u*)(pp + 4096 + 8 * q), hf);
                  *(LAS v4u*)(Vt + s * PT + c0 + 8 * q) = *(const v4u*)(pp + 5120 + 8 * q);
#pragma unroll
                  for (int e = 0; e < 8; ++e) { const int cg = hh * 128 + c0 + 8 * q + e;
                      const float oml = jpair == 0 ? 1.0f : 1.0f - sigmoidf_(lb_logits[1024 + cg] - lb_logits[cg]);
                      float k2, lf; hg_gate(hf[e], oml, k2, lf);
                      k2r[8 * q + e] = k2; bS[s * 128 + c0 + 8 * q + e] = lf; } } }
            __syncthreads();
            { const int c = tid & 127, p = tid >> 7; LAS float* tot = (LAS float*)(Vt + 64 * PT);
              float acc = 0.f;
#pragma unroll
              for (int s = 0; s < 16; ++s) { acc += bS[(16 * p + s) * 128 + c]; bS[(16 * p + s) * 128 + c] = acc; }
              tot[p * 128 + c] = acc;
              __syncthreads();
              float off = 0.f;
#pragma unroll
              for (int pp = 0; pp < 3; ++pp) off += pp < p ? tot[pp * 128 + c] : 0.f;
              if (p > 0) {
#pragma unroll
                  for (int s = 0; s < 16; ++s) bS[(16 * p + s) * 128 + c] += off; }
              if (p == 3) HDEC[(size_t)uu * 128 + c] = __expf(off + acc); }
            __syncthreads();
            { const int s = tid >> 3, c0 = (tid & 7) * 16;
#pragma unroll
              for (int q = 0; q < 2; ++q) { float r[8];
#pragma unroll
                  for (int e = 0; e < 8; ++e) { const int c = c0 + 8 * q + e; r[e] = k2r[8 * q + e] * __expf(bS[63 * 128 + c] - bS[s * 128 + c]); }
                  v4u o; o.x = pk2(r[0], r[1]); o.y = pk2(r[2], r[3]); o.z = pk2(r[4], r[5]); o.w = pk2(r[6], r[7]); *(LAS v4u*)(Kt + s * PT + c0 + 8 * q) = o; } }
            __syncthreads();
            f32x4 acc[8];
#pragma unroll
            for (int m = 0; m < 8; ++m) acc[m] = (f32x4){0.f, 0.f, 0.f, 0.f};
#pragma unroll
            for (int ks = 0; ks < 2; ++ks) { const bf16x8 bb = frag_tr(Vt, PT, 32 * ks, 16 * w, lane);
#pragma unroll
                for (int m = 0; m < 8; ++m) { const bf16x8 a = frag_tr(Kt, PT, 32 * ks, 16 * m, lane); acc[m] = MMA16(a, bb, acc[m]); } }
            { char* sp = (char*)(SST + (size_t)uu * 16384 + (size_t)(16 * w) * 128);
              const unsigned lo0 = (unsigned)(((lane & 15) * 128 + 4 * (lane >> 4)) * 2);
#pragma unroll
              for (int m = 0; m < 8; ++m) { v2u o; o.x = pk2(acc[m][0], acc[m][1]); o.y = pk2(acc[m][2], acc[m][3]); *(v2u*)(sp + (lo0 + (unsigned)(16 * m * 2))) = o; } }
            __syncthreads();
        }
    }
}

__device__ __forceinline__ void ph_chunk_r2(Frame& F, bf16_t* CST, float* NST, float* SCL, bf16_t* SST, const float* HDEC) {
    using namespace ck;
    for (int vb = F.bx; vb < 200; vb += F.G) {
    const int gt = vb * NTHREADS + F.tid;
    if (gt < 65536) {
        const int bh = gt >> 13; const size_t e8 = (size_t)(gt & 8191) * 8;
        float C[8]; float m = 0.f;
#pragma unroll
        for (int e = 0; e < 8; ++e) C[e] = 0.f;
        bf16_t* base = CST + (size_t)bh * NCH * 65536 + e8;
        for (int j0 = 0; j0 < NCH; j0 += 4) {
            v4u d[4]; float gg[4], ml[4];
#pragma unroll
            for (int q = 0; q < 4; ++q) { d[q] = *(const v4u*)(base + (size_t)(j0 + q) * 65536); gg[q] = SCL[(bh * NCH + j0 + q) * 4 + 0]; ml[q] = SCL[(bh * NCH + j0 + q) * 4 + 1]; }
#pragma unroll
            for (int q = 0; q < 4; ++q) {
                v4u o; o.x = pk2(C[0], C[1]); o.y = pk2(C[2], C[3]); o.z = pk2(C[4], C[5]); o.w = pk2(C[6], C[7]);
                *(v4u*)(base + (size_t)(j0 + q) * 65536) = o;
                if ((gt & 8191) == 0) SCL[(bh * NCH + j0 + q) * 4 + 2] = m;
                const float mn = fmaxf(gg[q] + m, ml[q]), a = __expf(gg[q] + m - mn), bc = __expf(ml[q] - mn);
                float f[8]; unpack8(d[q], f);
#pragma unroll
                for (int e = 0; e < 8; ++e) C[e] = a * C[e] + bc * f[e];
                m = mn; }
        }
    } else if (gt < 65536 + 2048) {
        const int idx = gt - 65536, bh = idx >> 8, k = idx & 255; float n = 0.f, m = 0.f;
        for (int j = 0; j < NCH; ++j) { const int u = bh * NCH + j; const float d = NST[(size_t)u * 256 + k], gg = SCL[u * 4 + 0], ml = SCL[u * 4 + 1];
            NST[(size_t)u * 256 + k] = n;
            const float mn = fmaxf(gg + m, ml); n = __expf(gg + m - mn) * n + __expf(ml - mn) * d; m = mn; }
    } else if (gt >= 136 * NTHREADS && gt < 136 * NTHREADS + 32768) {
        const int i = gt - 136 * NTHREADS, bh = i >> 11; const size_t e8 = (size_t)(i & 2047) * 8; const int c0 = (int)(e8 & 127);
        float S[8];
#pragma unroll
        for (int e = 0; e < 8; ++e) S[e] = 0.f;
        bf16_t* base = SST + (size_t)bh * NCH * 16384 + e8; const float* hd = HDEC + (size_t)bh * NCH * 128 + c0;
        for (int j0 = 0; j0 < NCH; j0 += 4) {
            v4u d[4]; f32x4 da[4], db[4];
#pragma unroll
            for (int q = 0; q < 4; ++q) { d[q] = *(const v4u*)(base + (size_t)(j0 + q) * 16384); da[q] = *(const f32x4*)(hd + (size_t)(j0 + q) * 128); db[q] = *(const f32x4*)(hd + (size_t)(j0 + q) * 128 + 4); }
#pragma unroll
            for (int q = 0; q < 4; ++q) {
                v4u o; o.x = pk2(S[0], S[1]); o.y = pk2(S[2], S[3]); o.z = pk2(S[4], S[5]); o.w = pk2(S[6], S[7]);
                *(v4u*)(base + (size_t)(j0 + q) * 16384) = o;
                float f[8]; unpack8(d[q], f);
#pragma unroll
                for (int e = 0; e < 4; ++e) { S[e] = da[q][e] * S[e] + f[e]; S[4 + e] = db[q][e] * S[4 + e] + f[4 + e]; } }
        }
    }
    }
}

__device__ __forceinline__ void ph_chunk_r3(Frame& F, const bf16_t* P, const bf16_t* QK, const bf16_t* cbuf, const float* gif, const float* i_bias, const float* f_bias, const float* lb_logits, int jpair,
                                            const bf16_t* CST, const float* NST, const float* SCL, const bf16_t* SST,
                                            const float* ml_norm, const float* ml_skip, const float* hg_norm, bf16_t* Y) {
    using namespace ck;
    LAS unsigned char* lds = F.lds;
    for (int u = F.bx; u < NU_ML + NU_HG; u += F.G) {
        int tid = F.tid; asm volatile("" : "+v"(tid));
        const int lane = tid & 63, w = __builtin_amdgcn_readfirstlane(tid >> 6), quad = lane >> 4, l15 = lane & 15;
        if (u < NU_ML) { for (int rep_ = 0; rep_ < 1 + CK_DUP_ML3; ++rep_) {
            const int bh = u / NCH, j = u - bh * NCH, b = bh >> 2, hh = bh & 3, t0 = b * SEQ + j * CL;
            constexpr int PT = 264, PW = 72;
            LAS bf16_t* Qs = (LAS bf16_t*)lds; LAS bf16_t* Ks = Qs + 64 * PT; LAS bf16_t* Vs = Ks + 64 * PT; LAS bf16_t* Ws = Vs + 64 * PT;
            LAS float* vec = (LAS float*)(Ws + 64 * PW);
            LAS float* bv = vec, *uv = vec + 64, *rv = vec + 128, *wl = vec + 192, *emt = vec + 256, *qnv = vec + 320, *tmp = vec + 384, *rstd = vec + 448, *part = vec + 512;
            const float mj = SCL[u * 4 + 2];
            bf16x8 cfr[8][2];
            { const bf16_t* Cj = CST + (size_t)u * 65536;
#pragma unroll
              for (int ks = 0; ks < 8; ++ks) { cfr[ks][0] = frag_rowk_g(Cj, 256, 32 * w, 32 * ks, lane); cfr[ks][1] = frag_rowk_g(Cj, 256, 32 * w + 16, 32 * ks, lane); } }
            LAS float* nsl = part + 512;
            if (tid < 64) *(LAS f32x4*)(nsl + 4 * tid) = *(const f32x4*)(NST + (size_t)u * 256 + 4 * tid);
            float ig_raw = 0.f, fg_raw = 0.f;
            if (w == 0) { ig_raw = gif[(size_t)(t0 + lane) * 8 + hh]; fg_raw = gif[(size_t)(t0 + lane) * 8 + 4 + hh]; }
            { const int s = tid >> 3, c0 = (tid & 7) * 32;
              const bf16_t* qp = QK + (size_t)(t0 + s) * 2048 + hh * 256 + c0; const bf16_t* vp = P + (size_t)(t0 + s) * AB_N + 1024 + hh * 256 + c0;
#pragma unroll
              for (int q = 0; q < 4; ++q) { *(LAS v4u*)(Qs + s * PT + c0 + 8 * q) = *(const v4u*)(qp + 8 * q); *(LAS v4u*)(Ks + s * PT + c0 + 8 * q) = *(const v4u*)(qp + 1024 + 8 * q);
                  *(LAS v4u*)(Vs + s * PT + c0 + 8 * q) = *(const v4u*)(vp + 8 * q); }
              { unsigned z0 = 0u; asm volatile("" : "+v"(z0)); *(LAS v4u*)(Ws + s * PW + (tid & 7) * 8) = (v4u){z0, z0, z0, z0}; } }
            if (w == 0) {
                const float ig = ig_raw + i_bias[hh];
                const float lf = log_sig(fg_raw + f_bias[hh]);
                const float bsum = wave_scan_add(lf, tmp, lane);
                const float uu = ig - bsum;
                const float cm = wave_scan_max(uu, tmp, lane);
                const float r = -fmaxf(mj, cm);
                bv[lane] = bsum; uv[lane] = uu; rv[lane] = r; wl[lane] = expf(mj + r); emt[lane] = expf(r - bsum);
            }
            __syncthreads();
            { const int l = tid >> 3, k0 = (tid & 7) * 32; float acc = 0.f;
#pragma unroll 8
              for (int k = 0; k < 32; ++k) acc += nsl[k0 + k] * bf2f(Qs[l * PT + k0 + k]);
              acc += DPP_F(acc, 0xB1); acc += DPP_F(acc, 0x4E); acc += DPP_F(acc, 0x141);
              if ((tid & 7) == 0) qnv[l] = acc; }
            for (int ti = w; ti < 10; ti += 8) {
                const int lt = ti < 1 ? 0 : ti < 3 ? 1 : ti < 6 ? 2 : 3, st = ti - (lt * (lt + 1)) / 2;
                f32x4 acc = (f32x4){0.f, 0.f, 0.f, 0.f};
#pragma unroll
                for (int ks = 0; ks < 8; ++ks) acc = MMA16(frag_rowk(Ks, PT, 16 * st, 32 * ks, lane), frag_rowk(Qs, PT, 16 * lt, 32 * ks, lane), acc);
                const int l = 16 * lt + l15, s0 = 16 * st + 4 * quad; const float rl = rv[l]; float wv[4];
#pragma unroll
                for (int e = 0; e < 4; ++e) wv[e] = (s0 + e <= l) ? acc[e] * __expf(rl + uv[s0 + e]) : 0.f;
                v2u o; o.x = pk2(wv[0], wv[1]); o.y = pk2(wv[2], wv[3]); *(LAS v2u*)(Ws + l * PW + s0) = o;
            }
            __syncthreads();
            f32x4 ai[4][2], ax[4][2], ad[4];
#pragma unroll
            for (int m = 0; m < 4; ++m) { ad[m] = (f32x4){0.f, 0.f, 0.f, 0.f};
#pragma unroll
                for (int n = 0; n < 2; ++n) { ai[m][n] = (f32x4){0.f, 0.f, 0.f, 0.f}; ax[m][n] = (f32x4){0.f, 0.f, 0.f, 0.f}; } }
            { unsigned o1 = 0x3F803F80u; asm volatile("" : "+v"(o1)); const v4u ow = {o1, o1, o1, o1}; const bf16x8 ones = __builtin_bit_cast(bf16x8, ow);
#pragma unroll
              for (int ks = 0; ks < 2; ++ks) { const bf16x8 b0 = frag_tr(Vs, PT, 32 * ks, 32 * w, lane), b1 = frag_tr(Vs, PT, 32 * ks, 32 * w + 16, lane);
#pragma unroll
                  for (int m = 0; m < 4; ++m) { const bf16x8 a = frag_rowk(Ws, PW, 16 * m, 32 * ks, lane); ai[m][0] = MMA16(a, b0, ai[m][0]); ai[m][1] = MMA16(a, b1, ai[m][1]); ad[m] = MMA16(a, ones, ad[m]); } } }
            {
#pragma unroll
              for (int ks = 0; ks < 8; ++ks) { const bf16x8 b0 = cfr[ks][0], b1 = cfr[ks][1];
#pragma unroll
                  for (int m = 0; m < 4; ++m) { const bf16x8 a = frag_rowk(Qs, PT, 16 * m, 32 * ks, lane); ax[m][0] = MMA16(a, b0, ax[m][0]); ax[m][1] = MMA16(a, b1, ax[m][1]); } } }
            v4u gcc[4], gop[4];
            { const int l = tid >> 3, v0 = (tid & 7) * 32; const size_t tk = (size_t)(t0 + l); const int col0 = hh * 256 + v0;
#pragma unroll
              for (int q = 0; q < 4; ++q) { gcc[q] = *(const v4u*)(cbuf + tk * 1024 + col0 + 8 * q); gop[q] = *(const v4u*)(P + tk * AB_N + 2048 + col0 + 8 * q); } }
            float hv[4][2][4];
#pragma unroll
            for (int m = 0; m < 4; ++m)
#pragma unroll
                for (int e = 0; e < 4; ++e) { const int l = 16 * m + 4 * quad + e; const float wi = wl[l], den = fmaxf(fabsf(ad[m][e] + wi * qnv[l]), emt[l]), inv = __builtin_amdgcn_rcpf(den);
                    hv[m][0][e] = (ai[m][0][e] + wi * ax[m][0][e]) * inv; hv[m][1][e] = (ai[m][1][e] + wi * ax[m][1][e]) * inv;
                    const float ss = row16_sum(hv[m][0][e] * hv[m][0][e] + hv[m][1][e] * hv[m][1][e]);
                    if (l15 == 0) part[w * 64 + l] = ss; }
            __syncthreads();
            if (tid < 64) { float t = 0.f;
#pragma unroll
                for (int ww = 0; ww < 8; ++ww) t += part[ww * 64 + tid];
                rstd[tid] = 1.0f / sqrtf(t * (1.0f / 256.0f) + NORM_EPS); }
            __syncthreads();
            { constexpr int PH = 264; LAS float* hs = (LAS float*)lds;
#pragma unroll
              for (int m = 0; m < 4; ++m)
#pragma unroll
                  for (int e = 0; e < 4; ++e) { const int l = 16 * m + 4 * quad + e; const float rs = rstd[l];
                      hs[l * PH + 32 * w + l15] = hv[m][0][e] * rs; hs[l * PH + 32 * w + 16 + l15] = hv[m][1][e] * rs; }
              __syncthreads();
              const int l = tid >> 3, v0 = (tid & 7) * 32; const size_t tk = (size_t)(t0 + l); const int col0 = hh * 256 + v0;
#pragma unroll
              for (int q = 0; q < 4; ++q) { float cc[8], op[8]; unpack8(gcc[q], cc); unpack8(gop[q], op);
                  const f32x4 h0 = *(const LAS f32x4*)(hs + l * PH + v0 + 8 * q), h1 = *(const LAS f32x4*)(hs + l * PH + v0 + 8 * q + 4);
                  const f32x4 n0 = *(const f32x4*)(ml_norm + col0 + 8 * q), n1 = *(const f32x4*)(ml_norm + col0 + 8 * q + 4), k0 = *(const f32x4*)(ml_skip + col0 + 8 * q), k1 = *(const f32x4*)(ml_skip + col0 + 8 * q + 4);
                  float r[8];
#pragma unroll
                  for (int e = 0; e < 4; ++e) { r[e] = sigmoidf_(op[e]) * (h0[e] * n0[e] + k0[e] * cc[e]); r[4 + e] = sigmoidf_(op[4 + e]) * (h1[e] * n1[e] + k1[e] * cc[4 + e]); }
                  v4u o; o.x = pk2(r[0], r[1]); o.y = pk2(r[2], r[3]); o.z = pk2(r[4], r[5]); o.w = pk2(r[6], r[7]); *(v4u*)(Y + tk * 2048 + col0 + 8 * q) = o; } }
            __syncthreads(); }
        } else { for (int rep_ = 0; rep_ < 1 + CK_DUP_HG3; ++rep_) {
            const int uu = u - NU_ML, bh = uu / NCH, j = uu - bh * NCH, b = bh >> 3, hh = bh & 7, t0 = b * SEQ + j * CL;
            constexpr int PT = 136, PA = 72;
            constexpr int BP = 65;
            LAS float* bT = (LAS float*)lds;
            constexpr int QP = 129;
            LAS float* qf = bT + 128 * BP;
            LAS bf16_t* kT = (LAS bf16_t*)(qf + 64 * QP);
            LAS bf16_t* qh = kT + 128 * 64;
            LAS bf16_t* Vt = qh + 64 * PT;
            LAS bf16_t* At = Vt + 64 * PT;
            LAS float* part = (LAS float*)(At + 64 * PA);
            LAS float* rstd = part + 512;
            bf16x8 sfr[4];
            { const bf16_t* Sj = SST + (size_t)uu * 16384;
#pragma unroll
              for (int ks = 0; ks < 4; ++ks) sfr[ks] = frag_rowk_g(Sj, 128, 16 * w, 32 * ks, lane); }
            { const int s = tid >> 3, c0 = (tid & 7) * 16; const bf16_t* pp = P + (size_t)(t0 + s) * AB_N + hh * 128 + c0;
#pragma unroll
              for (int q = 0; q < 2; ++q) { float hq[8], hf[8]; unpack8(*(const v4u*)(pp + 3072 + 8 * q), hq); unpack8(*(const v4u*)(pp + 4096 + 8 * q), hf);
                  *(LAS v4u*)(Vt + s * PT + c0 + 8 * q) = *(const v4u*)(pp + 5120 + 8 * q);
                  if (q == 0) { unsigned z0 = 0u; asm volatile("" : "+v"(z0)); *(LAS v4u*)(At + s * PA + (tid & 7) * 8) = (v4u){z0, z0, z0, z0}; }
#pragma unroll
                  for (int e = 0; e < 8; ++e) { const int c = c0 + 8 * q + e, cg = hh * 128 + c;
                      const float oml = jpair == 0 ? 1.0f : 1.0f - sigmoidf_(lb_logits[1024 + cg] - lb_logits[cg]);
                      float k2, lf; hg_gate(hf[e], oml, k2, lf);
                      bT[c * BP + s] = lf * 1.4426950408889634f; kT[c * 64 + s] = (bf16_t)f2bf(k2);        qf[s * QP + c] = hq[e] * __builtin_amdgcn_rcpf(1.0f + __expf(-hq[e])); } } }
            __syncthreads();
            { const int c = tid & 127, p = tid >> 7; LAS float* tot = part;
              float acc = 0.f;
#pragma unroll
              for (int s = 0; s < 16; ++s) { acc += bT[c * BP + 16 * p + s]; bT[c * BP + 16 * p + s] = acc; }
              tot[p * 128 + c] = acc;
              __syncthreads();
              float off = 0.f;
#pragma unroll
              for (int pp = 0; pp < 3; ++pp) off += pp < p ? tot[pp * 128 + c] : 0.f;
              if (p > 0) {
#pragma unroll
                  for (int s = 0; s < 16; ++s) bT[c * BP + 16 * p + s] += off; } }
            __syncthreads();
            { const int l = tid >> 3, c0 = (tid & 7) * 16;
              float dg = 0.f;
#pragma unroll
              for (int q = 0; q < 2; ++q) { float r[8];
#pragma unroll
                  for (int e = 0; e < 8; ++e) { const int c = c0 + 8 * q + e; const float qv = qf[l * QP + c]; r[e] = qv * __builtin_amdgcn_exp2f(bT[c * BP + l]); dg += qv * bf2f(kT[c * 64 + l]); }
                  v4u o; o.x = pk2(r[0], r[1]); o.y = pk2(r[2], r[3]); o.z = pk2(r[4], r[5]); o.w = pk2(r[6], r[7]); *(LAS v4u*)(qh + l * PT + c0 + 8 * q) = o; }
              dg += DPP_F(dg, 0xB1); dg += DPP_F(dg, 0x4E); dg += DPP_F(dg, 0x141);
              if ((tid & 7) == 0) At[l * PA + l] = (bf16_t)f2bf(dg); }
            if (tid < 480) { const int I = tid / 120, p = tid - I * 120; int lr = (int)((1.0f + sqrtf(1.0f + 8.0f * (float)p)) * 0.5f);
              lr = (lr * (lr - 1)) / 2 > p ? lr - 1 : lr; lr = ((lr + 1) * lr) / 2 <= p ? lr + 1 : lr;
              const int lA = 16 * I + lr, sA = 16 * I + (p - (lr * (lr - 1)) / 2); float a0 = 0.f;
#pragma unroll 4
              for (int c = 0; c < 128; ++c) a0 += qf[lA * QP + c] * bf2f(kT[c * 64 + sA]) * __builtin_amdgcn_exp2f(bT[c * BP + lA] - bT[c * BP + sA]);
              At[lA * PA + sA] = (bf16_t)f2bf(a0); }
            if (w < 6) { const int I = w < 3 ? w + 1 : (w < 5 ? w - 1 : 3), J = w < 3 ? 0 : (w < 5 ? 1 : 2);
                const int sA = 16 * J + l15, lB = 16 * I + l15, eJ = 16 * J + 15;
                f32x4 acc = (f32x4){0.f, 0.f, 0.f, 0.f};
#pragma unroll
                for (int ks = 0; ks < 4; ++ks) { float fa[8], fb[8];
#pragma unroll
                    for (int e = 0; e < 8; ++e) { const int c = 32 * ks + 8 * quad + e; const float Bc = bT[c * BP + eJ];
                        fa[e] = bf2f(kT[c * 64 + sA]) * __builtin_amdgcn_exp2f(Bc - bT[c * BP + sA]); fb[e] = qf[lB * QP + c] * __builtin_amdgcn_exp2f(bT[c * BP + lB] - Bc); }
                    v4u ua, ub; ua.x = pk2(fa[0], fa[1]); ua.y = pk2(fa[2], fa[3]); ua.z = pk2(fa[4], fa[5]); ua.w = pk2(fa[6], fa[7]); ub.x = pk2(fb[0], fb[1]); ub.y = pk2(fb[2], fb[3]); ub.z = pk2(fb[4], fb[5]); ub.w = pk2(fb[6], fb[7]);
                    acc = MMA16(__builtin_bit_cast(bf16x8, ua), __builtin_bit_cast(bf16x8, ub), acc); }
                v2u o; o.x = pk2(acc[0], acc[1]); o.y = pk2(acc[2], acc[3]); *(LAS v2u*)(At + lB * PA + 16 * J + 4 * quad) = o; }
            __syncthreads();
            f32x4 ao[4];
#pragma unroll
            for (int m = 0; m < 4; ++m) ao[m] = (f32x4){0.f, 0.f, 0.f, 0.f};
#pragma unroll
            for (int ks = 0; ks < 2; ++ks) { const bf16x8 bb = frag_tr(Vt, PT, 32 * ks, 16 * w, lane);
#pragma unroll
                for (int m = 0; m < 4; ++m) ao[m] = MMA16(frag_rowk(At, PA, 16 * m, 32 * ks, lane), bb, ao[m]); }
            {
#pragma unroll
              for (int ks = 0; ks < 4; ++ks) { const bf16x8 bb = sfr[ks];
#pragma unroll
                  for (int m = 0; m < 4; ++m) ao[m] = MMA16(frag_rowk(qh, PT, 16 * m, 32 * ks, lane), bb, ao[m]); } }
            v4u ggr[2];
            { const int l = tid >> 3, v0 = (tid & 7) * 16; const size_t tk = (size_t)(t0 + l); const int col0 = hh * 128 + v0;
#pragma unroll
              for (int q = 0; q < 2; ++q) ggr[q] = *(const v4u*)(P + tk * AB_N + 6144 + col0 + 8 * q); }
#pragma unroll
            for (int m = 0; m < 4; ++m)
#pragma unroll
                for (int e = 0; e < 4; ++e) { const int l = 16 * m + 4 * quad + e; const float ss = row16_sum(ao[m][e] * ao[m][e]); if (l15 == 0) part[w * 64 + l] = ss; }
            __syncthreads();
            if (tid < 64) { float t = 0.f;
#pragma unroll
                for (int ww = 0; ww < 8; ++ww) t += part[ww * 64 + tid];
                rstd[tid] = 1.0f / sqrtf(t * (1.0f / 128.0f) + NORM_EPS); }
            __syncthreads();
            { constexpr int PH = 132; LAS float* hs = (LAS float*)lds;
#pragma unroll
              for (int m = 0; m < 4; ++m)
#pragma unroll
                  for (int e = 0; e < 4; ++e) { const int l = 16 * m + 4 * quad + e; hs[l * PH + 16 * w + l15] = ao[m][e] * rstd[l]; }
              __syncthreads();
              const int l = tid >> 3, v0 = (tid & 7) * 16; const size_t tk = (size_t)(t0 + l); const int col0 = hh * 128 + v0;
#pragma unroll
              for (int q = 0; q < 2; ++q) { float gg[8]; unpack8(ggr[q], gg);
                  const f32x4 h0 = *(const LAS f32x4*)(hs + l * PH + v0 + 8 * q), h1 = *(const LAS f32x4*)(hs + l * PH + v0 + 8 * q + 4);
                  const f32x4 n0 = *(const f32x4*)(hg_norm + col0 + 8 * q), n1 = *(const f32x4*)(hg_norm + col0 + 8 * q + 4);
                  float r[8];
#pragma unroll
                  for (int e = 0; e < 4; ++e) { r[e] = h0[e] * n0[e] * siluf_(gg[e]); r[4 + e] = h1[e] * n1[e] * siluf_(gg[4 + e]); }
                  v4u o; o.x = pk2(r[0], r[1]); o.y = pk2(r[2], r[3]); o.z = pk2(r[4], r[5]); o.w = pk2(r[6], r[7]); *(v4u*)(Y + tk * 2048 + 1024 + col0 + 8 * q) = o; } }
            __syncthreads(); }
        }
    }
}


__device__ __forceinline__ void ph_qknorm_rope(Frame& F, bf16_t* slots, const float* q_norm, const float* k_norm, const float* rope) {
    const int sub = F.lane & 15, rsel = F.lane >> 4;
    const int skip = F.G == 256 ? 32 : 0;
    if (F.bx < skip) return;
    const int gw = (F.bx - skip) * 8 + F.wave, ngw = (F.G - skip) * 8;
    constexpr int NIT = 24 * T / 4;
    for (int it0 = gw; it0 < NIT; it0 += 4 * ngw) {
        v4u xin[4]; f32x4 cs[4][4];
#pragma unroll
        for (int u = 0; u < 4; ++u) { const int it = it0 + u * ngw;
            if (it < NIT) { const int rowi = it * 4 + rsel, sl = rowi / T, m = rowi - sl * T, pos = m & (SEQ - 1);
                const int slot = sl < 16 ? sl : (sl < 20 ? 24 + (sl - 16) : 32 + (sl - 20));
                xin[u] = *(const v4u*)(slots + ((size_t)slot * T + m) * 128 + 8 * sub);
                const f32x4* cp = (const f32x4*)(rope + ((size_t)pos * 64 + 8 * (sub & 7)) * 2);
#pragma unroll
                for (int q = 0; q < 4; ++q) cs[u][q] = cp[q]; } }
#pragma unroll
        for (int u = 0; u < 4; ++u) { const int it = it0 + u * ngw;
            if (it < NIT) { const int rowi = it * 4 + rsel, sl = rowi / T, m = rowi - sl * T;
                const int slot = sl < 16 ? sl : (sl < 20 ? 24 + (sl - 16) : 32 + (sl - 20));
                const float* w = (sl < 16 ? q_norm : (sl < 20 ? k_norm + 128 : k_norm + 256)) + 8 * sub;
                bf16_t* p = slots + ((size_t)slot * T + m) * 128 + 8 * sub;
                float x[8]; unpack8(xin[u], x);
                float ss = 0.f;
#pragma unroll
                for (int e = 0; e < 8; ++e) ss += x[e] * x[e];
                const float rstd = __builtin_amdgcn_rsqf(row16_sum(ss) * (1.0f / 128.0f) + NORM_EPS);
                const f32x4 w0 = *(const f32x4*)w, w1 = *(const f32x4*)(w + 4);
                float a[8], bpart[8];
#pragma unroll
                for (int e = 0; e < 8; ++e) { a[e] = x[e] * rstd * (e < 4 ? w0[e] : w1[e - 4]); bpart[e] = DPP_F(a[e], 0x128); }
                const float sgn = sub < 8 ? -1.0f : 1.0f;
                float y[8];
#pragma unroll
                for (int q = 0; q < 4; ++q) { const f32x4 c2 = cs[u][q]; y[2 * q] = a[2 * q] * c2.x + sgn * bpart[2 * q] * c2.y; y[2 * q + 1] = a[2 * q + 1] * c2.z + sgn * bpart[2 * q + 1] * c2.w; }
                v4u o; o.x = pk2(y[0], y[1]); o.y = pk2(y[2], y[3]); o.z = pk2(y[4], y[5]); o.w = pk2(y[6], y[7]);
                *(v4u*)p = o; } }
    }
}
__device__ __forceinline__ void ph_compress2(Frame& F, const bf16_t* hid, const float* w2  , const float* k_norm0, const float* rope, bf16_t* kcmp, bf16_t* vcmp) {
    for (int g4 = F.gw; g4 < 2 * 1024; g4 += F.NGW) {
        const int kv = g4 >> 10, r0 = 4 * (g4 & 1023);
        float h[4][4];
#pragma unroll
        for (int i = 0; i < 4; ++i) { const v2u hu = *(const v2u*)(hid + ((size_t)kv * 4096 + r0 + i) * 256 + 4 * F.lane); h[i][0] = bflo(hu.x); h[i][1] = bfhi(hu.x); h[i][2] = bflo(hu.y); h[i][3] = bfhi(hu.y); }
        const float* w = w2 + (size_t)kv * 256 * 128;
        float a0[4] = {0.f, 0.f, 0.f, 0.f}, a1[4] = {0.f, 0.f, 0.f, 0.f};
        for (int c4 = 0; c4 < 64; ++c4) {
            const float* wr = w + (size_t)(4 * c4) * 128 + F.lane;
            const float w00 = wr[0], w01 = wr[128], w02 = wr[256], w03 = wr[384], w10 = wr[64], w11 = wr[192], w12 = wr[320], w13 = wr[448];
#pragma unroll
            for (int i = 0; i < 4; ++i) {
                const float x0 = __builtin_bit_cast(float, __builtin_amdgcn_readlane(__builtin_bit_cast(int, h[i][0]), c4)), x1 = __builtin_bit_cast(float, __builtin_amdgcn_readlane(__builtin_bit_cast(int, h[i][1]), c4));
                const float x2 = __builtin_bit_cast(float, __builtin_amdgcn_readlane(__builtin_bit_cast(int, h[i][2]), c4)), x3 = __builtin_bit_cast(float, __builtin_amdgcn_readlane(__builtin_bit_cast(int, h[i][3]), c4));
                a0[i] += x0 * w00 + x1 * w01 + x2 * w02 + x3 * w03;
                a1[i] += x0 * w10 + x1 * w11 + x2 * w12 + x3 * w13; }
        }
#pragma unroll
        for (int i = 0; i < 4; ++i) { const int r = r0 + i;
            if (kv == 0) {
                const float rstd = 1.0f / sqrtf(wave_sum(a0[i] * a0[i] + a1[i] * a1[i]) * (1.0f / 128.0f) + NORM_EPS);
                const float a = a0[i] * rstd * k_norm0[F.lane], b = a1[i] * rstd * k_norm0[64 + F.lane];
                const int pos = 16 * (r & 511) + 31;
                const f32x2 cs = *(const f32x2*)(rope + ((size_t)pos * 64 + F.lane) * 2);
                kcmp[(size_t)r * 128 + F.lane] = (bf16_t)f2bf(a * cs.x - b * cs.y); kcmp[(size_t)r * 128 + 64 + F.lane] = (bf16_t)f2bf(b * cs.x + a * cs.y);
            } else { vcmp[(size_t)r * 128 + F.lane] = (bf16_t)f2bf(a0[i]); vcmp[(size_t)r * 128 + 64 + F.lane] = (bf16_t)f2bf(a1[i]); } }
    }
}

namespace nsa {
typedef short s16x4 __attribute__((ext_vector_type(4)));
typedef float f32x16 __attribute__((ext_vector_type(16)));
#define KSWZ(row, colB) ((row) * 256 + ((colB) ^ (((row) & 7) << 4)))
#define SBAR() __builtin_amdgcn_sched_barrier(0)
constexpr float SCALE = 0.08838834764831845f, CLOG = SCALE * 1.4426950408889634f;
constexpr int SHM_T = 64 * 128 * 2;
constexpr int L_V = 0, L_K = 2 * SHM_T, L_WREG = 4 * SHM_T, WREG = 8192, IMP_LD = 144, L_SELW = 132096, L_SCR = 133120, L_END = L_SCR + 8 * 64 * 4;
static_assert(L_WREG + 8 * WREG <= RING_BYTES && 8 * IMP_LD * 4 <= WREG && L_END <= LDS_BYTES && L_SELW >= MISC_OFF + 128, "attention LDS map");
__device__ __forceinline__ int crow(int r, int hi) { return (r & 3) + 8 * (r >> 2) + 4 * hi; }
__device__ __forceinline__ unsigned cvtpk(float lo, float hi) { return pk2(lo, hi); }
__device__ __forceinline__ void qkt(f32x16& p0, f32x16& p1, const LAS char* Ks, const bf16x8* qr, int r32, int hi) {
    p0 = f32x16{}; p1 = f32x16{};
#pragma unroll
    for (int d0 = 0; d0 < 8; ++d0) { const int cb = (d0 * 16 + hi * 8) * 2;
        const bf16x8 b0 = *(const LAS bf16x8*)(Ks + KSWZ(r32, cb)), b1 = *(const LAS bf16x8*)(Ks + KSWZ(32 + r32, cb));
        p0 = __builtin_amdgcn_mfma_f32_32x32x16_bf16(b0, qr[d0], p0, 0, 0, 0);
        p1 = __builtin_amdgcn_mfma_f32_32x32x16_bf16(b1, qr[d0], p1, 0, 0, 0); }
}
__device__ __forceinline__ int v_st(int k, int c) { const int kk = (k & ~0xC) | ((k & 4) << 1) | ((k & 8) >> 1); return ((kk >> 3) * 4 + (c >> 5)) * 512 + ((kk & 7) * 32 + (c & 31)) * 2; }
__device__ __forceinline__ int v_rd_base(int lane) { return ((lane & 3) << 3) | (((lane >> 2) & 3) << 6) | (((lane >> 4) & 1) << 5) | (((lane >> 5) & 1) << 8); }
constexpr int v_rd_off(int d0, int ks, int half) { return d0 * 512 + ks * 4096 + half * 2048; }
template <int OFF> __device__ __forceinline__ s16x4 tr_read(int vb) { s16x4 r; asm volatile("ds_read_b64_tr_b16 %0, %1 offset:%2" : "=&v"(r) : "v"(vb), "i"(OFF) : "memory"); return r; }
template <int D0> __device__ __forceinline__ void pv_one(f32x16& od, int vb, bf16x8 pa0, bf16x8 pa1, bf16x8 pa2, bf16x8 pa3) {
    const s16x4 l0 = tr_read<v_rd_off(D0, 0, 0)>(vb), h0 = tr_read<v_rd_off(D0, 0, 1)>(vb), l1 = tr_read<v_rd_off(D0, 1, 0)>(vb), h1 = tr_read<v_rd_off(D0, 1, 1)>(vb);
    const s16x4 l2 = tr_read<v_rd_off(D0, 2, 0)>(vb), h2 = tr_read<v_rd_off(D0, 2, 1)>(vb), l3 = tr_read<v_rd_off(D0, 3, 0)>(vb), h3 = tr_read<v_rd_off(D0, 3, 1)>(vb);
    asm volatile("s_waitcnt lgkmcnt(0)" ::: "memory"); SBAR();
#define PK(L, H) (bf16x8){L[0], L[1], L[2], L[3], H[0], H[1], H[2], H[3]}
    od = __builtin_amdgcn_mfma_f32_32x32x16_bf16(pa0, PK(l0, h0), od, 0, 0, 0);
    od = __builtin_amdgcn_mfma_f32_32x32x16_bf16(pa1, PK(l1, h1), od, 0, 0, 0);
    od = __builtin_amdgcn_mfma_f32_32x32x16_bf16(pa2, PK(l2, h2), od, 0, 0, 0);
    od = __builtin_amdgcn_mfma_f32_32x32x16_bf16(pa3, PK(l3, h3), od, 0, 0, 0);
#undef PK
}
__device__ __forceinline__ void pack_p(const f32x16& p0, const f32x16& p1, bf16x8& pa0, bf16x8& pa1, bf16x8& pa2, bf16x8& pa3) {
#define PK4(P, BASE, OUT) do { const unsigned a0 = cvtpk(P[BASE + 0], P[BASE + 1]), a1 = cvtpk(P[BASE + 2], P[BASE + 3]), b0 = cvtpk(P[BASE + 4], P[BASE + 5]), b1 = cvtpk(P[BASE + 6], P[BASE + 7]); \
    auto r0 = __builtin_amdgcn_permlane32_swap(a0, b0, false, false); auto r1 = __builtin_amdgcn_permlane32_swap(a1, b1, false, false); \
    v4u w = {r0[0], r1[0], r0[1], r1[1]}; OUT = __builtin_bit_cast(bf16x8, w); } while (0)
    PK4(p0, 0, pa0); PK4(p0, 8, pa1); PK4(p1, 0, pa2); PK4(p1, 8, pa3);
#undef PK4
}
__device__ __forceinline__ void qk_half(f32x16& p, const LAS char* Ks, const bf16x8* qr, int row, int hi) {
#pragma unroll
    for (int d0 = 0; d0 < 8; ++d0) { const int cb = (d0 * 16 + hi * 8) * 2; const bf16x8 b = *(const LAS bf16x8*)(Ks + KSWZ(row, cb)); p = __builtin_amdgcn_mfma_f32_32x32x16_bf16(b, qr[d0], p, 0, 0, 0); }
}
template <bool RANGE>
__device__ __forceinline__ float exp_half(f32x16& p, float bias, int klo, int khi, int hi, int koff) {
    float ps = 0.f;
#pragma unroll
    for (int r = 0; r < 16; ++r) { const int k = koff + crow(r, hi); float x = fmaf(p[r], CLOG, bias);
        if (RANGE) x = (k >= klo && k <= khi) ? x : -INFINITY;
        p[r] = __builtin_amdgcn_exp2f(x); ps += p[r]; }
    return ps;
}
__device__ __forceinline__ void pack_half(const f32x16& p, bf16x8& pa, bf16x8& pb) {
#define PK4(P, BASE, OUT) do { const unsigned a0 = cvtpk(P[BASE + 0], P[BASE + 1]), a1 = cvtpk(P[BASE + 2], P[BASE + 3]), b0 = cvtpk(P[BASE + 4], P[BASE + 5]), b1 = cvtpk(P[BASE + 6], P[BASE + 7]); \
    auto r0 = __builtin_amdgcn_permlane32_swap(a0, b0, false, false); auto r1 = __builtin_amdgcn_permlane32_swap(a1, b1, false, false); \
    v4u w = {r0[0], r1[0], r0[1], r1[1]}; OUT = __builtin_bit_cast(bf16x8, w); } while (0)
    PK4(p, 0, pa); PK4(p, 8, pb);
#undef PK4
}
template <int KH>
__device__ __forceinline__ void pv_half(f32x16 (&o)[4], int vb, bf16x8 pa, bf16x8 pb) {
    s16x4 l00 = tr_read<v_rd_off(0, 2 * KH, 0)>(vb), h00 = tr_read<v_rd_off(0, 2 * KH, 1)>(vb), l01 = tr_read<v_rd_off(0, 2 * KH + 1, 0)>(vb), h01 = tr_read<v_rd_off(0, 2 * KH + 1, 1)>(vb);
    const s16x4 l10 = tr_read<v_rd_off(1, 2 * KH, 0)>(vb), h10 = tr_read<v_rd_off(1, 2 * KH, 1)>(vb), l11 = tr_read<v_rd_off(1, 2 * KH + 1, 0)>(vb), h11 = tr_read<v_rd_off(1, 2 * KH + 1, 1)>(vb);
    const s16x4 l20 = tr_read<v_rd_off(2, 2 * KH, 0)>(vb), h20 = tr_read<v_rd_off(2, 2 * KH, 1)>(vb), l21 = tr_read<v_rd_off(2, 2 * KH + 1, 0)>(vb), h21 = tr_read<v_rd_off(2, 2 * KH + 1, 1)>(vb);
    const s16x4 l30 = tr_read<v_rd_off(3, 2 * KH, 0)>(vb), h30 = tr_read<v_rd_off(3, 2 * KH, 1)>(vb), l31 = tr_read<v_rd_off(3, 2 * KH + 1, 0)>(vb), h31 = tr_read<v_rd_off(3, 2 * KH + 1, 1)>(vb);
    asm volatile("s_waitcnt lgkmcnt(0)" ::: "memory"); SBAR();
#define PK(L, H) (bf16x8){L[0], L[1], L[2], L[3], H[0], H[1], H[2], H[3]}
    o[0] = __builtin_amdgcn_mfma_f32_32x32x16_bf16(pa, PK(l00, h00), o[0], 0, 0, 0); o[1] = __builtin_amdgcn_mfma_f32_32x32x16_bf16(pa, PK(l10, h10), o[1], 0, 0, 0);
    o[2] = __builtin_amdgcn_mfma_f32_32x32x16_bf16(pa, PK(l20, h20), o[2], 0, 0, 0); o[3] = __builtin_amdgcn_mfma_f32_32x32x16_bf16(pa, PK(l30, h30), o[3], 0, 0, 0);
    o[0] = __builtin_amdgcn_mfma_f32_32x32x16_bf16(pb, PK(l01, h01), o[0], 0, 0, 0); o[1] = __builtin_amdgcn_mfma_f32_32x32x16_bf16(pb, PK(l11, h11), o[1], 0, 0, 0);
    o[2] = __builtin_amdgcn_mfma_f32_32x32x16_bf16(pb, PK(l21, h21), o[2], 0, 0, 0); o[3] = __builtin_amdgcn_mfma_f32_32x32x16_bf16(pb, PK(l31, h31), o[3], 0, 0, 0);
#undef PK
}
template <bool RANGE>
__device__ __forceinline__ float exp_tile(f32x16& p0, f32x16& p1, float bias, int klo, int khi, int hi) {
    float ps = 0.f;
#pragma unroll
    for (int r = 0; r < 16; ++r) { const int k0 = crow(r, hi), k1 = 32 + k0;
        float x0 = fmaf(p0[r], CLOG, bias), x1 = fmaf(p1[r], CLOG, bias);
        if (RANGE) { x0 = (k0 >= klo && k0 <= khi) ? x0 : -INFINITY; x1 = (k1 >= klo && k1 <= khi) ? x1 : -INFINITY; }
        p0[r] = __builtin_amdgcn_exp2f(x0); p1[r] = __builtin_amdgcn_exp2f(x1); ps += p0[r] + p1[r]; }
    return ps;
}
struct Stg { bf16x8 k0, k1, v0, v1; };
__device__ __forceinline__ void tile_load(Stg& s, const bf16_t* Kg, const bf16_t* Vg, unsigned loff) {
    const char* kb = (const char*)Kg; const char* vb = (const char*)Vg;
    s.k0 = *(const bf16x8*)(kb + loff); s.k1 = *(const bf16x8*)(kb + loff + 8192u);
    s.v0 = *(const bf16x8*)(vb + loff); s.v1 = *(const bf16x8*)(vb + loff + 8192u);
}
__device__ __forceinline__ void tile_write(const Stg& s, LAS char* lds, int buf, int sr, int sc, int vst0, int vst1) {
    *(LAS bf16x8*)(lds + L_V + buf * SHM_T + vst0) = s.v0; *(LAS bf16x8*)(lds + L_V + buf * SHM_T + vst1) = s.v1;
    *(LAS bf16x8*)(lds + L_K + buf * SHM_T + KSWZ(sr, sc * 2)) = s.k0; *(LAS bf16x8*)(lds + L_K + buf * SHM_T + KSWZ(32 + sr, sc * 2)) = s.k1;
}
__device__ __forceinline__ void tile_dma(const bf16_t* Kg, const bf16_t* Vg, LAS char* lds, int buf, int w, unsigned dk0, unsigned dv0, unsigned dv1) {
    LAS char* kd = lds + L_K + buf * SHM_T + w * 1024; LAS char* vd = lds + L_V + buf * SHM_T + w * 1024;
    __builtin_amdgcn_global_load_lds((const unsigned*)((const char*)Kg + dk0), (LAS unsigned*)kd, 16, 0, 0);
    __builtin_amdgcn_global_load_lds((const unsigned*)((const char*)Kg + dk0 + 8192u), (LAS unsigned*)(kd + 8192), 16, 0, 0);
    __builtin_amdgcn_global_load_lds((const unsigned*)((const char*)Vg + dv0), (LAS unsigned*)vd, 16, 0, 0);
    __builtin_amdgcn_global_load_lds((const unsigned*)((const char*)Vg + dv1), (LAS unsigned*)(vd + 8192), 16, 0, 0);
}
__device__ __forceinline__ unsigned grp8_max(unsigned v) {
    v = max(v, (unsigned)__builtin_amdgcn_mov_dpp((int)v, 0xB1, 0xf, 0xf, true));
    v = max(v, (unsigned)__builtin_amdgcn_mov_dpp((int)v, 0x4E, 0xf, 0xf, true));
    v = max(v, (unsigned)__builtin_amdgcn_mov_dpp((int)v, 0x141, 0xf, 0xf, true));
    return v;
}
enum { BR_CMP1 = 0, BR_CMP2 = 1, BR_SEL = 2, BR_WIN = 3 };
}


struct NsaLane { int lane, w, r32, hi, tl, vb0; unsigned dk0, dv0, dv1; };
__device__ __forceinline__ NsaLane nsa_lane(int tid_in, LAS char* lds) {
    using namespace nsa;
    int tid = tid_in; asm volatile("" : "+v"(tid));
    NsaLane L; L.lane = tid & 63; L.w = __builtin_amdgcn_readfirstlane(tid >> 6); L.r32 = L.lane & 31; L.hi = L.lane >> 5; L.tl = 8 * L.w + (L.r32 >> 2);
    { const int r = L.w * 4 + (L.lane >> 4), x = L.lane & 15; L.dk0 = (unsigned)(r * 256 + ((x ^ (r & 7)) << 4));
#pragma unroll
      for (int i = 0; i < 2; ++i) { const int P = i * 512 + L.w * 64 + L.lane, blk = P >> 5, kk = (blk >> 2) * 8 + ((P & 31) >> 2), c = (blk & 3) * 32 + (P & 3) * 8;
          const int k = (kk & ~0xC) | ((kk & 4) << 1) | ((kk & 8) >> 1); const unsigned d = (unsigned)(k * 256 + c * 2); if (i == 0) L.dv0 = d; else L.dv1 = d; } }
    L.vb0 = (int)(uintptr_t)(lds + L_V) + v_rd_base(L.lane);
    return L;
}
__device__ __forceinline__ float nsa_load_q(bf16x8 (&qr)[8], const bf16_t* slots, int g, size_t mrow, int r32, int hi, LAS float* scr, int lane) {
    const bf16_t* qp = slots + ((size_t)(g * 4 + (r32 & 3)) * T + mrow) * 128 + hi * 8;
#pragma unroll
    for (int d0 = 0; d0 < 8; ++d0) qr[d0] = *(const bf16x8*)(qp + d0 * 16);
    float ss = 0.f;
#pragma unroll
    for (int d0 = 0; d0 < 8; ++d0) {
#pragma unroll
        for (int e = 0; e < 8; ++e) { const float x = bf2f((unsigned short)qr[d0][e]); ss += x * x; } }
    ss = half_swap_sum(ss, scr, lane);
    return sqrtf(ss) * nsa::CLOG;
}
__device__ __forceinline__ float nsa_kbound(const float* k_norm_br, int lane) {
    const float a = fmaxf(fabsf(k_norm_br[lane]), fabsf(k_norm_br[64 + lane]));
    return __builtin_bit_cast(float, __builtin_amdgcn_readfirstlane(__builtin_bit_cast(int, wave_max(a)))) * 11.54f;
}

__device__ __forceinline__ void ph_attn_mfma(Frame& F, const bf16_t* slots, const float* gp, const float* gbias, const float* k_norm, const bf16_t* kcmp, const bf16_t* vcmp, bf16_t* O) {
    using namespace nsa;
    LAS char* lds = (LAS char*)F.lds;
    const int vcu = (F.G % 8 == 0) ? (F.bx % 8) * (F.G / 8) + F.bx / 8 : F.bx;
    const int NU = BATCH * 4 * (SEQ / 64);
    for (int ui = 0; ui < (NU + F.G - 1) / F.G; ++ui) {
        if (ui * F.G + vcu >= NU) break;
        int bg, qb;
        if (F.G == 256) { const int v = vcu & 31; bg = vcu >> 5; qb = ui == 0 ? v : ui == 1 ? 63 - v : ui == 2 ? 64 + v : 127 - v; }
        else { const int u = ui * F.G + vcu; bg = u >> 7; qb = u & 127; }
        const int b = bg >> 2, g = bg & 3, q0 = qb * 64;

#define TILE_LOOP(BR, Kg, Vg, kt0, kt1) do { \
        int buf = 0; \
        __syncthreads(); \
        tile_dma((Kg) + (size_t)(kt0) * 64 * 128, (Vg) + (size_t)(kt0) * 64 * 128, lds, 0, L.w, L.dk0, L.dv0, L.dv1); \
        asm volatile("s_waitcnt vmcnt(0)" ::: "memory"); __syncthreads(); \
        for (int kt = (kt0); kt <= (kt1); ++kt) { \
            if (kt < (kt1)) tile_dma((Kg) + (size_t)(kt + 1) * 64 * 128, (Vg) + (size_t)(kt + 1) * 64 * 128, lds, buf ^ 1, L.w, L.dk0, L.dv0, L.dv1);        \
            float bias = -qn * kb; int klo = 0, khi = 63; bool rng = false, wave_on = true; \
            if (BR == BR_CMP1 || BR == BR_CMP2) { khi = nmax_t - 64 * kt; rng = (64 * kt + 63 > 4 * qb - 2); } \
            else if (BR == BR_SEL) { const unsigned wsel = selw[(L.r32 >> 2) * 4 + (kt >> 5)]; const bool on = ((wsel >> (kt & 31)) & 1u) != 0u; bias = on ? bias : -INFINITY; if (kt == qb) { khi = L.tl; rng = true; } \
                wave_on = __builtin_amdgcn_ballot_w64(on) != 0ull; }        \
            else { if (kt == qb) { khi = L.tl; rng = true; } else if (kt == qb - 8) { klo = L.tl + 1; rng = true; } } \
            { \
            const LAS char* Kt_ = lds + L_K + buf * SHM_T; const int vb = L.vb0 + buf * SHM_T; \
            f32x16 p0 = f32x16{}, p1 = f32x16{}; \
            qk_half(p0, Kt_, qr, L.r32, L.hi); qk_half(p1, Kt_, qr, 32 + L.r32, L.hi); \
            float ps = rng ? exp_half<true>(p0, bias, klo, khi, L.hi, 0) : exp_half<false>(p0, bias, klo, khi, L.hi, 0); \
            if (BR == BR_CMP1) { ps += rng ? exp_half<true>(p1, bias, klo, khi, L.hi, 32) : exp_half<false>(p1, bias, klo, khi, L.hi, 32); lsum += ps; } \
            else { \
                bf16x8 pa0, pa1, pa2, pa3; \
                if (BR == BR_CMP2) { _Pragma("unroll") for (int r = 0; r < 16; ++r) p0[r] *= inv_lc; } \
                pack_half(p0, pa0, pa1); \
                if (wave_on) pv_half<0>(o, vb, pa0, pa1); \
                ps += rng ? exp_half<true>(p1, bias, klo, khi, L.hi, 32) : exp_half<false>(p1, bias, klo, khi, L.hi, 32); \
                if (BR == BR_CMP2) { _Pragma("unroll") for (int r = 0; r < 16; ++r) p1[r] *= inv_lc; } else lsum += ps; \
                pack_half(p1, pa2, pa3); \
                if (wave_on) pv_half<1>(o, vb, pa2, pa3); \
                if (BR == BR_CMP2) { \
                      \
                    f32x16 d2 = f32x16{}; \
                    int r32o = L.r32, hio = L.hi; asm volatile("" : "+v"(r32o), "+v"(hio)); \
                    _Pragma("unroll") for (int s = 0; s < 4; ++s) { const int c = r32o - 4 * s; bf16x8 cv; \
                        _Pragma("unroll") for (int jj = 0; jj < 8; ++jj) { const int k = 8 * hio + jj; cv[jj] = (c >= 0 && c <= 4 && k >= 4 * c - 1 && k <= 4 * c + 3) ? (short)0x3F80 : (short)0; } \
                        d2 = __builtin_amdgcn_mfma_f32_32x32x16_bf16(s == 0 ? pa0 : s == 1 ? pa1 : s == 2 ? pa2 : pa3, cv, d2, 0, 0, 0); } \
                    if (L.r32 <= 16) { \
                        _Pragma("unroll") for (int q4 = 0; q4 < 4; ++q4) { const float sum = (d2[4 * q4] + d2[4 * q4 + 1]) + (d2[4 * q4 + 2] + d2[4 * q4 + 3]); \
                            LAS float* ip = imp + (2 * q4 + L.hi) * IMP_LD + 16 * kt + L.r32; *ip = *ip + sum; } } \
                    asm volatile("s_waitcnt lgkmcnt(0)" ::: "memory"); \
                } \
            } \
            } \
            asm volatile("s_waitcnt vmcnt(0)" ::: "memory"); \
            __syncthreads(); buf ^= 1; \
        } } while (0)
#define ROW_FACTORS(f) do { if (L.hi == 0) scr[L.r32] = (f); asm volatile("s_waitcnt lgkmcnt(0)" ::: "memory"); } while (0)

        {
            const NsaLane L = nsa_lane(F.tid, lds);
            LAS float* imp = (LAS float*)(lds + L_WREG + L.w * WREG); LAS bf16_t* park = (LAS bf16_t*)imp; LAS float* scr = (LAS float*)(lds + L_SCR) + L.w * 64; LAS unsigned* selw = nullptr; (void)selw;
            const int t = q0 + L.tl; const size_t mrow = (size_t)b * SEQ + t;
            bf16x8 qr[8]; const float qn = nsa_load_q(qr, slots, g, mrow, L.r32, L.hi, scr, L.lane);
            const float kb = nsa_kbound(k_norm, L.lane);
            for (int i = L.lane; i < 8 * IMP_LD; i += 64) imp[i] = 0.f;
            const bf16_t* Kc = kcmp + (size_t)(g * 1024 + b * 512) * 128; const bf16_t* Vc = vcmp + (size_t)(g * 1024 + b * 512) * 128;
            const int nmax_t = t >= 31 ? (t - 31) >> 4 : -1;
            const int nct = ((4 * qb + 2) >> 6) + 1;
            float lsum = 0.f, inv_lc = 0.f;
            { f32x16 o[4]; (void)o; TILE_LOOP(BR_CMP1, Kc, Vc, 0, nct - 1); }
            lsum = half_swap_sum(lsum, scr, L.lane); inv_lc = lsum > 0.f ? 1.0f / lsum : 0.f;
            f32x16 o[4];
#pragma unroll
            for (int d = 0; d < 4; ++d) o[d] = f32x16{};
            TILE_LOOP(BR_CMP2, Kc, Vc, 0, nct - 1);
            unsigned key[16];
            { const int tok = L.lane >> 3, sub = L.lane & 7;
#pragma unroll
              for (int e4 = 0; e4 < 4; ++e4) { const f32x4 vv = *(const LAS f32x4*)(imp + tok * IMP_LD + 16 * sub + 4 * e4);
#pragma unroll
                  for (int e = 0; e < 4; ++e) { const int s = 16 * sub + 4 * e4 + e; const bool forced = (s == 0) || (s == qb) || (s == qb - 1);
                      const float f = vv[e] + (forced ? 1e4f : 0.f);
                      key[4 * e4 + e] = s <= qb ? ((__builtin_bit_cast(unsigned, f) & 0xFFFFFF80u) | (unsigned)(127 - s)) : 0u; } }
              asm volatile("s_waitcnt lgkmcnt(0)" ::: "memory"); }
            { const int hd = g * 4 + (L.r32 & 3); const float g0 = sigmoidf_(gp[mrow * 48 + hd * 3 + 0] + gbias[hd * 3 + 0]);
              ROW_FACTORS(g0);
#pragma unroll
              for (int r = 0; r < 16; ++r) { const int row = crow(r, L.hi); const float fr = scr[row];
#pragma unroll
                  for (int d = 0; d < 4; ++d) park[row * 128 + d * 32 + L.r32] = (bf16_t)f2bf(o[d][r] * fr); }
              asm volatile("s_waitcnt lgkmcnt(0)" ::: "memory"); }
            { LAS unsigned* sw = (LAS unsigned*)(lds + L_SELW) + L.w * 32; const int tok = L.lane >> 3, sub = L.lane & 7;
              unsigned m0 = 0u, m1 = 0u, m2 = 0u, m3 = 0u;
              for (int k = 0; k < 16; ++k) {
                  unsigned mx = key[0];
#pragma unroll
                  for (int e = 1; e < 16; ++e) mx = max(mx, key[e]);
                  mx = grp8_max(mx);
                  if (mx != 0u) { const unsigned s = 127u - (mx & 127u); const unsigned bit = 1u << (s & 31u);
                      m0 |= (s >> 5) == 0u ? bit : 0u; m1 |= (s >> 5) == 1u ? bit : 0u; m2 |= (s >> 5) == 2u ? bit : 0u; m3 |= (s >> 5) == 3u ? bit : 0u; }
#pragma unroll
                  for (int e = 0; e < 16; ++e) key[e] = key[e] == mx ? 0u : key[e];
              }
              if (sub == 0) { sw[tok * 4 + 0] = m0; sw[tok * 4 + 1] = m1; sw[tok * 4 + 2] = m2; sw[tok * 4 + 3] = m3; }
              asm volatile("s_waitcnt lgkmcnt(0)" ::: "memory"); }
        }
        {
            const NsaLane L = nsa_lane(F.tid, lds);
            LAS float* imp = nullptr; (void)imp; LAS bf16_t* park = (LAS bf16_t*)(lds + L_WREG + L.w * WREG); LAS float* scr = (LAS float*)(lds + L_SCR) + L.w * 64; LAS unsigned* selw = (LAS unsigned*)(lds + L_SELW) + L.w * 32;
            const int t = q0 + L.tl; const size_t mrow = (size_t)b * SEQ + t;
            bf16x8 qr[8]; const float qn = nsa_load_q(qr, slots, g, mrow, L.r32, L.hi, scr, L.lane);
            const float kb = nsa_kbound(k_norm + 128, L.lane);
            const bf16_t* Ks = slots + ((size_t)(24 + g) * T + (size_t)b * SEQ) * 128; const bf16_t* Vs = slots + ((size_t)(28 + g) * T + (size_t)b * SEQ) * 128;
            const int nmax_t = 0; (void)nmax_t; float lsum = 0.f; const float inv_lc = 0.f; (void)inv_lc;
            f32x16 o[4];
#pragma unroll
            for (int d = 0; d < 4; ++d) o[d] = f32x16{};
            TILE_LOOP(BR_SEL, Ks, Vs, 0, qb);
            lsum = half_swap_sum(lsum, scr, L.lane);
            { const int hd = g * 4 + (L.r32 & 3); const float g1 = sigmoidf_(gp[mrow * 48 + hd * 3 + 1] + gbias[hd * 3 + 1]);
              ROW_FACTORS(lsum > 0.f ? g1 / lsum : 0.f);
#pragma unroll
              for (int r = 0; r < 16; ++r) { const int row = crow(r, L.hi); const float fr = scr[row];
#pragma unroll
                  for (int d = 0; d < 4; ++d) { LAS bf16_t* pp = park + row * 128 + d * 32 + L.r32; *pp = (bf16_t)f2bf(bf2f(*pp) + o[d][r] * fr); } }
              asm volatile("s_waitcnt lgkmcnt(0)" ::: "memory"); }
        }
        {
            const NsaLane L = nsa_lane(F.tid, lds);
            LAS float* imp = nullptr; (void)imp; LAS bf16_t* park = (LAS bf16_t*)(lds + L_WREG + L.w * WREG); LAS float* scr = (LAS float*)(lds + L_SCR) + L.w * 64; LAS unsigned* selw = nullptr; (void)selw;
            const int t = q0 + L.tl; const size_t mrow = (size_t)b * SEQ + t;
            bf16x8 qr[8]; const float qn = nsa_load_q(qr, slots, g, mrow, L.r32, L.hi, scr, L.lane);
            const float kb = nsa_kbound(k_norm + 256, L.lane);
            const bf16_t* Kw = slots + ((size_t)(32 + g) * T + (size_t)b * SEQ) * 128; const bf16_t* Vw = slots + ((size_t)(36 + g) * T + (size_t)b * SEQ) * 128;
            const int nmax_t = 0; (void)nmax_t; float lsum = 0.f; const float inv_lc = 0.f; (void)inv_lc;
            f32x16 o[4];
#pragma unroll
            for (int d = 0; d < 4; ++d) o[d] = f32x16{};
            TILE_LOOP(BR_WIN, Kw, Vw, (qb - 8 < 0 ? 0 : qb - 8), qb);
            lsum = half_swap_sum(lsum, scr, L.lane);
            { const int hd = g * 4 + (L.r32 & 3); const float g2 = sigmoidf_(gp[mrow * 48 + hd * 3 + 2] + gbias[hd * 3 + 2]);
              ROW_FACTORS(lsum > 0.f ? g2 / lsum : 0.f);
              char* Ow = (char*)(O + ((size_t)b * SEQ + q0 + 8 * L.w) * 2048 + g * 512);
#pragma unroll
              for (int r = 0; r < 16; ++r) { const int row = crow(r, L.hi); const float fr = scr[row];
#pragma unroll
                  for (int d = 0; d < 4; ++d) *(bf16_t*)(Ow + (unsigned)(((row >> 2) * 2048 + (row & 3) * 128 + d * 32 + L.r32) * 2)) = (bf16_t)f2bf(bf2f(park[row * 128 + d * 32 + L.r32]) + o[d][r] * fr); }
              asm volatile("s_waitcnt lgkmcnt(0)" ::: "memory"); }
        }
#undef TILE_LOOP
#undef ROW_FACTORS
    }
}

#ifndef MK_MULTI_LAUNCH
#define MK_MULTI_LAUNCH 0
#endif
constexpr int NPS = 8, NSLOTS_PH = 1 + 12 * NPS;
__global__ void __launch_bounds__(NTHREADS, 2) fwd_kernel(Args a) {
    extern __shared__ __attribute__((aligned(16))) unsigned char lds_raw[];
    volatile LAS unsigned* MISC = (volatile LAS unsigned*)((LAS unsigned char*)lds_raw + MISC_OFF);
    if (threadIdx.x < 32) MISC[threadIdx.x] = 0u;
    const int g_wave = __builtin_amdgcn_readfirstlane((int)(threadIdx.x >> 6));
    __syncthreads();
    const int lo = a.ph_lo, hi = a.ph_hi;
    const bool use_bar = (hi - lo) > 1;
    XcdBarrier bar; bar.bar = (unsigned*)(a.ws + WS_CTL) + CW_BAR; bar.x = 0; bar.st = MISC + 8; bar.wv = g_wave;
    if (use_bar) bar = xcd_barrier_post((unsigned*)(a.ws + WS_CTL) + CW_BAR, MISC + 8, g_wave);
#define IN(k) (lo <= (k) && (k) < hi)
#define SEAM(k) do { if (IN((k) + 1) && use_bar) xcd_barrier(bar); } while (0)
#define PH_ENTER() Frame F = make_frame(lds_raw, g_wave); CArgsP ap = get_args(); unsigned char* ws = ap->ws; float* h = ap->out; bf16_t* HN = (bf16_t*)(ws + WS_HN); bf16_t* ACT = (bf16_t*)(ws + WS_ACT); float* SSQ = (float*)(ws + WS_SSQP); LAS float* RED = (LAS float*)(F.lds + RED_OFF); (void)h; (void)HN; (void)ACT; LAS float* RSL = RED + 3072; (void)SSQ; (void)RED; (void)RSL

    if (IN(0)) { PH_ENTER(); ph_prologue(F, ap); }
    SEAM(0);

    for (int step = 0; step < 12; ++step) {
        const int layer = step / 3, sub = step - 3 * layer, base = 1 + NPS * step, jp = layer >> 1;
        if (sub != 1) {
            const int half = sub >> 1, f = layer * 2 + half;
            const int vin = 3 * layer + 2 * half;
            if (IN(base + 1)) { PH_ENTER(); Gemm g{HN, (const bf16_t*)(ws + WS_WGU + (size_t)f * GU_BYTES), T, 2 * FF, D, D, D, 0, 0}; StaticOrder S; S.init(T, 2 * FF, F.G, F.bx);
                pg8::Unit u0; const bool any = S.next(0, u0); const int pm0 = any ? u0.pm : 0; const float* sq = SSQ + (size_t)vin * T * 32; panel_rstd(F, sq, pm0, RSL);
                pg8::EpiSwiGLU E{ACT, FF, pg8::RowScale{RSL, pm0, sq}}; gemm_phase<pg8::EpiSwiGLU, StaticOrder>(F.lds, g, S, E, nullptr, F.tid); }
            SEAM(base + 1);
            if (IN(base + 2)) { PH_ENTER(); Gemm g{ACT, (const bf16_t*)(ws + WS_WD + (size_t)f * DN_BYTES), T, D, FF, FF, FF, 0, 0}; StaticOrder S; S.init(T, D, F.G, F.bx);
                pg8::EpiResid E{h, D, HN, SSQ + (size_t)(vin + 1) * T * 32, RED, step == 11}; gemm_phase<pg8::EpiResid, StaticOrder>(F.lds, g, S, E, nullptr, F.tid); }
            SEAM(base + 2);
        } else if ((layer & 1) == 0) {
#define AB_PTRS() bf16_t* P = ACT; unsigned char* mx = ws + WS_MIX; bf16_t* CB = (bf16_t*)(mx + MX_C); bf16_t* QK = (bf16_t*)(mx + MX_QK); bf16_t* CST = (bf16_t*)(mx + MX_CST); bf16_t* SST = (bf16_t*)(mx + MX_SST); float* GIF = (float*)(mx + MX_GIF); float* NST = (float*)(mx + MX_NST); float* SCL = (float*)(mx + MX_SCL); float* HDEC = (float*)(mx + MX_HDEC); bf16_t* Y = (bf16_t*)(mx + MX_Y); (void)P; (void)CB; (void)QK; (void)CST; (void)SST; (void)GIF; (void)NST; (void)SCL; (void)HDEC; (void)Y
            if (IN(base + 1)) { PH_ENTER(); AB_PTRS(); const float* ssq = SSQ + (size_t)(3 * layer + 1) * T * 32;
                { Gemm g{HN, (const bf16_t*)(ws + WS_WABIN + (size_t)jp * ABIN_BYTES), T, AB_N, D, D, D, 0, 0}; StaticOrder S; S.init(T, AB_N, F.G, F.bx);
                  pg8::Unit u0; const bool any = S.next(0, u0); const int pm0 = any ? u0.pm : 0; panel_rstd(F, ssq, pm0, RSL);
                  pg8::EpiPlainBf16 E{P, AB_N, pg8::RowScale{RSL, pm0, ssq}, true}; gemm_phase<pg8::EpiPlainBf16, StaticOrder>(F.lds, g, S, E, nullptr, F.tid); }
                ph_skinny<8>(F, HN, ssq, (const bf16_t*)(ws + WS_WSK) + (size_t)jp * 64 * D, GIF); }
            SEAM(base + 1);
            if (IN(base + 2)) { PH_ENTER(); AB_PTRS(); ph_conv(F, P, ap->in[12] + (size_t)jp * 4096, ap->in[13] + (size_t)jp * 1024, CB); }
            SEAM(base + 2);
            if (IN(base + 3)) { PH_ENTER(); AB_PTRS(); Gemm g{CB, (const bf16_t*)(ws + WS_WQK + (size_t)jp * WQK_BYTES), T, 2048, 256, 1024, 256, 3, 256}; StaticOrder S; S.init(T, 2048, F.G, F.bx);
                pg8::EpiPlainBf16 E{QK, 2048, pg8::RowScale{nullptr, -1, nullptr}, false}; gemm_phase<pg8::EpiPlainBf16, StaticOrder>(F.lds, g, S, E, nullptr, F.tid); }
            SEAM(base + 3);
            if (IN(base + 4)) { PH_ENTER(); AB_PTRS(); ph_chunk_r1(F, P, QK, GIF, ap->in[16] + jp * 4, ap->in[17] + jp * 4, ap->in[20], jp, CST, NST, SCL, SST, HDEC); }
            SEAM(base + 4);
            if (IN(base + 5)) { PH_ENTER(); AB_PTRS(); ph_chunk_r2(F, CST, NST, SCL, SST, HDEC); }
            SEAM(base + 5);
            if (IN(base + 6)) { PH_ENTER(); AB_PTRS(); ph_chunk_r3(F, P, QK, CB, GIF, ap->in[16] + jp * 4, ap->in[17] + jp * 4, ap->in[20], jp, CST, NST, SCL, SST, ap->in[18] + (size_t)jp * 1024, ap->in[19] + (size_t)jp * 1024, ap->in[21] + (size_t)jp * 1024, Y); }
            SEAM(base + 6);
            if (IN(base + 7)) { PH_ENTER(); AB_PTRS(); Gemm g{Y, (const bf16_t*)(ws + WS_WABOUT + (size_t)jp * SQ_BYTES), T, D, D, D, D, 0, 0}; StaticOrder S; S.init(T, D, F.G, F.bx);
                pg8::EpiResid E{h, D, HN, SSQ + (size_t)(3 * layer + 2) * T * 32, RED, false}; gemm_phase<pg8::EpiResid, StaticOrder>(F.lds, g, S, E, nullptr, F.tid); }
            SEAM(base + 7);
        } else {
#define C_PTRS() bf16_t* SL = ACT; unsigned char* mx = ws + WS_MIX; float* GP = (float*)(mx + MX_GP); bf16_t* HID = (bf16_t*)(mx + MX_HID); bf16_t* KC = (bf16_t*)(mx + MX_KCMP); bf16_t* VC = (bf16_t*)(mx + MX_VCMP); bf16_t* O = (bf16_t*)(mx + MX_O); const float* rope = (const float*)(ws + WS_ROPE); (void)SL; (void)GP; (void)HID; (void)KC; (void)VC; (void)O; (void)rope
            if (IN(base + 1)) { PH_ENTER(); C_PTRS(); const float* ssq = SSQ + (size_t)(3 * layer + 1) * T * 32;
                { Gemm g{HN, (const bf16_t*)(ws + WS_WCIN + (size_t)jp * CIN_BYTES), T, C_N, D, D, D, 0, 0}; StaticOrder S; S.init(T, C_N, F.G, F.bx);
                  pg8::Unit u0; const bool any = S.next(0, u0); const int pm0 = any ? u0.pm : 0; panel_rstd(F, ssq, pm0, RSL);
                  pg8::EpiSlots E{SL, T, pg8::RowScale{RSL, pm0, ssq}}; gemm_phase<pg8::EpiSlots, StaticOrder>(F.lds, g, S, E, nullptr, F.tid); }
                ph_skinny<48>(F, HN, ssq, (const bf16_t*)(ws + WS_WSK) + (size_t)(2 + jp) * 64 * D, GP); }
            SEAM(base + 1);
            if (IN(base + 2)) {
                { PH_ENTER(); C_PTRS(); const int kv = F.bx >= 16 ? 1 : 0;
                  const float* cbias = (const float*)(ws + WS_CB) + (size_t)jp * 512 + kv * 256;
                  Gemm g{SL + (size_t)(16 + 4 * kv) * T * 128, (const bf16_t*)(ws + WS_WCMP1 + (size_t)(jp * 2 + kv) * CMP1_BYTES), 4096, 256, 4096, 2048, 4096, 0, 0};
                  StaticOrder S; S.init(4096, 256, F.G, kv ? F.bx - 16 : F.bx);
                  pg8::EpiSiluBias E{HID + (size_t)kv * 4096 * 256, 256, cbias}; gemm_phase<pg8::EpiSiluBias, StaticOrder>(F.lds, g, S, E, nullptr, F.tid); }
                { PH_ENTER(); C_PTRS(); ph_qknorm_rope(F, SL, ap->in[24] + (size_t)jp * 128, ap->in[25] + (size_t)jp * 384, rope); } }
            SEAM(base + 2);
            if (IN(base + 3)) { PH_ENTER(); C_PTRS(); ph_compress2(F, HID, ap->in[29] + (size_t)jp * 2 * 256 * 128, ap->in[25] + (size_t)jp * 384, rope, KC, VC); }
            SEAM(base + 3);
            if (IN(base + 4)) { PH_ENTER(); C_PTRS(); ph_attn_mfma(F, SL, GP, ap->in[30] + (size_t)jp * 48, ap->in[25] + (size_t)jp * 384, KC, VC, O); }
            SEAM(base + 4);
            if (IN(base + 6)) { PH_ENTER(); C_PTRS(); Gemm g{O, (const bf16_t*)(ws + WS_WCOUT + (size_t)jp * SQ_BYTES), T, D, D, D, D, 0, 0}; StaticOrder S; S.init(T, D, F.G, F.bx);
                pg8::EpiResid E{h, D, HN, SSQ + (size_t)(3 * layer + 2) * T * 32, RED, false}; gemm_phase<pg8::EpiResid, StaticOrder>(F.lds, g, S, E, nullptr, F.tid); }
            SEAM(base + 6);
        }
    }
#undef IN
#undef SEAM
}

extern "C" void kernel_launch(void* const* d_in, const int* in_sizes, int n_in, void* d_out, int out_size, void* d_ws, size_t ws_size, hipStream_t stream) {
    static int grid = 0;
    if (grid == 0) {
        if (n_in != 31 || in_sizes[0] != T * D || out_size != T * D || ws_size < WS_END) { fprintf(stderr, "kernel_launch: unexpected problem shape (n_in %d, in0 %d, out %d, ws %zu < %zu)\n", n_in, n_in > 0 ? in_sizes[0] : -1, out_size, ws_size, (size_t)WS_END); grid = -1; return; }
        int dev = 0, cus = 0, per_cu = 0;
        if (hipGetDevice(&dev) != hipSuccess || hipDeviceGetAttribute(&cus, hipDeviceAttributeMultiprocessorCount, dev) != hipSuccess) { grid = -1; return; }
        if (hipFuncSetAttribute((const void*)fwd_kernel, hipFuncAttributeMaxDynamicSharedMemorySize, LDS_BYTES) != hipSuccess) { fprintf(stderr, "kernel_launch: hipFuncSetAttribute failed\n"); grid = -1; return; }
        if (hipOccupancyMaxActiveBlocksPerMultiprocessor(&per_cu, (const void*)fwd_kernel, NTHREADS, LDS_BYTES) != hipSuccess || per_cu < 1) { fprintf(stderr, "kernel_launch: occupancy query reports %d workgroups per CU\n", per_cu); }
        (void)hipGetLastError();
        grid = cus;
    }
    if (grid < 0) return;
    if (hipMemsetAsync((char*)d_ws + WS_CTL, 0, CTL_ZERO_BYTES, stream) != hipSuccess) return;
    Args a{};
    for (int i = 0; i < 31; ++i) a.in[i] = (const float*)d_in[i];
    a.out = (float*)d_out; a.ws = (unsigned char*)d_ws;
#if MK_MULTI_LAUNCH
    for (int p = 0; p < NSLOTS_PH; ++p) {
        if (p > 0) { const int step = (p - 1) / NPS, q = (p - 1) % NPS, sub = step % 3, layer = step / 3;
            if (q == 0) continue; if (sub != 1 && q > 2) continue; if (sub == 1 && (layer & 1) == 1 && (q == 5 || q == 7)) continue; }
        a.ph_lo = p; a.ph_hi = p + 1;
        hipLaunchKernelGGL(fwd_kernel, dim3(grid), dim3(NTHREADS), LDS_BYTES, stream, a);
    }
#else
    a.ph_lo = 0; a.ph_hi = NSLOTS_PH;
    hipLaunchKernelGGL(fwd_kernel, dim3(grid), dim3(NTHREADS), LDS_BYTES, stream, a);
#endif
}
```

```cpp
#include <hip/hip_runtime.h>
#include <cstdio>
#include <cstdint>

constexpr int BATCH = 2, SEQ = 8192, T = BATCH * SEQ, D = 2048, FF = 5504, DEPTH = 4;
constexpr int AB_COLS = 7176, AB_N = 7168;
constexpr int C_COLS = 5168, C_N = 5120;
constexpr int NSLOT = 40;
constexpr int NCMP = 512;
constexpr float NORM_EPS = 1e-6f;

#define GAS __attribute__((address_space(1)))
#define LAS __attribute__((address_space(3)))
typedef unsigned short bf16_t;
typedef unsigned v4u __attribute__((ext_vector_type(4)));
typedef unsigned v2u __attribute__((ext_vector_type(2)));
typedef float f32x4 __attribute__((ext_vector_type(4)));
typedef float f32x2 __attribute__((ext_vector_type(2)));
typedef short bf16x8 __attribute__((ext_vector_type(8)));

__device__ __forceinline__ unsigned f2bf(float f) { return (unsigned)__builtin_bit_cast(unsigned short, (__bf16)f); }
typedef float pk_f2_t __attribute__((ext_vector_type(2)));
typedef __bf16 pk_b2_t __attribute__((ext_vector_type(2)));
__device__ __forceinline__ unsigned pk2(float lo, float hi) { const pk_f2_t v = {lo, hi}; return __builtin_bit_cast(unsigned, __builtin_convertvector(v, pk_b2_t)); }
__device__ __forceinline__ float bf2f(unsigned short b) { return __builtin_bit_cast(float, ((unsigned)b) << 16); }
__device__ __forceinline__ float bflo(unsigned w) { return __builtin_bit_cast(float, w << 16); }
__device__ __forceinline__ float bfhi(unsigned w) { return __builtin_bit_cast(float, w & 0xffff0000u); }
#define DPP_F(v, ctrl) __builtin_bit_cast(float, __builtin_amdgcn_mov_dpp(__builtin_bit_cast(int, (v)), (ctrl), 0xf, 0xf, true))
__device__ __forceinline__ float wave_sum(float v) {
    v += DPP_F(v, 0xB1); v += DPP_F(v, 0x4E); v += DPP_F(v, 0x124); v += DPP_F(v, 0x128);
    const int b = __builtin_bit_cast(int, v);
    return (__builtin_bit_cast(float, __builtin_amdgcn_readlane(b, 0)) + __builtin_bit_cast(float, __builtin_amdgcn_readlane(b, 16))) + (__builtin_bit_cast(float, __builtin_amdgcn_readlane(b, 32)) + __builtin_bit_cast(float, __builtin_amdgcn_readlane(b, 48)));
}
__device__ __forceinline__ float wave_max(float v) {
    v = fmaxf(v, DPP_F(v, 0xB1)); v = fmaxf(v, DPP_F(v, 0x4E)); v = fmaxf(v, DPP_F(v, 0x124)); v = fmaxf(v, DPP_F(v, 0x128));
    const int b = __builtin_bit_cast(int, v);
    return fmaxf(fmaxf(__builtin_bit_cast(float, __builtin_amdgcn_readlane(b, 0)), __builtin_bit_cast(float, __builtin_amdgcn_readlane(b, 16))), fmaxf(__builtin_bit_cast(float, __builtin_amdgcn_readlane(b, 32)), __builtin_bit_cast(float, __builtin_amdgcn_readlane(b, 48))));
}
__device__ __forceinline__ float half_swap_sum(float x, LAS float* scr64, int lane) {
    scr64[lane] = x; asm volatile("s_waitcnt lgkmcnt(0)" ::: "memory"); const float y = scr64[lane ^ 32]; asm volatile("s_waitcnt lgkmcnt(0)" ::: "memory"); return x + y; }
__device__ __forceinline__ float opaque_one() { float one = 1.0f; asm volatile("" : "+v"(one)); return one; }
__device__ __forceinline__ float sigmoidf_(float x) { return __builtin_amdgcn_rcpf(1.0f + __expf(-x)); }
__device__ __forceinline__ float siluf_(float x) { return x * __builtin_amdgcn_rcpf(1.0f + __expf(-x)); }
__device__ __forceinline__ float row16_sum(float v) {
    v += __builtin_bit_cast(float, __builtin_amdgcn_mov_dpp(__builtin_bit_cast(int, v), 0xB1, 0xf, 0xf, true));
    v += __builtin_bit_cast(float, __builtin_amdgcn_mov_dpp(__builtin_bit_cast(int, v), 0x4E, 0xf, 0xf, true));
    v += __builtin_bit_cast(float, __builtin_amdgcn_mov_dpp(__builtin_bit_cast(int, v), 0x124, 0xf, 0xf, true));
    v += __builtin_bit_cast(float, __builtin_amdgcn_mov_dpp(__builtin_bit_cast(int, v), 0x128, 0xf, 0xf, true));
    return v;
}

__device__ __forceinline__ int lane_id() { int l; asm volatile("v_mbcnt_lo_u32_b32 %0, -1, 0\n\tv_mbcnt_hi_u32_b32 %0, -1, %0" : "=v"(l)); return l; }
#define XB_TMO      128
#define XB_XCNT(j)  (256  + 64 * (j))
#define XB_XSUB(j)  (1280 + 64 * (j))
#define XB_XGEN(j)  (2304 + 64 * (j))
#define XB_TOP      3328
#define XB_TOPGEN   3392
#define XCD_BAR_WORDS 3456
#define XB_SPIN_CAP (1u << 18)

__device__ __forceinline__ unsigned xb_ld(unsigned* p)              { return __hip_atomic_load(p, __ATOMIC_RELAXED, __HIP_MEMORY_SCOPE_AGENT); }
__device__ __forceinline__ unsigned xb_add(unsigned* p, unsigned v) { return __hip_atomic_fetch_add(p, v, __ATOMIC_RELAXED, __HIP_MEMORY_SCOPE_AGENT); }
__device__ __forceinline__ unsigned xb_xcc_id() { return (unsigned)__builtin_amdgcn_s_getreg((3 << 11) | 20) & 0xFu; }
#define XB_SPIN(cond, bar) do { unsigned _sp = 0; while (cond) { __builtin_amdgcn_s_sleep(1); \
    if ((++_sp & 255u) == 0u) { if (xb_ld(&(bar)[XB_TMO])) break; if (_sp > XB_SPIN_CAP) { atomicAdd(&(bar)[XB_TMO], 1u); break; } } } } while (0)

struct XcdBarrier {
    unsigned* bar; unsigned x;
    volatile LAS unsigned* st;
    int wv;
};
__device__ __forceinline__ bool xb_leader(const XcdBarrier& b) { int l; asm volatile("v_mbcnt_lo_u32_b32 %0, -1, 0\n\tv_mbcnt_hi_u32_b32 %0, -1, %0" : "=v"(l)); return b.wv == 0 && l == 0; }

__device__ __forceinline__ XcdBarrier xcd_barrier_post(unsigned* bar, volatile LAS unsigned* st, int wv) {
    XcdBarrier b; b.bar = bar; b.x = xb_xcc_id(); b.st = st; b.wv = wv;
    if (xb_leader(b)) (void)xb_add(&bar[XB_XCNT(b.x)], 1u);
    return b;
}
__device__ __forceinline__ void xcd_barrier_complete(unsigned* bar, unsigned x, unsigned& nloc, unsigned& nx) {
    const unsigned G = gridDim.x * gridDim.y * gridDim.z;
    unsigned sum, cnt, mine, sp = 0u;
    for (;;) {
        sum = 0u; cnt = 0u; mine = 0u;
#pragma unroll
        for (unsigned j = 0; j < 16; ++j) { const unsigned c = xb_ld(&bar[XB_XCNT(j)]); sum += c; cnt += (c > 0u) ? 1u : 0u; mine = (j == x) ? c : mine; }
        if (sum == G) break;
        __builtin_amdgcn_s_sleep(1);
        if ((++sp & 255u) == 0u) { if (xb_ld(&bar[XB_TMO])) break; if (sp > XB_SPIN_CAP) { atomicAdd(&bar[XB_TMO], 1u); break; } }
    }
    nloc = mine > 0u ? mine : 1u; nx = cnt > 0u ? cnt : 1u;
}

__device__ __forceinline__ void xcd_barrier(const XcdBarrier& b) {
    asm volatile("s_waitcnt vmcnt(0)" ::: "memory");
    __syncthreads();
    if (xb_leader(b)) {
        unsigned* bar = b.bar; asm volatile("" : "+s"(bar));
        __builtin_amdgcn_s_waitcnt(0);
        unsigned nloc = b.st[0], nx = b.st[1];
        if (nloc == 0u) { xcd_barrier_complete(bar, b.x, nloc, nx); b.st[0] = nloc; b.st[1] = nx; }
        const unsigned old = xb_add(&bar[XB_XSUB(b.x)], 1u);
        const unsigned gen = old / nloc;
        if (old + 1u == (gen + 1u) * nloc) {
            __builtin_amdgcn_fence(__ATOMIC_RELEASE, "agent");
            asm volatile("s_waitcnt vmcnt(0)" ::: "memory");
            const unsigned og = xb_add(&bar[XB_TOP], 1u);
            const unsigned tg = og / nx;
            if (og + 1u == (tg + 1u) * nx) xb_add(&bar[XB_TOPGEN], 1u);
            else XB_SPIN(xb_ld(&bar[XB_TOPGEN]) == tg, bar);
            __builtin_amdgcn_fence(__ATOMIC_ACQUIRE, "agent");
            xb_add(&bar[XB_XGEN(b.x)], 1u);
            asm volatile("s_waitcnt vmcnt(0)" ::: "memory");
        } else {
            XB_SPIN(xb_ld(&bar[XB_XGEN(b.x)]) == gen, bar);
            __builtin_amdgcn_fence(__ATOMIC_ACQUIRE, "agent");
            asm volatile("s_waitcnt vmcnt(0)" ::: "memory");
        }
    }
    __syncthreads();
}
namespace pg8 {
#define PG8_LAS __attribute__((address_space(3)))
typedef unsigned short bf16_t;
typedef short bf16x8 __attribute__((ext_vector_type(8)));
typedef float f32x4 __attribute__((ext_vector_type(4)));
typedef unsigned u32x4 __attribute__((ext_vector_type(4)));
constexpr int BM = 256, BK = 64, HALF = 128, HTB = HALF * BK * 2  , STAGE_BYTES = 8 * HTB, NXCD = 8, WGM = 8;

__host__ __device__ __forceinline__ int lds_byte(int r, int c) { const int st = (r >> 4) * 2 + (c >> 5), rr = r & 15, cc = c & 31, ob = rr * 64 + cc * 2; return st * 1024 + (ob ^ (((ob >> 9) & 1) << 5)); }
__host__ __device__ __forceinline__ void stage_rc(int b, int& R, int& C) { const int st = b / 1024, sb = b % 1024, swz = sb ^ (((sb >> 9) & 1) << 5); R = (st >> 1) * 16 + swz / 64; C = (st & 1) * 32 + (swz % 64) / 2; }
__host__ __device__ __forceinline__ int perm32(int rho) { const int n = rho >> 4, i = rho & 15; return 8 * (i >> 2) + 4 * n + (i & 3); }

struct Unit { int pm, pn; };
struct Gemm { const bf16_t* A; const bf16_t* Bt; int M, N, K; int lda, ldb; int amask; int astride; };

struct StaticOrder {
    int nM, nN, nwg, G, c;
    __host__ __device__ __forceinline__ void init(int M, int N, int G_, int c_) { nM = M / BM; nN = N / BM; nwg = nM * nN; G = G_; c = c_; }
    __host__ __device__ __forceinline__ bool next(int i, Unit& u) const {
        const long L = (long)i * G + c; if (L >= nwg) return false;
        int wgid = (int)L; { const int q = nwg / NXCD, r = nwg % NXCD, xcd = wgid % NXCD, off = wgid / NXCD; wgid = (xcd < r ? xcd * (q + 1) : r * (q + 1) + (xcd - r) * q) + off; }
        const int nig = WGM * nN, gid = wgid / nig, fm = gid * WGM, gsz = (nM - fm) < WGM ? (nM - fm) : WGM;
        u.pm = fm + ((wgid % nig) % gsz); u.pn = (wgid % nig) / gsz; return true;
    }
    __device__ __forceinline__ void a_ready(const Unit&) const {}
    __device__ __forceinline__ void done(const Unit&) const {}
};
struct CountedOrder : StaticOrder {
    const unsigned* ready; unsigned need; unsigned* tmo;
    __device__ __forceinline__ void a_ready(const Unit& u) const {
        if (threadIdx.x < 64) {
            const unsigned long long t0 = __builtin_amdgcn_s_memrealtime(); unsigned polls = 0;
            while ((unsigned)__builtin_amdgcn_readfirstlane(__hip_atomic_load(ready + 64 * u.pm, __ATOMIC_RELAXED, __HIP_MEMORY_SCOPE_AGENT)) < need) {
                if ((++polls & 255u) == 0u && __builtin_amdgcn_readfirstlane(__hip_atomic_load(tmo, __ATOMIC_RELAXED, __HIP_MEMORY_SCOPE_AGENT)) != 0u) break;
                if (__builtin_amdgcn_s_memrealtime() - t0 > 2000000ull) {
                    if (threadIdx.x == 0) { unsigned expect = 0u; __hip_atomic_compare_exchange_strong(tmo + 1, &expect, 0x600u | (unsigned)(u.pm & 0xff), __ATOMIC_RELAXED, __ATOMIC_RELAXED, __HIP_MEMORY_SCOPE_AGENT); __hip_atomic_store(tmo, 1u, __ATOMIC_RELAXED, __HIP_MEMORY_SCOPE_AGENT); }
                    break; }
                __builtin_amdgcn_s_sleep(2); }
            __builtin_amdgcn_fence(__ATOMIC_ACQUIRE, "agent");
            asm volatile("s_waitcnt vmcnt(0)" ::: "memory");
        }
#if !defined(BROKEN_HOOK_NO_BARRIER)
        asm volatile("" ::: "memory"); __builtin_amdgcn_s_barrier(); asm volatile("" ::: "memory");
#endif
    }
};

__device__ __forceinline__ unsigned cvt_pk_bf16(float lo, float hi) { unsigned r; asm volatile("v_cvt_pk_bf16_f32 %0, %1, %2" : "=v"(r) : "v"(lo), "v"(hi)); return r; }
typedef float f32x2 __attribute__((ext_vector_type(2)));
__device__ __forceinline__ f32x2 gelu_pk(f32x2 v) {
    const f32x2 av = __builtin_elementwise_abs(v), d = av * 0.2316418882f + 1.0f;
    f32x2 t; t.x = __builtin_amdgcn_rcpf(d.x); t.y = __builtin_amdgcn_rcpf(d.y);
    f32x2 q = t * 0.5307027145f + (-0.7265760135f); q = q * t + 0.7107068705f; q = q * t + (-0.142248368f); q = q * t + 0.127414796f; q = q * t;
    const f32x2 s = (v * v) * (-0.72134752044f);
    f32x2 e; e.x = __builtin_amdgcn_exp2f(s.x); e.y = __builtin_amdgcn_exp2f(s.y);
    const f32x2 m = v * (q * e), r = v - m;
    f32x2 o; o.x = v.x < 0.f ? m.x : r.x; o.y = v.y < 0.f ? m.y : r.y; return o;
}

struct EpiF32 {
    static constexpr bool PERM = false, AFTER_DRAIN = false;
    float* C; int ldc; const float* bias;
    __device__ __forceinline__ void operator()(const f32x4 (&acc)[2][2][4][2], const Unit& u, int wr, int wc, int fr, int fq) const {
        const int row0 = u.pm * BM + wr * 64 + fr, col0 = u.pn * BM + wc * 32 + 4 * fq;
        f32x4 bv[2][2];
#pragma unroll
        for (int bj = 0; bj < 2; ++bj)
#pragma unroll
            for (int n = 0; n < 2; ++n) bv[bj][n] = bias ? *(const f32x4*)(bias + col0 + bj * HALF + n * 16) : (f32x4){0.f, 0.f, 0.f, 0.f};
#pragma unroll
        for (int ai = 0; ai < 2; ++ai)
#pragma unroll
            for (int m = 0; m < 4; ++m) { float* rowp = C + (size_t)(row0 + ai * HALF + m * 16) * ldc + col0;
#pragma unroll
                for (int bj = 0; bj < 2; ++bj)
#pragma unroll
                    for (int n = 0; n < 2; ++n) *(f32x4*)(rowp + bj * HALF + n * 16) = acc[ai][bj][m][n] + bv[bj][n]; }
    }
};
template <int ACT  > struct EpiBf16 {
    static constexpr bool PERM = true, AFTER_DRAIN = false;
    bf16_t* O; int ldc; const float* bias; int split_cols; size_t split_stride;
    __device__ __forceinline__ void operator()(const f32x4 (&acc)[2][2][4][2], const Unit& u, int wr, int wc, int fr, int fq) const {
        const int row0 = u.pm * BM + wr * 64 + fr; int colt = u.pn * BM; bf16_t* base = O;
        if (split_cols) { const int t = colt / split_cols; base += (size_t)t * split_stride; colt -= t * split_cols; }
        const int col0 = colt + wc * 32 + 8 * fq, bcol0 = u.pn * BM + wc * 32 + 8 * fq;
        f32x4 bv[2][2];
#pragma unroll
        for (int bj = 0; bj < 2; ++bj)
#pragma unroll
            for (int n = 0; n < 2; ++n) bv[bj][n] = bias ? *(const f32x4*)(bias + bcol0 + bj * HALF + 4 * n) : (f32x4){0.f, 0.f, 0.f, 0.f};
#pragma unroll
        for (int ai = 0; ai < 2; ++ai)
#pragma unroll
            for (int m = 0; m < 4; ++m) { bf16_t* rowp = base + (size_t)(row0 + ai * HALF + m * 16) * ldc + col0;
#pragma unroll
                for (int bj = 0; bj < 2; ++bj) { f32x4 v0 = acc[ai][bj][m][0] + bv[bj][0], v1 = acc[ai][bj][m][1] + bv[bj][1];
                    if (ACT == 1) { f32x2 a = gelu_pk((f32x2){v0[0], v0[1]}), b = gelu_pk((f32x2){v0[2], v0[3]}), c = gelu_pk((f32x2){v1[0], v1[1]}), d = gelu_pk((f32x2){v1[2], v1[3]});
                        v0 = (f32x4){a.x, a.y, b.x, b.y}; v1 = (f32x4){c.x, c.y, d.x, d.y}; }
                    if (ACT == 2) {
#pragma unroll
                        for (int j = 0; j < 4; ++j) { v0[j] = 0.5f * v0[j] * (1.0f + erff(v0[j] * 0.70710678f)); v1[j] = 0.5f * v1[j] * (1.0f + erff(v1[j] * 0.70710678f)); } }
                    u32x4 w; w.x = cvt_pk_bf16(v0[0], v0[1]); w.y = cvt_pk_bf16(v0[2], v0[3]); w.z = cvt_pk_bf16(v1[0], v1[1]); w.w = cvt_pk_bf16(v1[2], v1[3]);
                    *(u32x4*)(rowp + bj * HALF) = w; } }
    }
};

struct RowScale { PG8_LAS const float* rsl; int pm0; const float* ssqp;
    __device__ __forceinline__ float operator()(int row) const { if ((row >> 8) == pm0) return rsl[row & 255];
        const f32x4* p = (const f32x4*)(ssqp + (size_t)row * 32); float s = 0.f;
#pragma unroll
        for (int q = 0; q < 8; ++q) { const f32x4 v = p[q]; s += (v.x + v.y) + (v.z + v.w); }
        return __builtin_amdgcn_rsqf(s * (1.0f / 2048.0f) + 1e-6f); } };
__device__ __forceinline__ float silu_f(float x) { return x * __builtin_amdgcn_rcpf(1.0f + __expf(-x)); }
struct EpiSwiGLU {
    static constexpr bool PERM = true, AFTER_DRAIN = false;
    bf16_t* O; int ldc; RowScale rsc;
    __device__ __forceinline__ void operator()(const f32x4 (&acc)[2][2][4][2], const Unit& u, int wr, int wc, int fr, int fq) const {
        const int row0 = u.pm * BM + wr * 64 + fr, col0 = u.pn * HALF + wc * 32 + 8 * fq;
#pragma unroll
        for (int ai = 0; ai < 2; ++ai)
#pragma unroll
            for (int m = 0; m < 4; ++m) { const int row = row0 + ai * HALF + m * 16; bf16_t* rowp = O + (size_t)row * ldc + col0;
                const float rs = rsc(row);
                const f32x4 g0 = acc[ai][0][m][0] * rs, g1 = acc[ai][0][m][1] * rs, u0 = acc[ai][1][m][0] * rs, u1 = acc[ai][1][m][1] * rs;
                float r[8];
#pragma unroll
                for (int j = 0; j < 4; ++j) { r[j] = silu_f(g0[j]) * u0[j]; r[4 + j] = silu_f(g1[j]) * u1[j]; }
                u32x4 w; w.x = cvt_pk_bf16(r[0], r[1]); w.y = cvt_pk_bf16(r[2], r[3]); w.z = cvt_pk_bf16(r[4], r[5]); w.w = cvt_pk_bf16(r[6], r[7]);
                *(u32x4*)rowp = w; }
    }
};
struct EpiResid {
    static constexpr bool PERM = true, AFTER_DRAIN = false;
    float* H; int ldc; bf16_t* HB; float* ssqp; PG8_LAS float* red; bool last;
    __device__ __forceinline__ void operator()(const f32x4 (&acc)[2][2][4][2], const Unit& u, int wr, int wc, int fr, int fq) const {
        const int row0 = u.pm * BM + wr * 64 + fr, col0 = u.pn * BM + wc * 32 + 8 * fq;
        PG8_LAS float* myred = red + (wr * 4 + wc) * 384;
        float part[8];
#pragma unroll
        for (int ai = 0; ai < 2; ++ai) {
            u32x4 t[4][2];
#pragma unroll
            for (int m = 0; m < 4; ++m) { const bf16_t* rowp = HB + (size_t)(row0 + ai * HALF + m * 16) * ldc + col0;
#pragma unroll
                for (int bj = 0; bj < 2; ++bj) t[m][bj] = *(const u32x4*)(rowp + bj * HALF); }
            asm volatile("" ::: "memory");
#pragma unroll
            for (int m = 0; m < 4; ++m) { const size_t off = (size_t)(row0 + ai * HALF + m * 16) * ldc + col0; float s = 0.f;
#pragma unroll
                for (int bj = 0; bj < 2; ++bj) { const u32x4 w0 = t[m][bj];
                    const f32x4 h0 = {__builtin_bit_cast(float, w0.x << 16), __builtin_bit_cast(float, w0.x & 0xFFFF0000u), __builtin_bit_cast(float, w0.y << 16), __builtin_bit_cast(float, w0.y & 0xFFFF0000u)};
                    const f32x4 h1 = {__builtin_bit_cast(float, w0.z << 16), __builtin_bit_cast(float, w0.z & 0xFFFF0000u), __builtin_bit_cast(float, w0.w << 16), __builtin_bit_cast(float, w0.w & 0xFFFF0000u)};
                    const f32x4 v0 = h0 + acc[ai][bj][m][0], v1 = h1 + acc[ai][bj][m][1];
                    if (last) { __builtin_nontemporal_store(v0, (f32x4*)(H + off + bj * HALF)); __builtin_nontemporal_store(v1, (f32x4*)(H + off + bj * HALF + 4)); }
                    else { u32x4 w; w.x = cvt_pk_bf16(v0[0], v0[1]); w.y = cvt_pk_bf16(v0[2], v0[3]); w.z = cvt_pk_bf16(v1[0], v1[1]); w.w = cvt_pk_bf16(v1[2], v1[3]); *(u32x4*)(HB + off + bj * HALF) = w; }
                    s += ((v0[0] * v0[0] + v0[1] * v0[1]) + (v0[2] * v0[2] + v0[3] * v0[3])) + ((v1[0] * v1[0] + v1[1] * v1[1]) + (v1[2] * v1[2] + v1[3] * v1[3])); }
                part[ai * 4 + m] = s; }
            asm volatile("" ::: "memory");
        }
        if (last) return;
#pragma unroll
        for (int r = 0; r < 8; ++r) if (fq > 0) myred[(r * 16 + fr) * 3 + (fq - 1)] = part[r];
        asm volatile("s_waitcnt lgkmcnt(0)" ::: "memory");
        if (fq == 0) {
#pragma unroll
            for (int r = 0; r < 8; ++r) { const float s = part[r] + (myred[(r * 16 + fr) * 3 + 0] + myred[(r * 16 + fr) * 3 + 1]) + myred[(r * 16 + fr) * 3 + 2];
                ssqp[(size_t)(row0 + (r >> 2) * HALF + (r & 3) * 16) * 32 + u.pn * 4 + wc] = s; } }
        asm volatile("s_waitcnt lgkmcnt(0)" ::: "memory");
    }
};
struct EpiPlainBf16 {
    static constexpr bool PERM = true, AFTER_DRAIN = false;
    bf16_t* O; int ldc; RowScale rsc; bool scaled;
    __device__ __forceinline__ void operator()(const f32x4 (&acc)[2][2][4][2], const Unit& u, int wr, int wc, int fr, int fq) const {
        const int row0 = u.pm * BM + wr * 64 + fr, col0 = u.pn * BM + wc * 32 + 8 * fq;
#pragma unroll
        for (int ai = 0; ai < 2; ++ai)
#pragma unroll
            for (int m = 0; m < 4; ++m) { const int row = row0 + ai * HALF + m * 16; bf16_t* rowp = O + (size_t)row * ldc + col0;
                const float rs = scaled ? rsc(row) : 1.0f;
#pragma unroll
                for (int bj = 0; bj < 2; ++bj) { const f32x4 v0 = acc[ai][bj][m][0] * rs, v1 = acc[ai][bj][m][1] * rs;
                    u32x4 w; w.x = cvt_pk_bf16(v0[0], v0[1]); w.y = cvt_pk_bf16(v0[2], v0[3]); w.z = cvt_pk_bf16(v1[0], v1[1]); w.w = cvt_pk_bf16(v1[2], v1[3]);
                    *(u32x4*)(rowp + bj * HALF) = w; } }
    }
};
struct EpiSlots {
    static constexpr bool PERM = true, AFTER_DRAIN = false;
    bf16_t* O; int Mrows; RowScale rsc;
    __device__ __forceinline__ void operator()(const f32x4 (&acc)[2][2][4][2], const Unit& u, int wr, int wc, int fr, int fq) const {
        const int row0 = u.pm * BM + wr * 64 + fr, d0 = wc * 32 + 8 * fq;
#pragma unroll
        for (int ai = 0; ai < 2; ++ai)
#pragma unroll
            for (int m = 0; m < 4; ++m) { const float rs = rsc(row0 + ai * HALF + m * 16);
#pragma unroll
                for (int bj = 0; bj < 2; ++bj) { const f32x4 v0 = acc[ai][bj][m][0] * rs, v1 = acc[ai][bj][m][1] * rs;
                    bf16_t* p = O + ((size_t)(2 * u.pn + bj) * Mrows + (row0 + ai * HALF + m * 16)) * 128 + d0;
                    u32x4 w; w.x = cvt_pk_bf16(v0[0], v0[1]); w.y = cvt_pk_bf16(v0[2], v0[3]); w.z = cvt_pk_bf16(v1[0], v1[1]); w.w = cvt_pk_bf16(v1[2], v1[3]);
                    *(u32x4*)p = w; } }
    }
};
struct EpiSiluBias {
    static constexpr bool PERM = true, AFTER_DRAIN = false;
    bf16_t* O; int ldc; const float* bias;
    __device__ __forceinline__ void operator()(const f32x4 (&acc)[2][2][4][2], const Unit& u, int wr, int wc, int fr, int fq) const {
        const int row0 = u.pm * BM + wr * 64 + fr, col0 = u.pn * BM + wc * 32 + 8 * fq;
        f32x4 bv[2][2];
#pragma unroll
        for (int bj = 0; bj < 2; ++bj)
#pragma unroll
            for (int n = 0; n < 2; ++n) bv[bj][n] = *(const f32x4*)(bias + col0 + bj * HALF + 4 * n);
#pragma unroll
        for (int ai = 0; ai < 2; ++ai)
#pragma unroll
            for (int m = 0; m < 4; ++m) { bf16_t* rowp = O + (size_t)(row0 + ai * HALF + m * 16) * ldc + col0;
#pragma unroll
                for (int bj = 0; bj < 2; ++bj) { const f32x4 v0 = acc[ai][bj][m][0] + bv[bj][0], v1 = acc[ai][bj][m][1] + bv[bj][1];
                    u32x4 w; w.x = cvt_pk_bf16(silu_f(v0[0]), silu_f(v0[1])); w.y = cvt_pk_bf16(silu_f(v0[2]), silu_f(v0[3])); w.z = cvt_pk_bf16(silu_f(v1[0]), silu_f(v1[1])); w.w = cvt_pk_bf16(silu_f(v1[2]), silu_f(v1[3]));
                    *(u32x4*)(rowp + bj * HALF) = w; } }
    }
};

template <class Epi, class Sched, bool STAMP = false>
__device__ __forceinline__ void gemm_phase(PG8_LAS unsigned char* lds, const Gemm g, const Sched& S, const Epi& E, unsigned long long* stamps, int tid_in) {
    int tid_ = tid_in; asm volatile("" : "+v"(tid_));
    const int tid = tid_, wid = __builtin_amdgcn_readfirstlane(tid >> 6), lane = tid & 63, wr = wid >> 2, wc = wid & 3, fr = lane & 15, fq = lane >> 4;
    const int K = g.K, nt = K / BK;
    int ts_lo = 0, ts_hi = 0, nts = 0; const unsigned long long rt_entry = STAMP ? (unsigned long long)wall_clock64() : 0ull;
#define PG8_STAMP() do { if (STAMP && wid == 0 && nts < 64) { const unsigned long long _c = (unsigned long long)clock64(); \
        ts_lo = (lane == nts) ? (int)(unsigned)_c : ts_lo; ts_hi = (lane == nts) ? (int)(unsigned)(_c >> 32) : ts_hi; ++nts; } } while (0)
    PG8_STAMP();
    unsigned voffA[2], voffB[2];
#pragma unroll
    for (int i = 0; i < 2; ++i) { int R, C; stage_rc(tid * 16 + i * 8192, R, C); const int Rb = Epi::PERM ? ((R & ~31) + perm32(R & 31)) : R;
        voffA[i] = (unsigned)(R * g.lda + C) * 2u; voffB[i] = (unsigned)(Rb * g.ldb + C) * 2u; }
    const size_t kstep = (size_t)(BK * 2);
    const size_t hstepA = (size_t)HALF * g.lda * 2, hstepB = (size_t)HALF * g.ldb * 2;
    const size_t tstepA = 2 * hstepA, tstepB = 2 * hstepB;
    const unsigned ldsw = (unsigned)wid * 1024u;
    const int aoff = lds_byte(wr * 64 + fr, fq * 8), boff = lds_byte(wc * 32 + fr, fq * 8);
#define PG8_SA(b, h) (((b) * 2 + (h)) * HTB)
#define PG8_SB(b, h) ((4 + (b) * 2 + (h)) * HTB)
#define PG8_STAGE(bufoff, gbase, voff) do { _Pragma("unroll") for (int _i = 0; _i < 2; ++_i) \
        __builtin_amdgcn_global_load_lds((const unsigned*)((const char*)(gbase) + (voff)[_i]), (PG8_LAS unsigned*)(lds + (bufoff) + ldsw + _i * 8192), 16, 0, 0); } while (0)
#define PG8_LDA(dst, b, h) do { _Pragma("unroll") for (int m = 0; m < 4; ++m) _Pragma("unroll") for (int k = 0; k < 2; ++k) dst[m][k] = *(const PG8_LAS bf16x8*)(lds + PG8_SA(b, h) + aoff + m * 2048 + k * 1024); } while (0)
#define PG8_LDB(dst, b, h) do { _Pragma("unroll") for (int n = 0; n < 2; ++n) _Pragma("unroll") for (int k = 0; k < 2; ++k) dst[n][k] = *(const PG8_LAS bf16x8*)(lds + PG8_SB(b, h) + boff + n * 2048 + k * 1024); } while (0)
#define PG8_MMA(ai, bj, At, Bt) do { __builtin_amdgcn_s_setprio(1); _Pragma("unroll") for (int m = 0; m < 4; ++m) _Pragma("unroll") for (int n = 0; n < 2; ++n) _Pragma("unroll") for (int k = 0; k < 2; ++k) \
        acc[ai][bj][m][n] = __builtin_amdgcn_mfma_f32_16x16x32_bf16(Bt[n][k], At[m][k], acc[ai][bj][m][n], 0, 0, 0); __builtin_amdgcn_s_setprio(0); } while (0)
#define PG8_WAIT_V(n) asm volatile("s_waitcnt vmcnt(" #n ")" ::: "memory")
#define PG8_WAIT_L(n) asm volatile("s_waitcnt lgkmcnt(" #n ")" ::: "memory")
#define PG8_BAR __builtin_amdgcn_s_barrier()
#define PG8_SCHED __builtin_amdgcn_sched_barrier(0)
    Unit cur, nxt; int ui = 0;
    if (!S.next(0, cur)) return;
    f32x4 acc[2][2][4][2];
#pragma unroll
    for (int a = 0; a < 2; ++a)
#pragma unroll
        for (int b = 0; b < 2; ++b)
#pragma unroll
            for (int m = 0; m < 4; ++m)
#pragma unroll
                for (int n = 0; n < 2; ++n) acc[a][b][m][n] = (f32x4){0.f, 0.f, 0.f, 0.f};
    bf16x8 At[4][2], B0[2][2], B1[2][2];
    const char* cA = (const char*)g.A + (size_t)cur.pm * tstepA + (size_t)((cur.pn & g.amask) * g.astride) * 2; const char* cB = (const char*)g.Bt + (size_t)cur.pn * tstepB;
    S.a_ready(cur);
    PG8_STAGE(PG8_SB(0, 0), cB, voffB); PG8_STAGE(PG8_SA(0, 0), cA, voffA); PG8_STAGE(PG8_SB(0, 1), cB + hstepB, voffB); PG8_STAGE(PG8_SA(0, 1), cA + hstepA, voffA);
    if (wr == 1) PG8_BAR;
    PG8_WAIT_V(4); PG8_BAR;
    PG8_STAGE(PG8_SB(1, 0), cB + kstep, voffB); PG8_STAGE(PG8_SA(1, 0), cA + kstep, voffA); PG8_STAGE(PG8_SB(1, 1), cB + hstepB + kstep, voffB);
    PG8_WAIT_V(6); PG8_BAR;
    PG8_STAMP();
    for (;;) {
        const bool has_next = S.next(ui + 1, nxt);
        const char* nA = has_next ? (const char*)g.A + (size_t)nxt.pm * tstepA + (size_t)((nxt.pn & g.amask) * g.astride) * 2 : cA; const char* nB = has_next ? (const char*)g.Bt + (size_t)nxt.pn * tstepB : cB;
        for (int t = 0; t < nt; t += 2) {
            const bool last = (t == nt - 2);
            const char* a1 = cA + (size_t)(t + 1) * kstep;
            const char* a2 = last ? nA : cA + (size_t)(t + 2) * kstep; const char* b2 = last ? nB : cB + (size_t)(t + 2) * kstep;
            const char* a3 = a2 + kstep; const char* b3 = b2 + kstep;
            if (last && has_next) S.a_ready(nxt);
            PG8_LDB(B0, 0, 0); PG8_SCHED; PG8_LDA(At, 0, 0); PG8_STAGE(PG8_SA(1, 1), a1 + hstepA, voffA);
            PG8_WAIT_L(8); PG8_BAR; PG8_WAIT_L(0); PG8_MMA(0, 0, At, B0); PG8_BAR; PG8_SCHED;
            PG8_LDB(B1, 0, 1); PG8_STAGE(PG8_SB(0, 0), b2, voffB);
            PG8_BAR; PG8_WAIT_L(0); PG8_MMA(0, 1, At, B1); PG8_BAR;
            PG8_LDA(At, 0, 1); PG8_STAGE(PG8_SA(0, 0), a2, voffA);
            PG8_BAR; PG8_WAIT_L(0); PG8_MMA(1, 0, At, B0); PG8_BAR; PG8_SCHED;
            PG8_STAGE(PG8_SB(0, 1), b2 + hstepB, voffB);
            PG8_WAIT_V(6); PG8_BAR; PG8_MMA(1, 1, At, B1); PG8_BAR;
            PG8_LDB(B0, 1, 0); PG8_SCHED; PG8_LDA(At, 1, 0); PG8_STAGE(PG8_SA(0, 1), a2 + hstepA, voffA);
            PG8_WAIT_L(8); PG8_BAR; PG8_WAIT_L(0); PG8_MMA(0, 0, At, B0); PG8_BAR; PG8_SCHED;
            PG8_LDB(B1, 1, 1); PG8_STAGE(PG8_SB(1, 0), b3, voffB);
            PG8_BAR; PG8_WAIT_L(0); PG8_MMA(0, 1, At, B1); PG8_BAR;
            PG8_LDA(At, 1, 1); PG8_STAGE(PG8_SA(1, 0), a3, voffA);
            PG8_BAR; PG8_WAIT_L(0); PG8_MMA(1, 0, At, B0); PG8_BAR; PG8_SCHED;
            PG8_STAGE(PG8_SB(1, 1), b3 + hstepB, voffB);
            PG8_WAIT_V(6); PG8_BAR; PG8_MMA(1, 1, At, B1); PG8_BAR;
        }
        PG8_STAMP();
        if constexpr (!Epi::AFTER_DRAIN) { E(acc, cur, wr, wc, fr, fq); S.done(cur); }
        PG8_STAMP();
        if (!has_next) break;
#pragma unroll
        for (int a = 0; a < 2; ++a)
#pragma unroll
            for (int b = 0; b < 2; ++b)
#pragma unroll
                for (int m = 0; m < 4; ++m)
#pragma unroll
                    for (int n = 0; n < 2; ++n) acc[a][b][m][n] = (f32x4){0.f, 0.f, 0.f, 0.f};
        cur = nxt; cA = nA; cB = nB; ++ui;
    }
    PG8_WAIT_V(0);
    if (wr == 0) PG8_BAR;
    PG8_BAR;
    if constexpr (Epi::AFTER_DRAIN) { E.fused(acc, cur, wr, wc, fr, fq, lds, wid, lane); S.done(cur); }
    PG8_STAMP();
    if (STAMP && wid == 0) { stamps[lane] = lane < nts ? (((unsigned long long)(unsigned)ts_hi << 32) | (unsigned)ts_lo) : 0ull;
        if (lane == 62) stamps[62] = rt_entry; if (lane == 63) stamps[63] = (unsigned long long)wall_clock64(); }
#undef PG8_STAMP
#undef PG8_SA
#undef PG8_SB
#undef PG8_STAGE
#undef PG8_LDA
#undef PG8_LDB
#undef PG8_MMA
#undef PG8_WAIT_V
#undef PG8_WAIT_L
#undef PG8_BAR
#undef PG8_SCHED
}
}

using pg8::Gemm; using pg8::StaticOrder; using pg8::gemm_phase;

constexpr size_t MiB = 1u << 20;
constexpr size_t WS_CTL = 0, CTL_ZERO_BYTES = 1 * MiB;
constexpr int CW_BAR = 4096;
constexpr size_t GU_BYTES = (size_t)2 * FF * D * 2, DN_BYTES = (size_t)D * FF * 2, ABIN_BYTES = (size_t)AB_N * D * 2, SQ_BYTES = (size_t)D * D * 2, CIN_BYTES = (size_t)C_N * D * 2;
constexpr size_t CMP1_BYTES = (size_t)256 * 4096 * 2, WQK_BYTES = (size_t)2048 * 256 * 2;
constexpr size_t WS_WGU = 1 * MiB;
constexpr size_t WS_WD = WS_WGU + 8 * GU_BYTES;
constexpr size_t WS_WABIN = WS_WD + 8 * DN_BYTES;
constexpr size_t WS_WABOUT = WS_WABIN + 2 * ABIN_BYTES;
constexpr size_t WS_WCIN = WS_WABOUT + 2 * SQ_BYTES;
constexpr size_t WS_WCOUT = WS_WCIN + 2 * CIN_BYTES;
constexpr size_t WS_WCMP1 = WS_WCOUT + 2 * SQ_BYTES;
constexpr size_t WS_WQK = WS_WCMP1 + 4 * CMP1_BYTES;
constexpr int ROPE_ROWS = 8208;
constexpr size_t WS_ROPE = WS_WQK + 2 * WQK_BYTES;
constexpr size_t WS_CB = WS_ROPE + 5 * MiB;
constexpr size_t WS_WSK = WS_CB + 64 * 1024;
constexpr size_t WS_HN = WS_CB + 2 * MiB;
static_assert(WS_WSK + (size_t)4 * 64 * D * 2 <= WS_HN, "skinny weights");
constexpr size_t WS_ACT = WS_HN + 64 * MiB;
constexpr size_t WS_MIX = WS_ACT + 224 * MiB;
constexpr size_t MX_C = 0, MX_QK = 32 * MiB, MX_CST = 96 * MiB, MX_SST = 224 * MiB, MX_Y = 288 * MiB, MX_GIF = 352 * MiB, MX_NST = 353 * MiB, MX_SCL = 354 * MiB, MX_HDEC = 355 * MiB;
constexpr size_t MX_GP = 0, MX_HID = 4 * MiB, MX_KCMP = 8 * MiB, MX_VCMP = 9 * MiB, MX_O = 288 * MiB;
constexpr size_t WS_SSQP = WS_MIX + 356 * MiB;
constexpr size_t SSQP_V = (size_t)T * 32 * 4;
constexpr size_t WS_END = WS_SSQP + 28 * MiB;
static_assert(WS_ROPE + (size_t)ROPE_ROWS * 64 * 2 * 4 <= WS_CB, "rope table");

__device__ __forceinline__ float ssqp_rstd(const float* ssqp, int row) {
    const f32x4* p = (const f32x4*)(ssqp + (size_t)row * 32); float s = 0.f;
#pragma unroll
    for (int q = 0; q < 8; ++q) { const f32x4 v = p[q]; s += (v.x + v.y) + (v.z + v.w); }
    return __builtin_amdgcn_rsqf(s * (1.0f / 2048.0f) + 1e-6f);
}
constexpr int NWAVES = 8, NTHREADS = 512;
constexpr int LDS_BYTES = 147456;
constexpr int RING_BYTES = 131072, MISC_OFF = RING_BYTES + 320, RED_OFF = RING_BYTES + 1024;

struct Args { const float* in[31]; float* out; unsigned char* ws; int ph_lo, ph_hi; };
static_assert(sizeof(Args) == 31 * 8 + 8 + 8 + 8, "Args has no padding");

typedef const Args __attribute__((address_space(4)))* CArgsP;
struct Frame {
    LAS unsigned char* lds;
    int tid, lane, wave, G, bx, gw, NGW;
};
__device__ __forceinline__ Frame make_frame(unsigned char* lds_raw, int wave_s) {
    Frame F; int w = wave_s, bx = blockIdx.x, G = gridDim.x;
    asm volatile("" : "+s"(w)); asm volatile("" : "+s"(bx)); asm volatile("" : "+s"(G));
    int tid = w * 64 + lane_id(); asm volatile("" : "+v"(tid));
    F.lds = (LAS unsigned char*)lds_raw; F.tid = tid; F.lane = tid & 63; F.wave = w;
    F.G = G; F.bx = bx; F.gw = bx * NWAVES + F.wave; F.NGW = G * NWAVES;
    return F;
}
__device__ __forceinline__ CArgsP get_args() { CArgsP p = (CArgsP)__builtin_amdgcn_kernarg_segment_ptr(); asm volatile("" : "+s"(p)); return p; }
#define LDS_WAIT() asm volatile("s_waitcnt lgkmcnt(0)" ::: "memory")

struct Job { const float* src; int ldn, K, col0, ncols; bf16_t* dst; int dst_ld, row0, mode; float scale; const float* kgain; };
constexpr int NJOBS = 64;
__device__ __forceinline__ Job make_job(int j, CArgsP ap) {
    Job J; J.scale = 1.0f; J.row0 = 0; J.mode = 0; J.col0 = 0; J.kgain = nullptr;
    unsigned char* ws = ap->ws;
    if (j < 24) { const int f = j / 3, kind = j % 3, layer = f >> 1, half = f & 1;
        if (kind < 2) { J.src = ap->in[(half ? 7 : 2) + kind] + (size_t)layer * D * FF; J.ldn = FF; J.K = D; J.ncols = FF; J.dst = (bf16_t*)(ws + WS_WGU + (size_t)f * GU_BYTES); J.dst_ld = D; J.mode = 1 + kind; J.kgain = ap->in[half ? 6 : 1] + (size_t)layer * D; }
        else { J.src = ap->in[half ? 9 : 4] + (size_t)layer * FF * D; J.ldn = D; J.K = FF; J.ncols = D; J.dst = (bf16_t*)(ws + WS_WD + (size_t)f * DN_BYTES); J.dst_ld = FF; J.scale = 0.5f; }
    } else if (j < 38) { const int q = j - 24, l = q / 7, seg = q % 7;
        J.src = ap->in[10] + (size_t)l * D * AB_COLS; J.ldn = AB_COLS; J.K = D; J.col0 = seg < 3 ? seg * 1024 : 3080 + (seg - 3) * 1024; J.ncols = 1024;
        J.dst = (bf16_t*)(ws + WS_WABIN + (size_t)l * ABIN_BYTES); J.dst_ld = D; J.row0 = seg * 1024; J.kgain = ap->in[5] + (size_t)(2 * l) * D;
    } else if (j < 40) { const int l = j - 38; J.src = ap->in[11] + (size_t)l * D * D; J.ldn = D; J.K = D; J.ncols = D; J.dst = (bf16_t*)(ws + WS_WABOUT + (size_t)l * SQ_BYTES); J.dst_ld = D;
    } else if (j < 42) { const int l = j - 40; J.src = ap->in[22] + (size_t)l * D * C_COLS; J.ldn = C_COLS; J.K = D; J.ncols = C_N; J.dst = (bf16_t*)(ws + WS_WCIN + (size_t)l * CIN_BYTES); J.dst_ld = D; J.kgain = ap->in[5] + (size_t)(2 * l + 1) * D;
    } else if (j < 44) { const int l = j - 42; J.src = ap->in[23] + (size_t)l * D * D; J.ldn = D; J.K = D; J.ncols = D; J.dst = (bf16_t*)(ws + WS_WCOUT + (size_t)l * SQ_BYTES); J.dst_ld = D;
    } else if (j < 48) { const int q = j - 44; J.src = ap->in[27] + (size_t)q * 4096 * 256; J.ldn = 256; J.K = 4096; J.ncols = 256; J.dst = (bf16_t*)(ws + WS_WCMP1 + (size_t)q * CMP1_BYTES); J.dst_ld = 4096;
    } else { const int q = j - 48, l = q / 8, r = q % 8, isk = r / 4, hh = r % 4;
        J.src = ap->in[isk ? 15 : 14] + (size_t)(l * 4 + hh) * 65536; J.ldn = 256; J.K = 256; J.ncols = 256; J.dst = (bf16_t*)(ws + WS_WQK + (size_t)l * WQK_BYTES); J.dst_ld = 256; J.row0 = isk * 1024 + hh * 256; J.scale = isk ? 0.0625f : 1.0f; }
    return J;
}
__device__ __forceinline__ void transpose_item(const Job& J, LAS float* scr, int item, int lane) {
    const int nblk = J.ncols / 64, kb = item / nblk, nb = item % nblk, k0 = 64 * kb, n0 = 64 * nb;
    const float* W = J.src + J.col0 + n0 + 4 * (lane & 15);
    f32x4 wv[16];
#pragma unroll
    for (int i = 0; i < 16; ++i) { const int kk = 4 * i + (lane >> 4); wv[i] = __builtin_nontemporal_load((const f32x4*)(W + (size_t)(k0 + kk) * J.ldn)); }
#pragma unroll
    for (int i = 0; i < 16; ++i) { const int kk = 4 * i + (lane >> 4); *(LAS f32x4*)(scr + kk * 64 + (((lane & 15) ^ ((kk >> 3) & 7)) << 2)) = wv[i]; }
    LDS_WAIT();
    const int c = lane & 7;
    const int drow0 = J.mode == 0 ? J.row0 + n0 : (n0 >> 7) * 256 + (n0 & 127) + (J.mode == 2 ? 128 : 0);
    const float sc = J.scale;
    f32x4 g0 = (f32x4){sc, sc, sc, sc}, g1 = g0;
    if (J.kgain) { g0 = *(const f32x4*)(J.kgain + k0 + 8 * c) * sc; g1 = *(const f32x4*)(J.kgain + k0 + 8 * c + 4) * sc; }
#pragma unroll
    for (int jj = 0; jj < 8; ++jj) { const int n = (lane >> 3) + 8 * jj; const LAS float* s = scr + (8 * c) * 64 + ((((n >> 2) ^ c) << 2) | (n & 3));
        v4u o; o.x = pk2(s[0 * 64] * g0.x, s[1 * 64] * g0.y); o.y = pk2(s[2 * 64] * g0.z, s[3 * 64] * g0.w); o.z = pk2(s[4 * 64] * g1.x, s[5 * 64] * g1.y); o.w = pk2(s[6 * 64] * g1.z, s[7 * 64] * g1.w);
        __builtin_nontemporal_store(o, (v4u*)(J.dst + (size_t)(drow0 + n) * J.dst_ld + k0 + 8 * c)); }
    LDS_WAIT();
}
__device__ __forceinline__ void ph_prologue(Frame& F, CArgsP ap) {
    LAS float* scr = (LAS float*)(F.lds + F.wave * 16384);
    for (int j = 0; j < NJOBS; ++j) {
        const Job J = make_job(j, ap);
        const int nitems = (J.K / 64) * (J.ncols / 64);
        for (int it = F.gw; it < nitems; it += F.NGW) transpose_item(J, scr, it, F.lane);
    }
    float* rope = (float*)(ap->ws + WS_ROPE);
    for (int idx = F.bx * NTHREADS + F.tid; idx < ROPE_ROWS * 64; idx += F.G * NTHREADS) {
        const int p = idx >> 6, i = idx & 63;
        const float inv = powf(10000.0f, -(float)i / 64.0f), ang = (float)p * inv;
        float sn, cs; sincosf(ang, &sn, &cs);
        rope[2 * idx] = cs; rope[2 * idx + 1] = sn;
    }
    float* cb = (float*)(ap->ws + WS_CB);
    for (int idx = F.gw; idx < 4 * 256; idx += F.NGW) {
        const int q = idx >> 8, c = idx & 255;
        const float* pos = ap->in[26] + (size_t)q * 4096; const float* w1 = ap->in[27] + (size_t)q * 4096 * 256 + c;
        float s = 0.f;
#pragma unroll 16
        for (int f = F.lane; f < 4096; f += 64) s += pos[f] * w1[(size_t)f * 256];
        s = wave_sum(s);
        if (F.lane == 0) cb[idx] = s + ap->in[28][idx];
    }
    { bf16_t* wsk = (bf16_t*)(ap->ws + WS_WSK);
      for (int idx = F.bx * NTHREADS + F.tid; idx < 4 * 64 * D; idx += F.G * NTHREADS) {
          const int q = idx / (64 * D), r = idx - q * 64 * D, n = r / D, k = r - n * D;
          const float* src = q < 2 ? ap->in[10] + (size_t)q * D * AB_COLS + (size_t)k * AB_COLS + 3072 : ap->in[22] + (size_t)(q - 2) * D * C_COLS + (size_t)k * C_COLS + 5120;
          const int nj = q < 2 ? 8 : 48;
          const float gk = ap->in[5][(size_t)(q < 2 ? 2 * q : 2 * (q - 2) + 1) * D + k];
          wsk[idx] = n < nj ? (bf16_t)f2bf(src[n] * gk) : (bf16_t)0; } }
    { bf16_t* HB = (bf16_t*)(ap->ws + WS_HN); float* ssq0 = (float*)(ap->ws + WS_SSQP);
      for (int row = F.gw; row < T; row += F.NGW) {
          const f32x4* xr = (const f32x4*)(ap->in[0] + (size_t)row * D) + F.lane; v2u* o8 = (v2u*)(HB + (size_t)row * D) + F.lane;
          float s = 0.f;
#pragma unroll
          for (int j = 0; j < 8; ++j) { const f32x4 v = __builtin_nontemporal_load(xr + 64 * j); v2u o; o.x = pk2(v.x, v.y); o.y = pk2(v.z, v.w); o8[64 * j] = o; s += (v.x * v.x + v.y * v.y) + (v.z * v.z + v.w * v.w); }
          s = wave_sum(s);
          if (F.lane < 32) ssq0[(size_t)row * 32 + F.lane] = F.lane == 0 ? s : 0.f; } }
}

template <int NJ>
__device__ __forceinline__ void ph_skinny(Frame& F, const bf16_t* HB, const float* ssqp, const bf16_t* Wsk, float* outp) {
    for (int blk = F.bx; blk < T / 64; blk += F.G) {
        const int lane = F.lane, l15 = lane & 15, quad = lane >> 4, mt = F.wave >> 1, nt0 = (F.wave & 1) * 2;
        const bf16_t* ap_ = HB + (size_t)(blk * 64 + mt * 16 + l15) * D + 8 * quad;
        const bf16_t* b0p = Wsk + (size_t)(nt0 * 16 + l15) * D + 8 * quad; const bf16_t* b1p = b0p + (size_t)16 * D;
        f32x4 a0 = (f32x4){0.f, 0.f, 0.f, 0.f}, a1 = (f32x4){0.f, 0.f, 0.f, 0.f};
        const bool t0on = nt0 * 16 < NJ, t1on = (nt0 + 1) * 16 < NJ;
        if (t0on && t1on) {
#pragma unroll 8
            for (int ks = 0; ks < D / 32; ++ks) { const bf16x8 a = *(const bf16x8*)(ap_ + 32 * ks), b0 = *(const bf16x8*)(b0p + 32 * ks), b1 = *(const bf16x8*)(b1p + 32 * ks);
                a0 = __builtin_amdgcn_mfma_f32_16x16x32_bf16(a, b0, a0, 0, 0, 0); a1 = __builtin_amdgcn_mfma_f32_16x16x32_bf16(a, b1, a1, 0, 0, 0); }
        } else if (t0on) {
#pragma unroll 8
            for (int ks = 0; ks < D / 32; ++ks) { const bf16x8 a = *(const bf16x8*)(ap_ + 32 * ks), b0 = *(const bf16x8*)(b0p + 32 * ks);
                a0 = __builtin_amdgcn_mfma_f32_16x16x32_bf16(a, b0, a0, 0, 0, 0); }
        }
#pragma unroll
        for (int e = 0; e < 4; ++e) { const int row = blk * 64 + mt * 16 + 4 * quad + e; const int c0 = nt0 * 16 + l15, c1 = c0 + 16;
            const float rs = ssqp_rstd(ssqp, row);
            if (c0 < NJ) outp[(size_t)row * NJ + c0] = a0[e] * rs; if (c1 < NJ) outp[(size_t)row * NJ + c1] = a1[e] * rs; }
    }
}

__device__ __forceinline__ void panel_rstd(Frame& F, const float* ssqp, int pm, LAS float* rsl) {
    const int row = pm * 256 + (F.tid >> 1); const f32x4* p = (const f32x4*)(ssqp + (size_t)row * 32 + (F.tid & 1) * 16); float s = 0.f;
#pragma unroll
    for (int q = 0; q < 4; ++q) { const f32x4 v = p[q]; s += (v.x + v.y) + (v.z + v.w); }
    const float o = DPP_F(s, 0xB1);
    const float t = (F.tid & 1) ? o + s : s + o;
    if ((F.tid & 1) == 0) rsl[F.tid >> 1] = __builtin_amdgcn_rsqf(t * (1.0f / 2048.0f) + 1e-6f);
    __syncthreads();
}

__device__ __forceinline__ void unpack8(const v4u u, float (&f)[8]) { f[0] = bflo(u.x); f[1] = bfhi(u.x); f[2] = bflo(u.y); f[3] = bfhi(u.y); f[4] = bflo(u.z); f[5] = bfhi(u.z); f[6] = bflo(u.w); f[7] = bfhi(u.w); }
__device__ __forceinline__ void ph_conv(Frame& F, const bf16_t* P, const float* cw, const float* cbias, bf16_t* cbuf) {
    const int idx0 = F.bx * NTHREADS + F.tid, c0 = (idx0 & 127) * 8, stride = F.G * NTHREADS;
    if ((stride & 127) != 0) {
        for (int idx = idx0; idx < T * 128; idx += stride) { const int t = idx >> 7, cc = (idx & 127) * 8, tl = t & (SEQ - 1); float acc[8];
#pragma unroll
            for (int e = 0; e < 8; ++e) acc[e] = cbias[cc + e];
#pragma unroll
            for (int jj = 0; jj < 4; ++jj) { if (tl - 3 + jj >= 0) { float uf[8]; unpack8(*(const v4u*)(P + (size_t)(t - 3 + jj) * AB_N + cc), uf);
#pragma unroll
                    for (int e = 0; e < 8; ++e) acc[e] += uf[e] * cw[jj * 1024 + cc + e]; } }
            v4u o; o.x = pk2(siluf_(acc[0]), siluf_(acc[1])); o.y = pk2(siluf_(acc[2]), siluf_(acc[3])); o.z = pk2(siluf_(acc[4]), siluf_(acc[5])); o.w = pk2(siluf_(acc[6]), siluf_(acc[7]));
            *(v4u*)(cbuf + (size_t)t * 1024 + cc) = o; }
        return; }
    float wt[4][8], bs[8];
#pragma unroll
    for (int e = 0; e < 8; ++e) { bs[e] = cbias[c0 + e];
#pragma unroll
        for (int jj = 0; jj < 4; ++jj) wt[jj][e] = cw[jj * 1024 + c0 + e]; }
    const int tstride = stride >> 7;
    for (int t0 = idx0 >> 7; t0 < T; t0 += 4 * tstride) {
        v4u in[4][4];
#pragma unroll
        for (int u = 0; u < 4; ++u) { const int t = t0 + u * tstride, tl = t & (SEQ - 1);
#pragma unroll
            for (int jj = 0; jj < 4; ++jj) { in[u][jj] = (v4u){0u, 0u, 0u, 0u}; if (t < T && tl - 3 + jj >= 0) in[u][jj] = *(const v4u*)(P + (size_t)(t - 3 + jj) * AB_N + c0); } }
#pragma unroll
        for (int u = 0; u < 4; ++u) { const int t = t0 + u * tstride;
            if (t < T) { float acc[8];
#pragma unroll
                for (int e = 0; e < 8; ++e) acc[e] = bs[e];
#pragma unroll
                for (int jj = 0; jj < 4; ++jj) { float uf[8]; unpack8(in[u][jj], uf);
#pragma unroll
                    for (int e = 0; e < 8; ++e) acc[e] += uf[e] * wt[jj][e]; }
                v4u o; o.x = pk2(siluf_(acc[0]), siluf_(acc[1])); o.y = pk2(siluf_(acc[2]), siluf_(acc[3])); o.z = pk2(siluf_(acc[4]), siluf_(acc[5])); o.w = pk2(siluf_(acc[6]), siluf_(acc[7]));
                *(v4u*)(cbuf + (size_t)t * 1024 + c0) = o; } }
    }
}

#ifndef CK_DUP_ML3
#define CK_DUP_ML3 0
#endif
#ifndef CK_DUP_HG3
#define CK_DUP_HG3 0
#endif
namespace ck {
typedef short s16x4 __attribute__((ext_vector_type(4)));
constexpr int CL = 64;
constexpr int NCH = SEQ / CL;
constexpr int NU_ML = BATCH * 4 * NCH, NU_HG = BATCH * 8 * NCH;
__device__ __forceinline__ bf16x8 frag_rowk(const LAS bf16_t* base, int pitch, int r0, int k0, int lane) { return *(const LAS bf16x8*)(base + (r0 + (lane & 15)) * pitch + k0 + 8 * (lane >> 4)); }
__device__ __forceinline__ bf16x8 frag_rowk_g(const bf16_t* base, int ld, int r0, int k0, int lane) { return *(const bf16x8*)(base + (size_t)(r0 + (lane & 15)) * ld + k0 + 8 * (lane >> 4)); }
__device__ __forceinline__ bf16x8 frag_tr(const LAS bf16_t* base, int pitch, int k0, int c0, int lane) {
    const int i = lane & 15, quad = lane >> 4;
    const unsigned a0 = (unsigned)(uintptr_t)(base + (k0 + 8 * quad + (i >> 2)) * pitch + c0 + 4 * (i & 3));
    s16x4 lo, hi;
    asm volatile("ds_read_b64_tr_b16 %0, %1" : "=&v"(lo) : "v"(a0) : "memory");
    asm volatile("ds_read_b64_tr_b16 %0, %1" : "=&v"(hi) : "v"(a0 + (unsigned)(4 * pitch * 2)) : "memory");
    asm volatile("s_waitcnt lgkmcnt(0)" : "+v"(lo), "+v"(hi) :: "memory");
    return (bf16x8){lo[0], lo[1], lo[2], lo[3], hi[0], hi[1], hi[2], hi[3]};
}
#define MMA16(a, b, c) __builtin_amdgcn_mfma_f32_16x16x32_bf16((a), (b), (c), 0, 0, 0)
__device__ __forceinline__ float log_sig(float x) { return fminf(x, 0.f) - log1pf(expf(-fabsf(x))); }
__device__ __forceinline__ void hg_gate(float z, float one_minus_lb, float& k2, float& lf) {
    const float e = __expf(-fabsf(z)), r = __builtin_amdgcn_rcpf(1.0f + e), sp = __logf(1.0f + e);
    k2 = one_minus_lb * (z >= 0.f ? e * r : r);
    const float t = fminf(k2, 0.999999f);
    const float la = t < 0.0625f ? -t * (1.0f + t * (0.5f + t * (0.33333334f + t * 0.25f))) : __logf(1.0f - t);
    lf = fmaxf(la, fminf(z, 0.f) - sp);
}
__device__ __forceinline__ float wave_scan_add(float x, LAS float* sc, int lane) {
#pragma unroll
    for (int o = 1; o < 64; o <<= 1) { sc[lane] = x; asm volatile("s_waitcnt lgkmcnt(0)" ::: "memory"); const float y = sc[lane >= o ? lane - o : lane]; asm volatile("s_waitcnt lgkmcnt(0)" ::: "memory"); x += lane >= o ? y : 0.f; }
    return x;
}
__device__ __forceinline__ float wave_scan_max(float x, LAS float* sc, int lane) {
#pragma unroll
    for (int o = 1; o < 64; o <<= 1) { sc[lane] = x; asm volatile("s_waitcnt lgkmcnt(0)" ::: "memory"); const float y = sc[lane >= o ? lane - o : lane]; asm volatile("s_waitcnt lgkmcnt(0)" ::: "memory"); x = lane >= o ? fmaxf(x, y) : x; }
    return x;
}
}

__device__ __forceinline__ void ph_chunk_r1(Frame& F, const bf16_t* P, const bf16_t* QK, const float* gif, const float* i_bias, const float* f_bias, const float* lb_logits, int jpair,
                                            bf16_t* CST, float* NST, float* SCL  , bf16_t* SST, float* HDEC) {
    using namespace ck;
    LAS unsigned char* lds = F.lds;
    for (int u = F.bx; u < NU_ML + NU_HG; u += F.G) {
        int tid = F.tid; asm volatile("" : "+v"(tid));
        const int lane = tid & 63, w = __builtin_amdgcn_readfirstlane(tid >> 6);
        if (u < NU_ML) {
            const int bh = u / NCH, j = u - bh * NCH, b = bh >> 2, hh = bh & 3, t0 = b * SEQ + j * CL;
            constexpr int PT = 264;
            LAS bf16_t* Vs = (LAS bf16_t*)lds;
            LAS bf16_t* Ks = Vs + 64 * PT;
            LAS float* av = (LAS float*)(Ks + 64 * PT);
            v4u kq[4], vq[4];
            { const int s = tid >> 3, c0 = (tid & 7) * 32;
              const bf16_t* kp = QK + (size_t)(t0 + s) * 2048 + 1024 + hh * 256 + c0; const bf16_t* vp = P + (size_t)(t0 + s) * AB_N + 1024 + hh * 256 + c0;
#pragma unroll
              for (int q = 0; q < 4; ++q) { kq[q] = *(const v4u*)(kp + 8 * q); vq[q] = *(const v4u*)(vp + 8 * q); } }
            if (w == 0) {
                const float ig = gif[(size_t)(t0 + lane) * 8 + hh] + i_bias[hh];
                const float lf = log_sig(gif[(size_t)(t0 + lane) * 8 + 4 + hh] + f_bias[hh]);
                const float bsum = wave_scan_add(lf, av, lane);
                av[lane] = bsum; LDS_WAIT(); const float g = av[63]; LDS_WAIT();
                const float upd = g - bsum + ig, mloc = wave_max(upd);
                av[lane] = expf(upd - mloc);
                if (lane == 0) { SCL[u * 4 + 0] = g; SCL[u * 4 + 1] = mloc; }
            }
            __syncthreads();
            { const int s = tid >> 3, c0 = (tid & 7) * 32; const float a = av[s];
#pragma unroll
              for (int q = 0; q < 4; ++q) { *(LAS v4u*)(Ks + s * PT + c0 + 8 * q) = kq[q];
                  float f[8]; unpack8(vq[q], f); v4u o; o.x = pk2(f[0] * a, f[1] * a); o.y = pk2(f[2] * a, f[3] * a); o.z = pk2(f[4] * a, f[5] * a); o.w = pk2(f[6] * a, f[7] * a);
                  *(LAS v4u*)(Vs + s * PT + c0 + 8 * q) = o; } }
            __syncthreads();
            if (tid < 256) { float s = 0.f;
                for (int ss = 0; ss < 64; ++ss) s += av[ss] * bf2f(Ks[ss * PT + tid]);
                NST[(size_t)u * 256 + tid] = s; }
            f32x4 acc[16][2];
#pragma unroll
            for (int m = 0; m < 16; ++m) { acc[m][0] = (f32x4){0.f, 0.f, 0.f, 0.f}; acc[m][1] = (f32x4){0.f, 0.f, 0.f, 0.f}; }
#pragma unroll
            for (int ks = 0; ks < 2; ++ks) {
                const bf16x8 b0 = frag_tr(Vs, PT, 32 * ks, 32 * w, lane), b1 = frag_tr(Vs, PT, 32 * ks, 32 * w + 16, lane);
#pragma unroll
                for (int m = 0; m < 16; ++m) { const bf16x8 a = frag_tr(Ks, PT, 32 * ks, 16 * m, lane); acc[m][0] = MMA16(a, b0, acc[m][0]); acc[m][1] = MMA16(a, b1, acc[m][1]); }
            }
            { char* cp = (char*)(CST + (size_t)u * 65536 + (size_t)(32 * w) * 256);
              const unsigned lo0 = (unsigned)(((lane & 15) * 256 + 4 * (lane >> 4)) * 2);
#pragma unroll
              for (int m = 0; m < 16; ++m)
#pragma unroll
                  for (int n = 0; n < 2; ++n) { v2u o; o.x = pk2(acc[m][n][0], acc[m][n][1]); o.y = pk2(acc[m][n][2], acc[m][n][3]); *(v2u*)(cp + (lo0 + (unsigned)((16 * n * 256 + 16 * m) * 2))) = o; } }
            __syncthreads();
        } else {
            const int uu = u - NU_ML, bh = uu / NCH, j = uu - bh * NCH, b = bh >> 3, hh = bh & 7, t0 = b * SEQ + j * CL;
            constexpr int PT = 136;
            LAS float* bS = (LAS float*)lds;
            LAS bf16_t* Kt = (LAS bf16_t*)(bS + 64 * 128);
            LAS bf16_t* Vt = Kt + 64 * PT;
            float k2r[16];
            { const int s = tid >> 3, c0 = (tid & 7) * 16; const bf16_t* pp = P + (size_t)(t0 + s) * AB_N + hh * 128 + c0;
#pragma unroll
              for (int q = 0; q < 2; ++q) { float hf[8]; unpack8(*(const v4u*)(pp + 4096 + 8 * q), hf);
                  *(LAS v4u*)(Vt + s * PT + c0 + 8 * q) = *(const v4u*)(pp + 5120 + 8 * q);
#pragma unroll
                  for (int e = 0; e < 8; ++e) { const int cg = hh * 128 + c0 + 8 * q + e;
                      const float oml = jpair == 0 ? 1.0f : 1.0f - sigmoidf_(lb_logits[1024 + cg] - lb_logits[cg]);
                      float k2, lf; hg_gate(hf[e], oml, k2, lf);
                      k2r[8 * q + e] = k2; bS[s * 128 + c0 + 8 * q + e] = lf; } } }
            __syncthreads();
            { const int c = tid & 127, p = tid >> 7; LAS float* tot = (LAS float*)(Vt + 64 * PT);
              float acc = 0.f;
#pragma unroll
              for (int s = 0; s < 16; ++s) { acc += bS[(16 * p + s) * 128 + c]; bS[(16 * p + s) * 128 + c] = acc; }
              tot[p * 128 + c] = acc;
              __syncthreads();
              float off = 0.f;
#pragma unroll
              for (int pp = 0; pp < 3; ++pp) off += pp < p ? tot[pp * 128 + c] : 0.f;
              if (p > 0) {
#pragma unroll
                  for (int s = 0; s < 16; ++s) bS[(16 * p + s) * 128 + c] += off; }
              if (p == 3) HDEC[(size_t)uu * 128 + c] = __expf(off + acc); }
            __syncthreads();
            { const int s = tid >> 3, c0 = (tid & 7) * 16;
#pragma unroll
              for (int q = 0; q < 2; ++q) { float r[8];
#pragma unroll
                  for (int e = 0; e < 8; ++e) { const int c = c0 + 8 * q + e; r[e] = k2r[8 * q + e] * __expf(bS[63 * 128 + c] - bS[s * 128 + c]); }
                  v4u o; o.x = pk2(r[0], r[1]); o.y = pk2(r[2], r[3]); o.z = pk2(r[4], r[5]); o.w = pk2(r[6], r[7]); *(LAS v4u*)(Kt + s * PT + c0 + 8 * q) = o; } }
            __syncthreads();
            f32x4 acc[8];
#pragma unroll
            for (int m = 0; m < 8; ++m) acc[m] = (f32x4){0.f, 0.f, 0.f, 0.f};
#pragma unroll
            for (int ks = 0; ks < 2; ++ks) { const bf16x8 bb = frag_tr(Vt, PT, 32 * ks, 16 * w, lane);
#pragma unroll
                for (int m = 0; m < 8; ++m) { const bf16x8 a = frag_tr(Kt, PT, 32 * ks, 16 * m, lane); acc[m] = MMA16(a, bb, acc[m]); } }
            { char* sp = (char*)(SST + (size_t)uu * 16384 + (size_t)(16 * w) * 128);
              const unsigned lo0 = (unsigned)(((lane & 15) * 128 + 4 * (lane >> 4)) * 2);
#pragma unroll
              for (int m = 0; m < 8; ++m) { v2u o; o.x = pk2(acc[m][0], acc[m][1]); o.y = pk2(acc[m][2], acc[m][3]); *(v2u*)(sp + (lo0 + (unsigned)(16 * m * 2))) = o; } }
            __syncthreads();
        }
    }
}

__device__ __forceinline__ void ph_chunk_r2(Frame& F, bf16_t* CST, float* NST, float* SCL, bf16_t* SST, const float* HDEC) {
    using namespace ck;
    for (int vb = F.bx; vb < 200; vb += F.G) {
    const int gt = vb * NTHREADS + F.tid;
    if (gt < 65536) {
        const int bh = gt >> 13; const size_t e8 = (size_t)(gt & 8191) * 8;
        float C[8]; float m = 0.f;
#pragma unroll
        for (int e = 0; e < 8; ++e) C[e] = 0.f;
        bf16_t* base = CST + (size_t)bh * NCH * 65536 + e8;
        for (int j0 = 0; j0 < NCH; j0 += 4) {
            v4u d[4]; float gg[4], ml[4];
#pragma unroll
            for (int q = 0; q < 4; ++q) { d[q] = *(const v4u*)(base + (size_t)(j0 + q) * 65536); gg[q] = SCL[(bh * NCH + j0 + q) * 4 + 0]; ml[q] = SCL[(bh * NCH + j0 + q) * 4 + 1]; }
#pragma unroll
            for (int q = 0; q < 4; ++q) {
                v4u o; o.x = pk2(C[0], C[1]); o.y = pk2(C[2], C[3]); o.z = pk2(C[4], C[5]); o.w = pk2(C[6], C[7]);
                *(v4u*)(base + (size_t)(j0 + q) * 65536) = o;
                if ((gt & 8191) == 0) SCL[(bh * NCH + j0 + q) * 4 + 2] = m;
                const float mn = fmaxf(gg[q] + m, ml[q]), a = __expf(gg[q] + m - mn), bc = __expf(ml[q] - mn);
                float f[8]; unpack8(d[q], f);
#pragma unroll
                for (int e = 0; e < 8; ++e) C[e] = a * C[e] + bc * f[e];
                m = mn; }
        }
    } else if (gt < 65536 + 2048) {
        const int idx = gt - 65536, bh = idx >> 8, k = idx & 255; float n = 0.f, m = 0.f;
        for (int j = 0; j < NCH; ++j) { const int u = bh * NCH + j; const float d = NST[(size_t)u * 256 + k], gg = SCL[u * 4 + 0], ml = SCL[u * 4 + 1];
            NST[(size_t)u * 256 + k] = n;
            const float mn = fmaxf(gg + m, ml); n = __expf(gg + m - mn) * n + __expf(ml - mn) * d; m = mn; }
    } else if (gt >= 136 * NTHREADS && gt < 136 * NTHREADS + 32768) {
        const int i = gt - 136 * NTHREADS, bh = i >> 11; const size_t e8 = (size_t)(i & 2047) * 8; const int c0 = (int)(e8 & 127);
        float S[8];
#pragma unroll
        for (int e = 0; e < 8; ++e) S[e] = 0.f;
        bf16_t* base = SST + (size_t)bh * NCH * 16384 + e8; const float* hd = HDEC + (size_t)bh * NCH * 128 + c0;
        for (int j0 = 0; j0 < NCH; j0 += 4) {
            v4u d[4]; f32x4 da[4], db[4];
#pragma unroll
            for (int q = 0; q < 4; ++q) { d[q] = *(const v4u*)(base + (size_t)(j0 + q) * 16384); da[q] = *(const f32x4*)(hd + (size_t)(j0 + q) * 128); db[q] = *(const f32x4*)(hd + (size_t)(j0 + q) * 128 + 4); }
#pragma unroll
            for (int q = 0; q < 4; ++q) {
                v4u o; o.x = pk2(S[0], S[1]); o.y = pk2(S[2], S[3]); o.z = pk2(S[4], S[5]); o.w = pk2(S[6], S[7]);
                *(v4u*)(base + (size_t)(j0 + q) * 16384) = o;
                float f[8]; unpack8(d[q], f);
#pragma unroll
                for (int e = 0; e < 4; ++e) { S[e] = da[q][e] * S[e] + f[e]; S[4 + e] = db[q][e] * S[4 + e] + f[4 + e]; } }
        }
    }
    }
}

__device__ __forceinline__ void ph_chunk_r3(Frame& F, const bf16_t* P, const bf16_t* QK, const bf16_t* cbuf, const float* gif, const float* i_bias, const float* f_bias, const float* lb_logits, int jpair,
                                            const bf16_t* CST, const float* NST, const float* SCL, const bf16_t* SST,
                                            const float* ml_norm, const float* ml_skip, const float* hg_norm, bf16_t* Y) {
    using namespace ck;
    LAS unsigned char* lds = F.lds;
    for (int u = F.bx; u < NU_ML + NU_HG; u += F.G) {
        int tid = F.tid; asm volatile("" : "+v"(tid));
        const int lane = tid & 63, w = __builtin_amdgcn_readfirstlane(tid >> 6), quad = lane >> 4, l15 = lane & 15;
        if (u < NU_ML) { for (int rep_ = 0; rep_ < 1 + CK_DUP_ML3; ++rep_) {
            const int bh = u / NCH, j = u - bh * NCH, b = bh >> 2, hh = bh & 3, t0 = b * SEQ + j * CL;
            constexpr int PT = 264, PW = 72;
            LAS bf16_t* Qs = (LAS bf16_t*)lds; LAS bf16_t* Ks = Qs + 64 * PT; LAS bf16_t* Vs = Ks + 64 * PT; LAS bf16_t* Ws = Vs + 64 * PT;
            LAS float* vec = (LAS float*)(Ws + 64 * PW);
            LAS float* bv = vec, *uv = vec + 64, *rv = vec + 128, *wl = vec + 192, *emt = vec + 256, *qnv = vec + 320, *tmp = vec + 384, *rstd = vec + 448, *part = vec + 512;
            const float mj = SCL[u * 4 + 2];
            bf16x8 cfr[8][2];
            { const bf16_t* Cj = CST + (size_t)u * 65536;
#pragma unroll
              for (int ks = 0; ks < 8; ++ks) { cfr[ks][0] = frag_rowk_g(Cj, 256, 32 * w, 32 * ks, lane); cfr[ks][1] = frag_rowk_g(Cj, 256, 32 * w + 16, 32 * ks, lane); } }
            LAS float* nsl = part + 512;
            if (tid < 64) *(LAS f32x4*)(nsl + 4 * tid) = *(const f32x4*)(NST + (size_t)u * 256 + 4 * tid);
            float ig_raw = 0.f, fg_raw = 0.f;
            if (w == 0) { ig_raw = gif[(size_t)(t0 + lane) * 8 + hh]; fg_raw = gif[(size_t)(t0 + lane) * 8 + 4 + hh]; }
            { const int s = tid >> 3, c0 = (tid & 7) * 32;
              const bf16_t* qp = QK + (size_t)(t0 + s) * 2048 + hh * 256 + c0; const bf16_t* vp = P + (size_t)(t0 + s) * AB_N + 1024 + hh * 256 + c0;
#pragma unroll
              for (int q = 0; q < 4; ++q) { *(LAS v4u*)(Qs + s * PT + c0 + 8 * q) = *(const v4u*)(qp + 8 * q); *(LAS v4u*)(Ks + s * PT + c0 + 8 * q) = *(const v4u*)(qp + 1024 + 8 * q);
                  *(LAS v4u*)(Vs + s * PT + c0 + 8 * q) = *(const v4u*)(vp + 8 * q); }
              { unsigned z0 = 0u; asm volatile("" : "+v"(z0)); *(LAS v4u*)(Ws + s * PW + (tid & 7) * 8) = (v4u){z0, z0, z0, z0}; } }
            if (w == 0) {
                const float ig = ig_raw + i_bias[hh];
                const float lf = log_sig(fg_raw + f_bias[hh]);
                const float bsum = wave_scan_add(lf, tmp, lane);
                const float uu = ig - bsum;
                const float cm = wave_scan_max(uu, tmp, lane);
                const float r = -fmaxf(mj, cm);
                bv[lane] = bsum; uv[lane] = uu; rv[lane] = r; wl[lane] = expf(mj + r); emt[lane] = expf(r - bsum);
            }
            __syncthreads();
            { const int l = tid >> 3, k0 = (tid & 7) * 32; float acc = 0.f;
#pragma unroll 8
              for (int k = 0; k < 32; ++k) acc += nsl[k0 + k] * bf2f(Qs[l * PT + k0 + k]);
              acc += DPP_F(acc, 0xB1); acc += DPP_F(acc, 0x4E); acc += DPP_F(acc, 0x141);
              if ((tid & 7) == 0) qnv[l] = acc; }
            for (int ti = w; ti < 10; ti += 8) {
                const int lt = ti < 1 ? 0 : ti < 3 ? 1 : ti < 6 ? 2 : 3, st = ti - (lt * (lt + 1)) / 2;
                f32x4 acc = (f32x4){0.f, 0.f, 0.f, 0.f};
#pragma unroll
                for (int ks = 0; ks < 8; ++ks) acc = MMA16(frag_rowk(Ks, PT, 16 * st, 32 * ks, lane), frag_rowk(Qs, PT, 16 * lt, 32 * ks, lane), acc);
                const int l = 16 * lt + l15, s0 = 16 * st + 4 * quad; const float rl = rv[l]; float wv[4];
#pragma unroll
                for (int e = 0; e < 4; ++e) wv[e] = (s0 + e <= l) ? acc[e] * __expf(rl + uv[s0 + e]) : 0.f;
                v2u o; o.x = pk2(wv[0], wv[1]); o.y = pk2(wv[2], wv[3]); *(LAS v2u*)(Ws + l * PW + s0) = o;
            }
            __syncthreads();
            f32x4 ai[4][2], ax[4][2], ad[4];
#pragma unroll
            for (int m = 0; m < 4; ++m) { ad[m] = (f32x4){0.f, 0.f, 0.f, 0.f};
#pragma unroll
                for (int n = 0; n < 2; ++n) { ai[m][n] = (f32x4){0.f, 0.f, 0.f, 0.f}; ax[m][n] = (f32x4){0.f, 0.f, 0.f, 0.f}; } }
            { unsigned o1 = 0x3F803F80u; asm volatile("" : "+v"(o1)); const v4u ow = {o1, o1, o1, o1}; const bf16x8 ones = __builtin_bit_cast(bf16x8, ow);
#pragma unroll
              for (int ks = 0; ks < 2; ++ks) { const bf16x8 b0 = frag_tr(Vs, PT, 32 * ks, 32 * w, lane), b1 = frag_tr(Vs, PT, 32 * ks, 32 * w + 16, lane);
#pragma unroll
                  for (int m = 0; m < 4; ++m) { const bf16x8 a = frag_rowk(Ws, PW, 16 * m, 32 * ks, lane); ai[m][0] = MMA16(a, b0, ai[m][0]); ai[m][1] = MMA16(a, b1, ai[m][1]); ad[m] = MMA16(a, ones, ad[m]); } } }
            {
#pragma unroll
              for (int ks = 0; ks < 8; ++ks) { const bf16x8 b0 = cfr[ks][0], b1 = cfr[ks][1];
#pragma unroll
                  for (int m = 0; m < 4; ++m) { const bf16x8 a = frag_rowk(Qs, PT, 16 * m, 32 * ks, lane); ax[m][0] = MMA16(a, b0, ax[m][0]); ax[m][1] = MMA16(a, b1, ax[m][1]); } } }
            v4u gcc[4], gop[4];
            { const int l = tid >> 3, v0 = (tid & 7) * 32; const size_t tk = (size_t)(t0 + l); const int col0 = hh * 256 + v0;
#pragma unroll
              for (int q = 0; q < 4; ++q) { gcc[q] = *(const v4u*)(cbuf + tk * 1024 + col0 + 8 * q); gop[q] = *(const v4u*)(P + tk * AB_N + 2048 + col0 + 8 * q); } }
            float hv[4][2][4];
#pragma unroll
            for (int m = 0; m < 4; ++m)
#pragma unroll
                for (int e = 0; e < 4; ++e) { const int l = 16 * m + 4 * quad + e; const float wi = wl[l], den = fmaxf(fabsf(ad[m][e] + wi * qnv[l]), emt[l]), inv = __builtin_amdgcn_rcpf(den);
                    hv[m][0][e] = (ai[m][0][e] + wi * ax[m][0][e]) * inv; hv[m][1][e] = (ai[m][1][e] + wi * ax[m][1][e]) * inv;
                    const float ss = row16_sum(hv[m][0][e] * hv[m][0][e] + hv[m][1][e] * hv[m][1][e]);
                    if (l15 == 0) part[w * 64 + l] = ss; }
            __syncthreads();
            if (tid < 64) { float t = 0.f;
#pragma unroll
                for (int ww = 0; ww < 8; ++ww) t += part[ww * 64 + tid];
                rstd[tid] = 1.0f / sqrtf(t * (1.0f / 256.0f) + NORM_EPS); }
            __syncthreads();
            { constexpr int PH = 264; LAS float* hs = (LAS float*)lds;
#pragma unroll
              for (int m = 0; m < 4; ++m)
#pragma unroll
                  for (int e = 0; e < 4; ++e) { const int l = 16 * m + 4 * quad + e; const float rs = rstd[l];
                      hs[l * PH + 32 * w + l15] = hv[m][0][e] * rs; hs[l * PH + 32 * w + 16 + l15] = hv[m][1][e] * rs; }
              __syncthreads();
              const int l = tid >> 3, v0 = (tid & 7) * 32; const size_t tk = (size_t)(t0 + l); const int col0 = hh * 256 + v0;
#pragma unroll
              for (int q = 0; q < 4; ++q) { float cc[8], op[8]; unpack8(gcc[q], cc); unpack8(gop[q], op);
                  const f32x4 h0 = *(const LAS f32x4*)(hs + l * PH + v0 + 8 * q), h1 = *(const LAS f32x4*)(hs + l * PH + v0 + 8 * q + 4);
                  const f32x4 n0 = *(const f32x4*)(ml_norm + col0 + 8 * q), n1 = *(const f32x4*)(ml_norm + col0 + 8 * q + 4), k0 = *(const f32x4*)(ml_skip + col0 + 8 * q), k1 = *(const f32x4*)(ml_skip + col0 + 8 * q + 4);
                  float r[8];
#pragma unroll
                  for (int e = 0; e < 4; ++e) { r[e] = sigmoidf_(op[e]) * (h0[e] * n0[e] + k0[e] * cc[e]); r[4 + e] = sigmoidf_(op[4 + e]) * (h1[e] * n1[e] + k1[e] * cc[4 + e]); }
                  v4u o; o.x = pk2(r[0], r[1]); o.y = pk2(r[2], r[3]); o.z = pk2(r[4], r[5]); o.w = pk2(r[6], r[7]); *(v4u*)(Y + tk * 2048 + col0 + 8 * q) = o; } }
            __syncthreads(); }
        } else { for (int rep_ = 0; rep_ < 1 + CK_DUP_HG3; ++rep_) {
            const int uu = u - NU_ML, bh = uu / NCH, j = uu - bh * NCH, b = bh >> 3, hh = bh & 7, t0 = b * SEQ + j * CL;
            constexpr int PT = 136, PA = 72;
            constexpr int BP = 65;
            LAS float* bT = (LAS float*)lds;
            constexpr int QP = 129;
            LAS float* qf = bT + 128 * BP;
            LAS bf16_t* kT = (LAS bf16_t*)(qf + 64 * QP);
            LAS bf16_t* qh = kT + 128 * 64;
            LAS bf16_t* Vt = qh + 64 * PT;
            LAS bf16_t* At = Vt + 64 * PT;
            LAS float* part = (LAS float*)(At + 64 * PA);
            LAS float* rstd = part + 512;
            bf16x8 sfr[4];
            { const bf16_t* Sj = SST + (size_t)uu * 16384;
#pragma unroll
              for (int ks = 0; ks < 4; ++ks) sfr[ks] = frag_rowk_g(Sj, 128, 16 * w, 32 * ks, lane); }
            { const int s = tid >> 3, c0 = (tid & 7) * 16; const bf16_t* pp = P + (size_t)(t0 + s) * AB_N + hh * 128 + c0;
#pragma unroll
              for (int q = 0; q < 2; ++q) { float hq[8], hf[8]; unpack8(*(const v4u*)(pp + 3072 + 8 * q), hq); unpack8(*(const v4u*)(pp + 4096 + 8 * q), hf);
                  *(LAS v4u*)(Vt + s * PT + c0 + 8 * q) = *(const v4u*)(pp + 5120 + 8 * q);
                  if (q == 0) { unsigned z0 = 0u; asm volatile("" : "+v"(z0)); *(LAS v4u*)(At + s * PA + (tid & 7) * 8) = (v4u){z0, z0, z0, z0}; }
#pragma unroll
                  for (int e = 0; e < 8; ++e) { const int c = c0 + 8 * q + e, cg = hh * 128 + c;
                      const float oml = jpair == 0 ? 1.0f : 1.0f - sigmoidf_(lb_logits[1024 + cg] - lb_logits[cg]);
                      float k2, lf; hg_gate(hf[e], oml, k2, lf);
                      bT[c * BP + s] = lf * 1.4426950408889634f; kT[c * 64 + s] = (bf16_t)f2bf(k2);        qf[s * QP + c] = hq[e] * __builtin_amdgcn_rcpf(1.0f + __expf(-hq[e])); } } }
            __syncthreads();
            { const int c = tid & 127, p = tid >> 7; LAS float* tot = part;
              float acc = 0.f;
#pragma unroll
              for (int s = 0; s < 16; ++s) { acc += bT[c * BP + 16 * p + s]; bT[c * BP + 16 * p + s] = acc; }
              tot[p * 128 + c] = acc;
              __syncthreads();
              float off = 0.f;
#pragma unroll
              for (int pp = 0; pp < 3; ++pp) off += pp < p ? tot[pp * 128 + c] : 0.f;
              if (p > 0) {
#pragma unroll
                  for (int s = 0; s < 16; ++s) bT[c * BP + 16 * p + s] += off; } }
            __syncthreads();
            { const int l = tid >> 3, c0 = (tid & 7) * 16;
              float dg = 0.f;
#pragma unroll
              for (int q = 0; q < 2; ++q) { float r[8];
#pragma unroll
                  for (int e = 0; e < 8; ++e) { const int c = c0 + 8 * q + e; const float qv = qf[l * QP + c]; r[e] = qv * __builtin_amdgcn_exp2f(bT[c * BP + l]); dg += qv * bf2f(kT[c * 64 + l]); }
                  v4u o; o.x = pk2(r[0], r[1]); o.y = pk2(r[2], r[3]); o.z = pk2(r[4], r[5]); o.w = pk2(r[6], r[7]); *(LAS v4u*)(qh + l * PT + c0 + 8 * q) = o; }
              dg += DPP_F(dg, 0xB1); dg += DPP_F(dg, 0x4E); dg += DPP_F(dg, 0x141);
              if ((tid & 7) == 0) At[l * PA + l] = (bf16_t)f2bf(dg); }
            if (tid < 480) { const int I = tid / 120, p = tid - I * 120; int lr = (int)((1.0f + sqrtf(1.0f + 8.0f * (float)p)) * 0.5f);
              lr = (lr * (lr - 1)) / 2 > p ? lr - 1 : lr; lr = ((lr + 1) * lr) / 2 <= p ? lr + 1 : lr;
              const int lA = 16 * I + lr, sA = 16 * I + (p - (lr * (lr - 1)) / 2); float a0 = 0.f;
#pragma unroll 4
              for (int c = 0; c < 128; ++c) a0 += qf[lA * QP + c] * bf2f(kT[c * 64 + sA]) * __builtin_amdgcn_exp2f(bT[c * BP + lA] - bT[c * BP + sA]);
              At[lA * PA + sA] = (bf16_t)f2bf(a0); }
            if (w < 6) { const int I = w < 3 ? w + 1 : (w < 5 ? w - 1 : 3), J = w < 3 ? 0 : (w < 5 ? 1 : 2);
                const int sA = 16 * J + l15, lB = 16 * I + l15, eJ = 16 * J + 15;
                f32x4 acc = (f32x4){0.f, 0.f, 0.f, 0.f};
#pragma unroll
                for (int ks = 0; ks < 4; ++ks) { float fa[8], fb[8];
#pragma unroll
                    for (int e = 0; e < 8; ++e) { const int c = 32 * ks + 8 * quad + e; const float Bc = bT[c * BP + eJ];
                        fa[e] = bf2f(kT[c * 64 + sA]) * __builtin_amdgcn_exp2f(Bc - bT[c * BP + sA]); fb[e] = qf[lB * QP + c] * __builtin_amdgcn_exp2f(bT[c * BP + lB] - Bc); }
                    v4u ua, ub; ua.x = pk2(fa[0], fa[1]); ua.y = pk2(fa[2], fa[3]); ua.z = pk2(fa[4], fa[5]); ua.w = pk2(fa[6], fa[7]); ub.x = pk2(fb[0], fb[1]); ub.y = pk2(fb[2], fb[3]); ub.z = pk2(fb[4], fb[5]); ub.w = pk2(fb[6], fb[7]);
                    acc = MMA16(__builtin_bit_cast(bf16x8, ua), __builtin_bit_cast(bf16x8, ub), acc); }
                v2u o; o.x = pk2(acc[0], acc[1]); o.y = pk2(acc[2], acc[3]); *(LAS v2u*)(At + lB * PA + 16 * J + 4 * quad) = o; }
            __syncthreads();
            f32x4 ao[4];
#pragma unroll
            for (int m = 0; m < 4; ++m) ao[m] = (f32x4){0.f, 0.f, 0.f, 0.f};
#pragma unroll
            for (int ks = 0; ks < 2; ++ks) { const bf16x8 bb = frag_tr(Vt, PT, 32 * ks, 16 * w, lane);
#pragma unroll
                for (int m = 0; m < 4; ++m) ao[m] = MMA16(frag_rowk(At, PA, 16 * m, 32 * ks, lane), bb, ao[m]); }
            {
#pragma unroll
              for (int ks = 0; ks < 4; ++ks) { const bf16x8 bb = sfr[ks];
#pragma unroll
                  for (int m = 0; m < 4; ++m) ao[m] = MMA16(frag_rowk(qh, PT, 16 * m, 32 * ks, lane), bb, ao[m]); } }
            v4u ggr[2];
            { const int l = tid >> 3, v0 = (tid & 7) * 16; const size_t tk = (size_t)(t0 + l); const int col0 = hh * 128 + v0;
#pragma unroll
              for (int q = 0; q < 2; ++q) ggr[q] = *(const v4u*)(P + tk * AB_N + 6144 + col0 + 8 * q); }
#pragma unroll
            for (int m = 0; m < 4; ++m)
#pragma unroll
                for (int e = 0; e < 4; ++e) { const int l = 16 * m + 4 * quad + e; const float ss = row16_sum(ao[m][e] * ao[m][e]); if (l15 == 0) part[w * 64 + l] = ss; }
            __syncthreads();
            if (tid < 64) { float t = 0.f;
#pragma unroll
                for (int ww = 0; ww < 8; ++ww) t += part[ww * 64 + tid];
                rstd[tid] = 1.0f / sqrtf(t * (1.0f / 128.0f) + NORM_EPS); }
            __syncthreads();
            { constexpr int PH = 132; LAS float* hs = (LAS float*)lds;
#pragma unroll
              for (int m = 0; m < 4; ++m)
#pragma unroll
                  for (int e = 0; e < 4; ++e) { const int l = 16 * m + 4 * quad + e; hs[l * PH + 16 * w + l15] = ao[m][e] * rstd[l]; }
              __syncthreads();
              const int l = tid >> 3, v0 = (tid & 7) * 16; const size_t tk = (size_t)(t0 + l); const int col0 = hh * 128 + v0;
#pragma unroll
              for (int q = 0; q < 2; ++q) { float gg[8]; unpack8(ggr[q], gg);
                  const f32x4 h0 = *(const LAS f32x4*)(hs + l * PH + v0 + 8 * q), h1 = *(const LAS f32x4*)(hs + l * PH + v0 + 8 * q + 4);
                  const f32x4 n0 = *(const f32x4*)(hg_norm + col0 + 8 * q), n1 = *(const f32x4*)(hg_norm + col0 + 8 * q + 4);
                  float r[8];
#pragma unroll
                  for (int e = 0; e < 4; ++e) { r[e] = h0[e] * n0[e] * siluf_(gg[e]); r[4 + e] = h1[e] * n1[e] * siluf_(gg[4 + e]); }
                  v4u o; o.x = pk2(r[0], r[1]); o.y = pk2(r[2], r[3]); o.z = pk2(r[4], r[5]); o.w = pk2(r[6], r[7]); *(v4u*)(Y + tk * 2048 + 1024 + col0 + 8 * q) = o; } }
            __syncthreads(); }
        }
    }
}


__device__ __forceinline__ void ph_qknorm_rope(Frame& F, bf16_t* slots, const float* q_norm, const float* k_norm, const float* rope) {
    const int sub = F.lane & 15, rsel = F.lane >> 4;
    const int skip = F.G == 256 ? 32 : 0;
    if (F.bx < skip) return;
    const int gw = (F.bx - skip) * 8 + F.wave, ngw = (F.G - skip) * 8;
    constexpr int NIT = 24 * T / 4;
    for (int it0 = gw; it0 < NIT; it0 += 4 * ngw) {
        v4u xin[4]; f32x4 cs[4][4];
#pragma unroll
        for (int u = 0; u < 4; ++u) { const int it = it0 + u * ngw;
            if (it < NIT) { const int rowi = it * 4 + rsel, sl = rowi / T, m = rowi - sl * T, pos = m & (SEQ - 1);
                const int slot = sl < 16 ? sl : (sl < 20 ? 24 + (sl - 16) : 32 + (sl - 20));
                xin[u] = *(const v4u*)(slots + ((size_t)slot * T + m) * 128 + 8 * sub);
                const f32x4* cp = (const f32x4*)(rope + ((size_t)pos * 64 + 8 * (sub & 7)) * 2);
#pragma unroll
                for (int q = 0; q < 4; ++q) cs[u][q] = cp[q]; } }
#pragma unroll
        for (int u = 0; u < 4; ++u) { const int it = it0 + u * ngw;
            if (it < NIT) { const int rowi = it * 4 + rsel, sl = rowi / T, m = rowi - sl * T;
                const int slot = sl < 16 ? sl : (sl < 20 ? 24 + (sl - 16) : 32 + (sl - 20));
                const float* w = (sl < 16 ? q_norm : (sl < 20 ? k_norm + 128 : k_norm + 256)) + 8 * sub;
                bf16_t* p = slots + ((size_t)slot * T + m) * 128 + 8 * sub;
                float x[8]; unpack8(xin[u], x);
                float ss = 0.f;
#pragma unroll
                for (int e = 0; e < 8; ++e) ss += x[e] * x[e];
                const float rstd = __builtin_amdgcn_rsqf(row16_sum(ss) * (1.0f / 128.0f) + NORM_EPS);
                const f32x4 w0 = *(const f32x4*)w, w1 = *(const f32x4*)(w + 4);
                float a[8], bpart[8];
#pragma unroll
                for (int e = 0; e < 8; ++e) { a[e] = x[e] * rstd * (e < 4 ? w0[e] : w1[e - 4]); bpart[e] = DPP_F(a[e], 0x128); }
                const float sgn = sub < 8 ? -1.0f : 1.0f;
                float y[8];
#pragma unroll
                for (int q = 0; q < 4; ++q) { const f32x4 c2 = cs[u][q]; y[2 * q] = a[2 * q] * c2.x + sgn * bpart[2 * q] * c2.y; y[2 * q + 1] = a[2 * q + 1] * c2.z + sgn * bpart[2 * q + 1] * c2.w; }
                v4u o; o.x = pk2(y[0], y[1]); o.y = pk2(y[2], y[3]); o.z = pk2(y[4], y[5]); o.w = pk2(y[6], y[7]);
                *(v4u*)p = o; } }
    }
}
__device__ __forceinline__ void ph_compress2(Frame& F, const bf16_t* hid, const float* w2  , const float* k_norm0, const float* rope, bf16_t* kcmp, bf16_t* vcmp) {
    for (int g4 = F.gw; g4 < 2 * 1024; g4 += F.NGW) {
        const int kv = g4 >> 10, r0 = 4 * (g4 & 1023);
        float h[4][4];
#pragma unroll
        for (int i = 0; i < 4; ++i) { const v2u hu = *(const v2u*)(hid + ((size_t)kv * 4096 + r0 + i) * 256 + 4 * F.lane); h[i][0] = bflo(hu.x); h[i][1] = bfhi(hu.x); h[i][2] = bflo(hu.y); h[i][3] = bfhi(hu.y); }
        const float* w = w2 + (size_t)kv * 256 * 128;
        float a0[4] = {0.f, 0.f, 0.f, 0.f}, a1[4] = {0.f, 0.f, 0.f, 0.f};
        for (int c4 = 0; c4 < 64; ++c4) {
            const float* wr = w + (size_t)(4 * c4) * 128 + F.lane;
            const float w00 = wr[0], w01 = wr[128], w02 = wr[256], w03 = wr[384], w10 = wr[64], w11 = wr[192], w12 = wr[320], w13 = wr[448];
#pragma unroll
            for (int i = 0; i < 4; ++i) {
                const float x0 = __builtin_bit_cast(float, __builtin_amdgcn_readlane(__builtin_bit_cast(int, h[i][0]), c4)), x1 = __builtin_bit_cast(float, __builtin_amdgcn_readlane(__builtin_bit_cast(int, h[i][1]), c4));
                const float x2 = __builtin_bit_cast(float, __builtin_amdgcn_readlane(__builtin_bit_cast(int, h[i][2]), c4)), x3 = __builtin_bit_cast(float, __builtin_amdgcn_readlane(__builtin_bit_cast(int, h[i][3]), c4));
                a0[i] += x0 * w00 + x1 * w01 + x2 * w02 + x3 * w03;
                a1[i] += x0 * w10 + x1 * w11 + x2 * w12 + x3 * w13; }
        }
#pragma unroll
        for (int i = 0; i < 4; ++i) { const int r = r0 + i;
            if (kv == 0) {
                const float rstd = 1.0f / sqrtf(wave_sum(a0[i] * a0[i] + a1[i] * a1[i]) * (1.0f / 128.0f) + NORM_EPS);
                const float a = a0[i] * rstd * k_norm0[F.lane], b = a1[i] * rstd * k_norm0[64 + F.lane];
                const int pos = 16 * (r & 511) + 31;
                const f32x2 cs = *(const f32x2*)(rope + ((size_t)pos * 64 + F.lane) * 2);
                kcmp[(size_t)r * 128 + F.lane] = (bf16_t)f2bf(a * cs.x - b * cs.y); kcmp[(size_t)r * 128 + 64 + F.lane] = (bf16_t)f2bf(b * cs.x + a * cs.y);
            } else { vcmp[(size_t)r * 128 + F.lane] = (bf16_t)f2bf(a0[i]); vcmp[(size_t)r * 128 + 64 + F.lane] = (bf16_t)f2bf(a1[i]); } }
    }
}

namespace nsa {
typedef short s16x4 __attribute__((ext_vector_type(4)));
typedef float f32x16 __attribute__((ext_vector_type(16)));
#define KSWZ(row, colB) ((row) * 256 + ((colB) ^ (((row) & 7) << 4)))
#define SBAR() __builtin_amdgcn_sched_barrier(0)
constexpr float SCALE = 0.08838834764831845f, CLOG = SCALE * 1.4426950408889634f;
constexpr int SHM_T = 64 * 128 * 2;
constexpr int L_V = 0, L_K = 2 * SHM_T, L_WREG = 4 * SHM_T, WREG = 8192, IMP_LD = 144, L_SELW = 132096, L_SCR = 133120, L_END = L_SCR + 8 * 64 * 4;
static_assert(L_WREG + 8 * WREG <= RING_BYTES && 8 * IMP_LD * 4 <= WREG && L_END <= LDS_BYTES && L_SELW >= MISC_OFF + 128, "attention LDS map");
__device__ __forceinline__ int crow(int r, int hi) { return (r & 3) + 8 * (r >> 2) + 4 * hi; }
__device__ __forceinline__ unsigned cvtpk(float lo, float hi) { unsigned r; asm volatile("v_cvt_pk_bf16_f32 %0, %1, %2" : "=v"(r) : "v"(lo), "v"(hi)); return r; }
__device__ __forceinline__ void qkt(f32x16& p0, f32x16& p1, const LAS char* Ks, const bf16x8* qr, int r32, int hi) {
    p0 = f32x16{}; p1 = f32x16{};
#pragma unroll
    for (int d0 = 0; d0 < 8; ++d0) { const int cb = (d0 * 16 + hi * 8) * 2;
        const bf16x8 b0 = *(const LAS bf16x8*)(Ks + KSWZ(r32, cb)), b1 = *(const LAS bf16x8*)(Ks + KSWZ(32 + r32, cb));
        p0 = __builtin_amdgcn_mfma_f32_32x32x16_bf16(b0, qr[d0], p0, 0, 0, 0);
        p1 = __builtin_amdgcn_mfma_f32_32x32x16_bf16(b1, qr[d0], p1, 0, 0, 0); }
}
__device__ __forceinline__ int v_st(int k, int c) { const int kk = (k & ~0xC) | ((k & 4) << 1) | ((k & 8) >> 1); return ((kk >> 3) * 4 + (c >> 5)) * 512 + ((kk & 7) * 32 + (c & 31)) * 2; }
__device__ __forceinline__ int v_rd_base(int lane) { return ((lane & 3) << 3) | (((lane >> 2) & 3) << 6) | (((lane >> 4) & 1) << 5) | (((lane >> 5) & 1) << 8); }
constexpr int v_rd_off(int d0, int ks, int half) { return d0 * 512 + ks * 4096 + half * 2048; }
template <int OFF> __device__ __forceinline__ s16x4 tr_read(int vb) { s16x4 r; asm volatile("ds_read_b64_tr_b16 %0, %1 offset:%2" : "=&v"(r) : "v"(vb), "i"(OFF) : "memory"); return r; }
template <int D0> __device__ __forceinline__ void pv_one(f32x16& od, int vb, bf16x8 pa0, bf16x8 pa1, bf16x8 pa2, bf16x8 pa3) {
    const s16x4 l0 = tr_read<v_rd_off(D0, 0, 0)>(vb), h0 = tr_read<v_rd_off(D0, 0, 1)>(vb), l1 = tr_read<v_rd_off(D0, 1, 0)>(vb), h1 = tr_read<v_rd_off(D0, 1, 1)>(vb);
    const s16x4 l2 = tr_read<v_rd_off(D0, 2, 0)>(vb), h2 = tr_read<v_rd_off(D0, 2, 1)>(vb), l3 = tr_read<v_rd_off(D0, 3, 0)>(vb), h3 = tr_read<v_rd_off(D0, 3, 1)>(vb);
    asm volatile("s_waitcnt lgkmcnt(0)" ::: "memory"); SBAR();
#define PK(L, H) (bf16x8){L[0], L[1], L[2], L[3], H[0], H[1], H[2], H[3]}
    od = __builtin_amdgcn_mfma_f32_32x32x16_bf16(pa0, PK(l0, h0), od, 0, 0, 0);
    od = __builtin_amdgcn_mfma_f32_32x32x16_bf16(pa1, PK(l1, h1), od, 0, 0, 0);
    od = __builtin_amdgcn_mfma_f32_32x32x16_bf16(pa2, PK(l2, h2), od, 0, 0, 0);
    od = __builtin_amdgcn_mfma_f32_32x32x16_bf16(pa3, PK(l3, h3), od, 0, 0, 0);
#undef PK
}
__device__ __forceinline__ void pack_p(const f32x16& p0, const f32x16& p1, bf16x8& pa0, bf16x8& pa1, bf16x8& pa2, bf16x8& pa3) {
#define PK4(P, BASE, OUT) do { const unsigned a0 = cvtpk(P[BASE + 0], P[BASE + 1]), a1 = cvtpk(P[BASE + 2], P[BASE + 3]), b0 = cvtpk(P[BASE + 4], P[BASE + 5]), b1 = cvtpk(P[BASE + 6], P[BASE + 7]); \
    auto r0 = __builtin_amdgcn_permlane32_swap(a0, b0, false, false); auto r1 = __builtin_amdgcn_permlane32_swap(a1, b1, false, false); \
    v4u w = {r0[0], r1[0], r0[1], r1[1]}; OUT = __builtin_bit_cast(bf16x8, w); } while (0)
    PK4(p0, 0, pa0); PK4(p0, 8, pa1); PK4(p1, 0, pa2); PK4(p1, 8, pa3);
#undef PK4
}
__device__ __forceinline__ void qk_half(f32x16& p, const LAS char* Ks, const bf16x8* qr, int row, int hi) {
#pragma unroll
    for (int d0 = 0; d0 < 8; ++d0) { const int cb = (d0 * 16 + hi * 8) * 2; const bf16x8 b = *(const LAS bf16x8*)(Ks + KSWZ(row, cb)); p = __builtin_amdgcn_mfma_f32_32x32x16_bf16(b, qr[d0], p, 0, 0, 0); }
}
template <bool RANGE>
__device__ __forceinline__ float exp_half(f32x16& p, float bias, int klo, int khi, int hi, int koff) {
    float ps = 0.f;
#pragma unroll
    for (int r = 0; r < 16; ++r) { const int k = koff + crow(r, hi); float x = fmaf(p[r], CLOG, bias);
        if (RANGE) x = (k >= klo && k <= khi) ? x : -INFINITY;
        p[r] = __builtin_amdgcn_exp2f(x); ps += p[r]; }
    return ps;
}
__device__ __forceinline__ void pack_half(const f32x16& p, bf16x8& pa, bf16x8& pb) {
#define PK4(P, BASE, OUT) do { const unsigned a0 = cvtpk(P[BASE + 0], P[BASE + 1]), a1 = cvtpk(P[BASE + 2], P[BASE + 3]), b0 = cvtpk(P[BASE + 4], P[BASE + 5]), b1 = cvtpk(P[BASE + 6], P[BASE + 7]); \
    auto r0 = __builtin_amdgcn_permlane32_swap(a0, b0, false, false); auto r1 = __builtin_amdgcn_permlane32_swap(a1, b1, false, false); \
    v4u w = {r0[0], r1[0], r0[1], r1[1]}; OUT = __builtin_bit_cast(bf16x8, w); } while (0)
    PK4(p, 0, pa); PK4(p, 8, pb);
#undef PK4
}
template <int KH>
__device__ __forceinline__ void pv_half(f32x16 (&o)[4], int vb, bf16x8 pa, bf16x8 pb) {
    s16x4 l00 = tr_read<v_rd_off(0, 2 * KH, 0)>(vb), h00 = tr_read<v_rd_off(0, 2 * KH, 1)>(vb), l01 = tr_read<v_rd_off(0, 2 * KH + 1, 0)>(vb), h01 = tr_read<v_rd_off(0, 2 * KH + 1, 1)>(vb);
    const s16x4 l10 = tr_read<v_rd_off(1, 2 * KH, 0)>(vb), h10 = tr_read<v_rd_off(1, 2 * KH, 1)>(vb), l11 = tr_read<v_rd_off(1, 2 * KH + 1, 0)>(vb), h11 = tr_read<v_rd_off(1, 2 * KH + 1, 1)>(vb);
    const s16x4 l20 = tr_read<v_rd_off(2, 2 * KH, 0)>(vb), h20 = tr_read<v_rd_off(2, 2 * KH, 1)>(vb), l21 = tr_read<v_rd_off(2, 2 * KH + 1, 0)>(vb), h21 = tr_read<v_rd_off(2, 2 * KH + 1, 1)>(vb);
    const s16x4 l30 = tr_read<v_rd_off(3, 2 * KH, 0)>(vb), h30 = tr_read<v_rd_off(3, 2 * KH, 1)>(vb), l31 = tr_read<v_rd_off(3, 2 * KH + 1, 0)>(vb), h31 = tr_read<v_rd_off(3, 2 * KH + 1, 1)>(vb);
    asm volatile("s_waitcnt lgkmcnt(0)" ::: "memory"); SBAR();
#define PK(L, H) (bf16x8){L[0], L[1], L[2], L[3], H[0], H[1], H[2], H[3]}
    o[0] = __builtin_amdgcn_mfma_f32_32x32x16_bf16(pa, PK(l00, h00), o[0], 0, 0, 0); o[1] = __builtin_amdgcn_mfma_f32_32x32x16_bf16(pa, PK(l10, h10), o[1], 0, 0, 0);
    o[2] = __builtin_amdgcn_mfma_f32_32x32x16_bf16(pa, PK(l20, h20), o[2], 0, 0, 0); o[3] = __builtin_amdgcn_mfma_f32_32x32x16_bf16(pa, PK(l30, h30), o[3], 0, 0, 0);
    o[0] = __builtin_amdgcn_mfma_f32_32x32x16_bf16(pb, PK(l01, h01), o[0], 0, 0, 0); o[1] = __builtin_amdgcn_mfma_f32_32x32x16_bf16(pb, PK(l11, h11), o[1], 0, 0, 0);
    o[2] = __builtin_amdgcn_mfma_f32_32x32x16_bf16(pb, PK(l21, h21), o[2], 0, 0, 0); o[3] = __builtin_amdgcn_mfma_f32_32x32x16_bf16(pb, PK(l31, h31), o[3], 0, 0, 0);
#undef PK
}
template <bool RANGE>
__device__ __forceinline__ float exp_tile(f32x16& p0, f32x16& p1, float bias, int klo, int khi, int hi) {
    float ps = 0.f;
#pragma unroll
    for (int r = 0; r < 16; ++r) { const int k0 = crow(r, hi), k1 = 32 + k0;
        float x0 = fmaf(p0[r], CLOG, bias), x1 = fmaf(p1[r], CLOG, bias);
        if (RANGE) { x0 = (k0 >= klo && k0 <= khi) ? x0 : -INFINITY; x1 = (k1 >= klo && k1 <= khi) ? x1 : -INFINITY; }
        p0[r] = __builtin_amdgcn_exp2f(x0); p1[r] = __builtin_amdgcn_exp2f(x1); ps += p0[r] + p1[r]; }
    return ps;
}
struct Stg { bf16x8 k0, k1, v0, v1; };
__device__ __forceinline__ void tile_load(Stg& s, const bf16_t* Kg, const bf16_t* Vg, unsigned loff) {
    const char* kb = (const char*)Kg; const char* vb = (const char*)Vg;
    s.k0 = *(const bf16x8*)(kb + loff); s.k1 = *(const bf16x8*)(kb + loff + 8192u);
    s.v0 = *(const bf16x8*)(vb + loff); s.v1 = *(const bf16x8*)(vb + loff + 8192u);
}
__device__ __forceinline__ void tile_write(const Stg& s, LAS char* lds, int buf, int sr, int sc, int vst0, int vst1) {
    *(LAS bf16x8*)(lds + L_V + buf * SHM_T + vst0) = s.v0; *(LAS bf16x8*)(lds + L_V + buf * SHM_T + vst1) = s.v1;
    *(LAS bf16x8*)(lds + L_K + buf * SHM_T + KSWZ(sr, sc * 2)) = s.k0; *(LAS bf16x8*)(lds + L_K + buf * SHM_T + KSWZ(32 + sr, sc * 2)) = s.k1;
}
__device__ __forceinline__ void tile_dma(const bf16_t* Kg, const bf16_t* Vg, LAS char* lds, int buf, int w, unsigned dk0, unsigned dv0, unsigned dv1) {
    LAS char* kd = lds + L_K + buf * SHM_T + w * 1024; LAS char* vd = lds + L_V + buf * SHM_T + w * 1024;
    __builtin_amdgcn_global_load_lds((const unsigned*)((const char*)Kg + dk0), (LAS unsigned*)kd, 16, 0, 0);
    __builtin_amdgcn_global_load_lds((const unsigned*)((const char*)Kg + dk0 + 8192u), (LAS unsigned*)(kd + 8192), 16, 0, 0);
    __builtin_amdgcn_global_load_lds((const unsigned*)((const char*)Vg + dv0), (LAS unsigned*)vd, 16, 0, 0);
    __builtin_amdgcn_global_load_lds((const unsigned*)((const char*)Vg + dv1), (LAS unsigned*)(vd + 8192), 16, 0, 0);
}
__device__ __forceinline__ unsigned grp8_max(unsigned v) {
    v = max(v, (unsigned)__builtin_amdgcn_mov_dpp((int)v, 0xB1, 0xf, 0xf, true));
    v = max(v, (unsigned)__builtin_amdgcn_mov_dpp((int)v, 0x4E, 0xf, 0xf, true));
    v = max(v, (unsigned)__builtin_amdgcn_mov_dpp((int)v, 0x141, 0xf, 0xf, true));
    return v;
}
enum { BR_CMP1 = 0, BR_CMP2 = 1, BR_SEL = 2, BR_WIN = 3 };
}


struct NsaLane { int lane, w, r32, hi, tl, vb0; unsigned dk0, dv0, dv1; };
__device__ __forceinline__ NsaLane nsa_lane(int tid_in, LAS char* lds) {
    using namespace nsa;
    int tid = tid_in; asm volatile("" : "+v"(tid));
    NsaLane L; L.lane = tid & 63; L.w = __builtin_amdgcn_readfirstlane(tid >> 6); L.r32 = L.lane & 31; L.hi = L.lane >> 5; L.tl = 8 * L.w + (L.r32 >> 2);
    { const int r = L.w * 4 + (L.lane >> 4), x = L.lane & 15; L.dk0 = (unsigned)(r * 256 + ((x ^ (r & 7)) << 4));
#pragma unroll
      for (int i = 0; i < 2; ++i) { const int P = i * 512 + L.w * 64 + L.lane, blk = P >> 5, kk = (blk >> 2) * 8 + ((P & 31) >> 2), c = (blk & 3) * 32 + (P & 3) * 8;
          const int k = (kk & ~0xC) | ((kk & 4) << 1) | ((kk & 8) >> 1); const unsigned d = (unsigned)(k * 256 + c * 2); if (i == 0) L.dv0 = d; else L.dv1 = d; } }
    L.vb0 = (int)(uintptr_t)(lds + L_V) + v_rd_base(L.lane);
    return L;
}
__device__ __forceinline__ float nsa_load_q(bf16x8 (&qr)[8], const bf16_t* slots, int g, size_t mrow, int r32, int hi, LAS float* scr, int lane) {
    const bf16_t* qp = slots + ((size_t)(g * 4 + (r32 & 3)) * T + mrow) * 128 + hi * 8;
#pragma unroll
    for (int d0 = 0; d0 < 8; ++d0) qr[d0] = *(const bf16x8*)(qp + d0 * 16);
    float ss = 0.f;
#pragma unroll
    for (int d0 = 0; d0 < 8; ++d0) {
#pragma unroll
        for (int e = 0; e < 8; ++e) { const float x = bf2f((unsigned short)qr[d0][e]); ss += x * x; } }
    ss = half_swap_sum(ss, scr, lane);
    return sqrtf(ss) * nsa::CLOG;
}
__device__ __forceinline__ float nsa_kbound(const float* k_norm_br, int lane) {
    const float a = fmaxf(fabsf(k_norm_br[lane]), fabsf(k_norm_br[64 + lane]));
    return __builtin_bit_cast(float, __builtin_amdgcn_readfirstlane(__builtin_bit_cast(int, wave_max(a)))) * 11.54f;
}

__device__ __forceinline__ void ph_attn_mfma(Frame& F, const bf16_t* slots, const float* gp, const float* gbias, const float* k_norm, const bf16_t* kcmp, const bf16_t* vcmp, bf16_t* O) {
    using namespace nsa;
    LAS char* lds = (LAS char*)F.lds;
    const int vcu = (F.G % 8 == 0) ? (F.bx % 8) * (F.G / 8) + F.bx / 8 : F.bx;
    const int NU = BATCH * 4 * (SEQ / 64);
    for (int ui = 0; ui < (NU + F.G - 1) / F.G; ++ui) {
        if (ui * F.G + vcu >= NU) break;
        int bg, qb;
        if (F.G == 256) { const int v = vcu & 31; bg = vcu >> 5; qb = ui == 0 ? v : ui == 1 ? 63 - v : ui == 2 ? 64 + v : 127 - v; }
        else { const int u = ui * F.G + vcu; bg = u >> 7; qb = u & 127; }
        const int b = bg >> 2, g = bg & 3, q0 = qb * 64;

#define TILE_LOOP(BR, Kg, Vg, kt0, kt1) do { \
        int buf = 0; \
        __syncthreads(); \
        tile_dma((Kg) + (size_t)(kt0) * 64 * 128, (Vg) + (size_t)(kt0) * 64 * 128, lds, 0, L.w, L.dk0, L.dv0, L.dv1); \
        asm volatile("s_waitcnt vmcnt(0)" ::: "memory"); __syncthreads(); \
        for (int kt = (kt0); kt <= (kt1); ++kt) { \
            if (kt < (kt1)) tile_dma((Kg) + (size_t)(kt + 1) * 64 * 128, (Vg) + (size_t)(kt + 1) * 64 * 128, lds, buf ^ 1, L.w, L.dk0, L.dv0, L.dv1);        \
            float bias = -qn * kb; int klo = 0, khi = 63; bool rng = false, wave_on = true; \
            if (BR == BR_CMP1 || BR == BR_CMP2) { khi = nmax_t - 64 * kt; rng = (64 * kt + 63 > 4 * qb - 2); } \
            else if (BR == BR_SEL) { const unsigned wsel = selw[(L.r32 >> 2) * 4 + (kt >> 5)]; const bool on = ((wsel >> (kt & 31)) & 1u) != 0u; bias = on ? bias : -INFINITY; if (kt == qb) { khi = L.tl; rng = true; } \
                wave_on = __builtin_amdgcn_ballot_w64(on) != 0ull; }        \
            else { if (kt == qb) { khi = L.tl; rng = true; } else if (kt == qb - 8) { klo = L.tl + 1; rng = true; } } \
            { \
            const LAS char* Kt_ = lds + L_K + buf * SHM_T; const int vb = L.vb0 + buf * SHM_T; \
            f32x16 p0 = f32x16{}, p1 = f32x16{}; \
            qk_half(p0, Kt_, qr, L.r32, L.hi); qk_half(p1, Kt_, qr, 32 + L.r32, L.hi); \
            float ps = rng ? exp_half<true>(p0, bias, klo, khi, L.hi, 0) : exp_half<false>(p0, bias, klo, khi, L.hi, 0); \
            if (BR == BR_CMP1) { ps += rng ? exp_half<true>(p1, bias, klo, khi, L.hi, 32) : exp_half<false>(p1, bias, klo, khi, L.hi, 32); lsum += ps; } \
            else { \
                bf16x8 pa0, pa1, pa2, pa3; \
                if (BR == BR_CMP2) { _Pragma("unroll") for (int r = 0; r < 16; ++r) p0[r] *= inv_lc; } \
                pack_half(p0, pa0, pa1); \
                if (wave_on) pv_half<0>(o, vb, pa0, pa1); \
                ps += rng ? exp_half<true>(p1, bias, klo, khi, L.hi, 32) : exp_half<false>(p1, bias, klo, khi, L.hi, 32); \
                if (BR == BR_CMP2) { _Pragma("unroll") for (int r = 0; r < 16; ++r) p1[r] *= inv_lc; } else lsum += ps; \
                pack_half(p1, pa2, pa3); \
                if (wave_on) pv_half<1>(o, vb, pa2, pa3); \
                if (BR == BR_CMP2) { \
                      \
                    f32x16 d2 = f32x16{}; \
                    int r32o = L.r32, hio = L.hi; asm volatile("" : "+v"(r32o), "+v"(hio)); \
                    _Pragma("unroll") for (int s = 0; s < 4; ++s) { const int c = r32o - 4 * s; bf16x8 cv; \
                        _Pragma("unroll") for (int jj = 0; jj < 8; ++jj) { const int k = 8 * hio + jj; cv[jj] = (c >= 0 && c <= 4 && k >= 4 * c - 1 && k <= 4 * c + 3) ? (short)0x3F80 : (short)0; } \
                        d2 = __builtin_amdgcn_mfma_f32_32x32x16_bf16(s == 0 ? pa0 : s == 1 ? pa1 : s == 2 ? pa2 : pa3, cv, d2, 0, 0, 0); } \
                    if (L.r32 <= 16) { \
                        _Pragma("unroll") for (int q4 = 0; q4 < 4; ++q4) { const float sum = (d2[4 * q4] + d2[4 * q4 + 1]) + (d2[4 * q4 + 2] + d2[4 * q4 + 3]); \
                            LAS float* ip = imp + (2 * q4 + L.hi) * IMP_LD + 16 * kt + L.r32; *ip = *ip + sum; } } \
                    asm volatile("s_waitcnt lgkmcnt(0)" ::: "memory"); \
                } \
            } \
            } \
            asm volatile("s_waitcnt vmcnt(0)" ::: "memory"); \
            __syncthreads(); buf ^= 1; \
        } } while (0)
#define ROW_FACTORS(f) do { if (L.hi == 0) scr[L.r32] = (f); asm volatile("s_waitcnt lgkmcnt(0)" ::: "memory"); } while (0)

        {
            const NsaLane L = nsa_lane(F.tid, lds);
            LAS float* imp = (LAS float*)(lds + L_WREG + L.w * WREG); LAS bf16_t* park = (LAS bf16_t*)imp; LAS float* scr = (LAS float*)(lds + L_SCR) + L.w * 64; LAS unsigned* selw = nullptr; (void)selw;
            const int t = q0 + L.tl; const size_t mrow = (size_t)b * SEQ + t;
            bf16x8 qr[8]; const float qn = nsa_load_q(qr, slots, g, mrow, L.r32, L.hi, scr, L.lane);
            const float kb = nsa_kbound(k_norm, L.lane);
            for (int i = L.lane; i < 8 * IMP_LD; i += 64) imp[i] = 0.f;
            const bf16_t* Kc = kcmp + (size_t)(g * 1024 + b * 512) * 128; const bf16_t* Vc = vcmp + (size_t)(g * 1024 + b * 512) * 128;
            const int nmax_t = t >= 31 ? (t - 31) >> 4 : -1;
            const int nct = ((4 * qb + 2) >> 6) + 1;
            float lsum = 0.f, inv_lc = 0.f;
            { f32x16 o[4]; (void)o; TILE_LOOP(BR_CMP1, Kc, Vc, 0, nct - 1); }
            lsum = half_swap_sum(lsum, scr, L.lane); inv_lc = lsum > 0.f ? 1.0f / lsum : 0.f;
            f32x16 o[4];
#pragma unroll
            for (int d = 0; d < 4; ++d) o[d] = f32x16{};
            TILE_LOOP(BR_CMP2, Kc, Vc, 0, nct - 1);
            unsigned key[16];
            { const int tok = L.lane >> 3, sub = L.lane & 7;
#pragma unroll
              for (int e4 = 0; e4 < 4; ++e4) { const f32x4 vv = *(const LAS f32x4*)(imp + tok * IMP_LD + 16 * sub + 4 * e4);
#pragma unroll
                  for (int e = 0; e < 4; ++e) { const int s = 16 * sub + 4 * e4 + e; const bool forced = (s == 0) || (s == qb) || (s == qb - 1);
                      const float f = vv[e] + (forced ? 1e4f : 0.f);
                      key[4 * e4 + e] = s <= qb ? ((__builtin_bit_cast(unsigned, f) & 0xFFFFFF80u) | (unsigned)(127 - s)) : 0u; } }
              asm volatile("s_waitcnt lgkmcnt(0)" ::: "memory"); }
            { const int hd = g * 4 + (L.r32 & 3); const float g0 = sigmoidf_(gp[mrow * 48 + hd * 3 + 0] + gbias[hd * 3 + 0]);
              ROW_FACTORS(g0);
#pragma unroll
              for (int r = 0; r < 16; ++r) { const int row = crow(r, L.hi); const float fr = scr[row];
#pragma unroll
                  for (int h2 = 0; h2 < 2; ++h2) ((LAS unsigned*)park)[row * 64 + h2 * 32 + L.r32] = pk2(o[2 * h2][r] * fr, o[2 * h2 + 1][r] * fr); }
              asm volatile("s_waitcnt lgkmcnt(0)" ::: "memory"); }
            { LAS unsigned* sw = (LAS unsigned*)(lds + L_SELW) + L.w * 32; const int tok = L.lane >> 3, sub = L.lane & 7;
              unsigned m0 = 0u, m1 = 0u, m2 = 0u, m3 = 0u;
              for (int k = 0; k < 16; ++k) {
                  unsigned mx = key[0];
#pragma unroll
                  for (int e = 1; e < 16; ++e) mx = max(mx, key[e]);
                  mx = grp8_max(mx);
                  if (mx != 0u) { const unsigned s = 127u - (mx & 127u); const unsigned bit = 1u << (s & 31u);
                      m0 |= (s >> 5) == 0u ? bit : 0u; m1 |= (s >> 5) == 1u ? bit : 0u; m2 |= (s >> 5) == 2u ? bit : 0u; m3 |= (s >> 5) == 3u ? bit : 0u; }
#pragma unroll
                  for (int e = 0; e < 16; ++e) key[e] = key[e] == mx ? 0u : key[e];
              }
              if (sub == 0) { sw[tok * 4 + 0] = m0; sw[tok * 4 + 1] = m1; sw[tok * 4 + 2] = m2; sw[tok * 4 + 3] = m3; }
              asm volatile("s_waitcnt lgkmcnt(0)" ::: "memory"); }
        }
        {
            const NsaLane L = nsa_lane(F.tid, lds);
            LAS float* imp = nullptr; (void)imp; LAS bf16_t* park = (LAS bf16_t*)(lds + L_WREG + L.w * WREG); LAS float* scr = (LAS float*)(lds + L_SCR) + L.w * 64; LAS unsigned* selw = (LAS unsigned*)(lds + L_SELW) + L.w * 32;
            const int t = q0 + L.tl; const size_t mrow = (size_t)b * SEQ + t;
            bf16x8 qr[8]; const float qn = nsa_load_q(qr, slots, g, mrow, L.r32, L.hi, scr, L.lane);
            const float kb = nsa_kbound(k_norm + 128, L.lane);
            const bf16_t* Ks = slots + ((size_t)(24 + g) * T + (size_t)b * SEQ) * 128; const bf16_t* Vs = slots + ((size_t)(28 + g) * T + (size_t)b * SEQ) * 128;
            const int nmax_t = 0; (void)nmax_t; float lsum = 0.f; const float inv_lc = 0.f; (void)inv_lc;
            f32x16 o[4];
#pragma unroll
            for (int d = 0; d < 4; ++d) o[d] = f32x16{};
            TILE_LOOP(BR_SEL, Ks, Vs, 0, qb);
            lsum = half_swap_sum(lsum, scr, L.lane);
            { const int hd = g * 4 + (L.r32 & 3); const float g1 = sigmoidf_(gp[mrow * 48 + hd * 3 + 1] + gbias[hd * 3 + 1]);
              ROW_FACTORS(lsum > 0.f ? g1 / lsum : 0.f);
#pragma unroll
              for (int r = 0; r < 16; ++r) { const int row = crow(r, L.hi); const float fr = scr[row];
#pragma unroll
                  for (int h2 = 0; h2 < 2; ++h2) { LAS unsigned* pw = (LAS unsigned*)park + row * 64 + h2 * 32 + L.r32; const unsigned w = *pw; *pw = pk2(bflo(w) + o[2 * h2][r] * fr, bfhi(w) + o[2 * h2 + 1][r] * fr); } }
              asm volatile("s_waitcnt lgkmcnt(0)" ::: "memory"); }
        }
        {
            const NsaLane L = nsa_lane(F.tid, lds);
            LAS float* imp = nullptr; (void)imp; LAS bf16_t* park = (LAS bf16_t*)(lds + L_WREG + L.w * WREG); LAS float* scr = (LAS float*)(lds + L_SCR) + L.w * 64; LAS unsigned* selw = nullptr; (void)selw;
            const int t = q0 + L.tl; const size_t mrow = (size_t)b * SEQ + t;
            bf16x8 qr[8]; const float qn = nsa_load_q(qr, slots, g, mrow, L.r32, L.hi, scr, L.lane);
            const float kb = nsa_kbound(k_norm + 256, L.lane);
            const bf16_t* Kw = slots + ((size_t)(32 + g) * T + (size_t)b * SEQ) * 128; const bf16_t* Vw = slots + ((size_t)(36 + g) * T + (size_t)b * SEQ) * 128;
            const int nmax_t = 0; (void)nmax_t; float lsum = 0.f; const float inv_lc = 0.f; (void)inv_lc;
            f32x16 o[4];
#pragma unroll
            for (int d = 0; d < 4; ++d) o[d] = f32x16{};
            TILE_LOOP(BR_WIN, Kw, Vw, (qb - 8 < 0 ? 0 : qb - 8), qb);
            lsum = half_swap_sum(lsum, scr, L.lane);
            { const int hd = g * 4 + (L.r32 & 3); const float g2 = sigmoidf_(gp[mrow * 48 + hd * 3 + 2] + gbias[hd * 3 + 2]);
              ROW_FACTORS(lsum > 0.f ? g2 / lsum : 0.f);
              char* Ow = (char*)(O + ((size_t)b * SEQ + q0 + 8 * L.w) * 2048 + g * 512);
#pragma unroll
              for (int r = 0; r < 16; ++r) { const int row = crow(r, L.hi); const float fr = scr[row];
#pragma unroll
                  for (int h2 = 0; h2 < 2; ++h2) { const unsigned w = ((LAS unsigned*)park)[row * 64 + h2 * 32 + L.r32];
                      *(bf16_t*)(Ow + (unsigned)(((row >> 2) * 2048 + (row & 3) * 128 + (2 * h2) * 32 + L.r32) * 2)) = (bf16_t)f2bf(bflo(w) + o[2 * h2][r] * fr);
                      *(bf16_t*)(Ow + (unsigned)(((row >> 2) * 2048 + (row & 3) * 128 + (2 * h2 + 1) * 32 + L.r32) * 2)) = (bf16_t)f2bf(bfhi(w) + o[2 * h2 + 1][r] * fr); } }
              asm volatile("s_waitcnt lgkmcnt(0)" ::: "memory"); }
        }
#undef TILE_LOOP
#undef ROW_FACTORS
    }
}

#ifndef MK_MULTI_LAUNCH
#define MK_MULTI_LAUNCH 0
#endif
constexpr int NPS = 8, NSLOTS_PH = 1 + 12 * NPS;
__global__ void __launch_bounds__(NTHREADS, 2) fwd_kernel(Args a) {
    extern __shared__ __attribute__((aligned(16))) unsigned char lds_raw[];
    volatile LAS unsigned* MISC = (volatile LAS unsigned*)((LAS unsigned char*)lds_raw + MISC_OFF);
    if (threadIdx.x < 32) MISC[threadIdx.x] = 0u;
    const int g_wave = __builtin_amdgcn_readfirstlane((int)(threadIdx.x >> 6));
    __syncthreads();
    const int lo = a.ph_lo, hi = a.ph_hi;
    const bool use_bar = (hi - lo) > 1;
    XcdBarrier bar; bar.bar = (unsigned*)(a.ws + WS_CTL) + CW_BAR; bar.x = 0; bar.st = MISC + 8; bar.wv = g_wave;
    if (use_bar) bar = xcd_barrier_post((unsigned*)(a.ws + WS_CTL) + CW_BAR, MISC + 8, g_wave);
#define IN(k) (lo <= (k) && (k) < hi)
#define SEAM(k) do { if (IN((k) + 1) && use_bar) xcd_barrier(bar); } while (0)
#define PH_ENTER() Frame F = make_frame(lds_raw, g_wave); CArgsP ap = get_args(); unsigned char* ws = ap->ws; float* h = ap->out; bf16_t* HN = (bf16_t*)(ws + WS_HN); bf16_t* ACT = (bf16_t*)(ws + WS_ACT); float* SSQ = (float*)(ws + WS_SSQP); LAS float* RED = (LAS float*)(F.lds + RED_OFF); (void)h; (void)HN; (void)ACT; LAS float* RSL = RED + 3072; (void)SSQ; (void)RED; (void)RSL

    if (IN(0)) { PH_ENTER(); ph_prologue(F, ap); }
    SEAM(0);

    for (int step = 0; step < 12; ++step) {
        const int layer = step / 3, sub = step - 3 * layer, base = 1 + NPS * step, jp = layer >> 1;
        if (sub != 1) {
            const int half = sub >> 1, f = layer * 2 + half;
            const int vin = 3 * layer + 2 * half;
            if (IN(base + 1)) { PH_ENTER(); Gemm g{HN, (const bf16_t*)(ws + WS_WGU + (size_t)f * GU_BYTES), T, 2 * FF, D, D, D, 0, 0}; StaticOrder S; S.init(T, 2 * FF, F.G, F.bx);
                pg8::Unit u0; const bool any = S.next(0, u0); const int pm0 = any ? u0.pm : 0; const float* sq = SSQ + (size_t)vin * T * 32; panel_rstd(F, sq, pm0, RSL);
                pg8::EpiSwiGLU E{ACT, FF, pg8::RowScale{RSL, pm0, sq}}; gemm_phase<pg8::EpiSwiGLU, StaticOrder>(F.lds, g, S, E, nullptr, F.tid); }
            SEAM(base + 1);
            if (IN(base + 2)) { PH_ENTER(); Gemm g{ACT, (const bf16_t*)(ws + WS_WD + (size_t)f * DN_BYTES), T, D, FF, FF, FF, 0, 0}; StaticOrder S; S.init(T, D, F.G, F.bx);
                pg8::EpiResid E{h, D, HN, SSQ + (size_t)(vin + 1) * T * 32, RED, step == 11}; gemm_phase<pg8::EpiResid, StaticOrder>(F.lds, g, S, E, nullptr, F.tid); }
            SEAM(base + 2);
        } else if ((layer & 1) == 0) {
#define AB_PTRS() bf16_t* P = ACT; unsigned char* mx = ws + WS_MIX; bf16_t* CB = (bf16_t*)(mx + MX_C); bf16_t* QK = (bf16_t*)(mx + MX_QK); bf16_t* CST = (bf16_t*)(mx + MX_CST); bf16_t* SST = (bf16_t*)(mx + MX_SST); float* GIF = (float*)(mx + MX_GIF); float* NST = (float*)(mx + MX_NST); float* SCL = (float*)(mx + MX_SCL); float* HDEC = (float*)(mx + MX_HDEC); bf16_t* Y = (bf16_t*)(mx + MX_Y); (void)P; (void)CB; (void)QK; (void)CST; (void)SST; (void)GIF; (void)NST; (void)SCL; (void)HDEC; (void)Y
            if (IN(base + 1)) { PH_ENTER(); AB_PTRS(); const float* ssq = SSQ + (size_t)(3 * layer + 1) * T * 32;
                { Gemm g{HN, (const bf16_t*)(ws + WS_WABIN + (size_t)jp * ABIN_BYTES), T, AB_N, D, D, D, 0, 0}; StaticOrder S; S.init(T, AB_N, F.G, F.bx);
                  pg8::Unit u0; const bool any = S.next(0, u0); const int pm0 = any ? u0.pm : 0; panel_rstd(F, ssq, pm0, RSL);
                  pg8::EpiPlainBf16 E{P, AB_N, pg8::RowScale{RSL, pm0, ssq}, true}; gemm_phase<pg8::EpiPlainBf16, StaticOrder>(F.lds, g, S, E, nullptr, F.tid); }
                ph_skinny<8>(F, HN, ssq, (const bf16_t*)(ws + WS_WSK) + (size_t)jp * 64 * D, GIF); }
            SEAM(base + 1);
            if (IN(base + 2)) { PH_ENTER(); AB_PTRS(); ph_conv(F, P, ap->in[12] + (size_t)jp * 4096, ap->in[13] + (size_t)jp * 1024, CB); }
            SEAM(base + 2);
            if (IN(base + 3)) { PH_ENTER(); AB_PTRS(); Gemm g{CB, (const bf16_t*)(ws + WS_WQK + (size_t)jp * WQK_BYTES), T, 2048, 256, 1024, 256, 3, 256}; StaticOrder S; S.init(T, 2048, F.G, F.bx);
                pg8::EpiPlainBf16 E{QK, 2048, pg8::RowScale{nullptr, -1, nullptr}, false}; gemm_phase<pg8::EpiPlainBf16, StaticOrder>(F.lds, g, S, E, nullptr, F.tid); }
            SEAM(base + 3);
            if (IN(base + 4)) { PH_ENTER(); AB_PTRS(); ph_chunk_r1(F, P, QK, GIF, ap->in[16] + jp * 4, ap->in[17] + jp * 4, ap->in[20], jp, CST, NST, SCL, SST, HDEC); }
            SEAM(base + 4);
            if (IN(base + 5)) { PH_ENTER(); AB_PTRS(); ph_chunk_r2(F, CST, NST, SCL, SST, HDEC); }
            SEAM(base + 5);
            if (IN(base + 6)) { PH_ENTER(); AB_PTRS(); ph_chunk_r3(F, P, QK, CB, GIF, ap->in[16] + jp * 4, ap->in[17] + jp * 4, ap->in[20], jp, CST, NST, SCL, SST, ap->in[18] + (size_t)jp * 1024, ap->in[19] + (size_t)jp * 1024, ap->in[21] + (size_t)jp * 1024, Y); }
            SEAM(base + 6);
            if (IN(base + 7)) { PH_ENTER(); AB_PTRS(); Gemm g{Y, (const bf16_t*)(ws + WS_WABOUT + (size_t)jp * SQ_BYTES), T, D, D, D, D, 0, 0}; StaticOrder S; S.init(T, D, F.G, F.bx);
                pg8::EpiResid E{h, D, HN, SSQ + (size_t)(3 * layer + 2) * T * 32, RED, false}; gemm_phase<pg8::EpiResid, StaticOrder>(F.lds, g, S, E, nullptr, F.tid); }
            SEAM(base + 7);
        } else {
#define C_PTRS() bf16_t* SL = ACT; unsigned char* mx = ws + WS_MIX; float* GP = (float*)(mx + MX_GP); bf16_t* HID = (bf16_t*)(mx + MX_HID); bf16_t* KC = (bf16_t*)(mx + MX_KCMP); bf16_t* VC = (bf16_t*)(mx + MX_VCMP); bf16_t* O = (bf16_t*)(mx + MX_O); const float* rope = (const float*)(ws + WS_ROPE); (void)SL; (void)GP; (void)HID; (void)KC; (void)VC; (void)O; (void)rope
            if (IN(base + 1)) { PH_ENTER(); C_PTRS(); const float* ssq = SSQ + (size_t)(3 * layer + 1) * T * 32;
                { Gemm g{HN, (const bf16_t*)(ws + WS_WCIN + (size_t)jp * CIN_BYTES), T, C_N, D, D, D, 0, 0}; StaticOrder S; S.init(T, C_N, F.G, F.bx);
                  pg8::Unit u0; const bool any = S.next(0, u0); const int pm0 = any ? u0.pm : 0; panel_rstd(F, ssq, pm0, RSL);
                  pg8::EpiSlots E{SL, T, pg8::RowScale{RSL, pm0, ssq}}; gemm_phase<pg8::EpiSlots, StaticOrder>(F.lds, g, S, E, nullptr, F.tid); }
                ph_skinny<48>(F, HN, ssq, (const bf16_t*)(ws + WS_WSK) + (size_t)(2 + jp) * 64 * D, GP); }
            SEAM(base + 1);
            if (IN(base + 2)) {
                { PH_ENTER(); C_PTRS(); const int kv = F.bx >= 16 ? 1 : 0;
                  const float* cbias = (const float*)(ws + WS_CB) + (size_t)jp * 512 + kv * 256;
                  Gemm g{SL + (size_t)(16 + 4 * kv) * T * 128, (const bf16_t*)(ws + WS_WCMP1 + (size_t)(jp * 2 + kv) * CMP1_BYTES), 4096, 256, 4096, 2048, 4096, 0, 0};
                  StaticOrder S; S.init(4096, 256, F.G, kv ? F.bx - 16 : F.bx);
                  pg8::EpiSiluBias E{HID + (size_t)kv * 4096 * 256, 256, cbias}; gemm_phase<pg8::EpiSiluBias, StaticOrder>(F.lds, g, S, E, nullptr, F.tid); }
                { PH_ENTER(); C_PTRS(); ph_qknorm_rope(F, SL, ap->in[24] + (size_t)jp * 128, ap->in[25] + (size_t)jp * 384, rope); } }
            SEAM(base + 2);
            if (IN(base + 3)) { PH_ENTER(); C_PTRS(); ph_compress2(F, HID, ap->in[29] + (size_t)jp * 2 * 256 * 128, ap->in[25] + (size_t)jp * 384, rope, KC, VC); }
            SEAM(base + 3);
            if (IN(base + 4)) { PH_ENTER(); C_PTRS(); ph_attn_mfma(F, SL, GP, ap->in[30] + (size_t)jp * 48, ap->in[25] + (size_t)jp * 384, KC, VC, O); }
            SEAM(base + 4);
            if (IN(base + 6)) { PH_ENTER(); C_PTRS(); Gemm g{O, (const bf16_t*)(ws + WS_WCOUT + (size_t)jp * SQ_BYTES), T, D, D, D, D, 0, 0}; StaticOrder S; S.init(T, D, F.G, F.bx);
                pg8::EpiResid E{h, D, HN, SSQ + (size_t)(3 * layer + 2) * T * 32, RED, false}; gemm_phase<pg8::EpiResid, StaticOrder>(F.lds, g, S, E, nullptr, F.tid); }
            SEAM(base + 6);
        }
    }
#undef IN
#undef SEAM
}

extern "C" void kernel_launch(void* const* d_in, const int* in_sizes, int n_in, void* d_out, int out_size, void* d_ws, size_t ws_size, hipStream_t stream) {
    static int grid = 0;
    if (grid == 0) {
        if (n_in != 31 || in_sizes[0] != T * D || out_size != T * D || ws_size < WS_END) { fprintf(stderr, "kernel_launch: unexpected problem shape (n_in %d, in0 %d, out %d, ws %zu < %zu)\n", n_in, n_in > 0 ? in_sizes[0] : -1, out_size, ws_size, (size_t)WS_END); grid = -1; return; }
        int dev = 0, cus = 0, per_cu = 0;
        if (hipGetDevice(&dev) != hipSuccess || hipDeviceGetAttribute(&cus, hipDeviceAttributeMultiprocessorCount, dev) != hipSuccess) { grid = -1; return; }
        if (hipFuncSetAttribute((const void*)fwd_kernel, hipFuncAttributeMaxDynamicSharedMemorySize, LDS_BYTES) != hipSuccess) { fprintf(stderr, "kernel_launch: hipFuncSetAttribute failed\n"); grid = -1; return; }
        if (hipOccupancyMaxActiveBlocksPerMultiprocessor(&per_cu, (const void*)fwd_kernel, NTHREADS, LDS_BYTES) != hipSuccess || per_cu < 1) { fprintf(stderr, "kernel_launch: occupancy query reports %d workgroups per CU\n", per_cu); }
        (void)hipGetLastError();
        grid = cus;
    }
    if (grid < 0) return;
    if (hipMemsetAsync((char*)d_ws + WS_CTL, 0, CTL_ZERO_BYTES, stream) != hipSuccess) return;
    Args a{};
    for (int i = 0; i < 31; ++i) a.in[i] = (const float*)d_in[i];
    a.out = (float*)d_out; a.ws = (unsigned char*)d_ws;
#if MK_MULTI_LAUNCH
    for (int p = 0; p < NSLOTS_PH; ++p) {
        if (p > 0) { const int step = (p - 1) / NPS, q = (p - 1) % NPS, sub = step % 3, layer = step / 3;
            if (q == 0) continue; if (sub != 1 && q > 2) continue; if (sub == 1 && (layer & 1) == 1 && (q == 5 || q == 7)) continue; }
        a.ph_lo = p; a.ph_hi = p + 1;
        hipLaunchKernelGGL(fwd_kernel, dim3(grid), dim3(NTHREADS), LDS_BYTES, stream, a);
    }
#else
    a.ph_lo = 0; a.ph_hi = NSLOTS_PH;
    hipLaunchKernelGGL(fwd_kernel, dim3(grid), dim3(NTHREADS), LDS_BYTES, stream, a);
#endif
}
```

```cpp
#include <hip/hip_runtime.h>
#include <cstdio>
#include <cstdint>

constexpr int BATCH = 2, SEQ = 8192, T = BATCH * SEQ, D = 2048, FF = 5504, DEPTH = 4;
constexpr int AB_COLS = 7176, AB_N = 7168;
constexpr int C_COLS = 5168, C_N = 5120;
constexpr int NSLOT = 40;
constexpr int NCMP = 512;
constexpr float NORM_EPS = 1e-6f;

#define GAS __attribute__((address_space(1)))
#define LAS __attribute__((address_space(3)))
typedef unsigned short bf16_t;
typedef unsigned v4u __attribute__((ext_vector_type(4)));
typedef unsigned v2u __attribute__((ext_vector_type(2)));
typedef float f32x4 __attribute__((ext_vector_type(4)));
typedef float f32x2 __attribute__((ext_vector_type(2)));
typedef short bf16x8 __attribute__((ext_vector_type(8)));

__device__ __forceinline__ unsigned f2bf(float f) { return (unsigned)__builtin_bit_cast(unsigned short, (__bf16)f); }
typedef float pk_f2_t __attribute__((ext_vector_type(2)));
typedef __bf16 pk_b2_t __attribute__((ext_vector_type(2)));
__device__ __forceinline__ unsigned pk2(float lo, float hi) { const pk_f2_t v = {lo, hi}; return __builtin_bit_cast(unsigned, __builtin_convertvector(v, pk_b2_t)); }
__device__ __forceinline__ float bf2f(unsigned short b) { return __builtin_bit_cast(float, ((unsigned)b) << 16); }
__device__ __forceinline__ float bflo(unsigned w) { return __builtin_bit_cast(float, w << 16); }
__device__ __forceinline__ float bfhi(unsigned w) { return __builtin_bit_cast(float, w & 0xffff0000u); }
#define DPP_F(v, ctrl) __builtin_bit_cast(float, __builtin_amdgcn_mov_dpp(__builtin_bit_cast(int, (v)), (ctrl), 0xf, 0xf, true))
__device__ __forceinline__ float wave_sum(float v) {
    v += DPP_F(v, 0xB1); v += DPP_F(v, 0x4E); v += DPP_F(v, 0x124); v += DPP_F(v, 0x128);
    const int b = __builtin_bit_cast(int, v);
    return (__builtin_bit_cast(float, __builtin_amdgcn_readlane(b, 0)) + __builtin_bit_cast(float, __builtin_amdgcn_readlane(b, 16))) + (__builtin_bit_cast(float, __builtin_amdgcn_readlane(b, 32)) + __builtin_bit_cast(float, __builtin_amdgcn_readlane(b, 48)));
}
__device__ __forceinline__ float wave_max(float v) {
    v = fmaxf(v, DPP_F(v, 0xB1)); v = fmaxf(v, DPP_F(v, 0x4E)); v = fmaxf(v, DPP_F(v, 0x124)); v = fmaxf(v, DPP_F(v, 0x128));
    const int b = __builtin_bit_cast(int, v);
    return fmaxf(fmaxf(__builtin_bit_cast(float, __builtin_amdgcn_readlane(b, 0)), __builtin_bit_cast(float, __builtin_amdgcn_readlane(b, 16))), fmaxf(__builtin_bit_cast(float, __builtin_amdgcn_readlane(b, 32)), __builtin_bit_cast(float, __builtin_amdgcn_readlane(b, 48))));
}
__device__ __forceinline__ float half_swap_sum(float x, LAS float* scr64, int lane) {
    scr64[lane] = x; asm volatile("s_waitcnt lgkmcnt(0)" ::: "memory"); const float y = scr64[lane ^ 32]; asm volatile("s_waitcnt lgkmcnt(0)" ::: "memory"); return x + y; }
__device__ __forceinline__ float opaque_one() { float one = 1.0f; asm volatile("" : "+v"(one)); return one; }
__device__ __forceinline__ float sigmoidf_(float x) { return __builtin_amdgcn_rcpf(1.0f + __expf(-x)); }
__device__ __forceinline__ float siluf_(float x) { return x * __builtin_amdgcn_rcpf(1.0f + __expf(-x)); }
__device__ __forceinline__ float row16_sum(float v) {
    v += __builtin_bit_cast(float, __builtin_amdgcn_mov_dpp(__builtin_bit_cast(int, v), 0xB1, 0xf, 0xf, true));
    v += __builtin_bit_cast(float, __builtin_amdgcn_mov_dpp(__builtin_bit_cast(int, v), 0x4E, 0xf, 0xf, true));
    v += __builtin_bit_cast(float, __builtin_amdgcn_mov_dpp(__builtin_bit_cast(int, v), 0x124, 0xf, 0xf, true));
    v += __builtin_bit_cast(float, __builtin_amdgcn_mov_dpp(__builtin_bit_cast(int, v), 0x128, 0xf, 0xf, true));
    return v;
}

__device__ __forceinline__ int lane_id() { int l; asm volatile("v_mbcnt_lo_u32_b32 %0, -1, 0\n\tv_mbcnt_hi_u32_b32 %0, -1, %0" : "=v"(l)); return l; }
#define XB_TMO      128
#define XB_XCNT(j)  (256  + 64 * (j))
#define XB_XSUB(j)  (1280 + 64 * (j))
#define XB_XGEN(j)  (2304 + 64 * (j))
#define XB_TOP      3328
#define XB_TOPGEN   3392
#define XCD_BAR_WORDS 3456
#define XB_SPIN_CAP (1u << 18)

__device__ __forceinline__ unsigned xb_ld(unsigned* p)              { return __hip_atomic_load(p, __ATOMIC_RELAXED, __HIP_MEMORY_SCOPE_AGENT); }
__device__ __forceinline__ unsigned xb_add(unsigned* p, unsigned v) { return __hip_atomic_fetch_add(p, v, __ATOMIC_RELAXED, __HIP_MEMORY_SCOPE_AGENT); }
__device__ __forceinline__ unsigned xb_xcc_id() { return (unsigned)__builtin_amdgcn_s_getreg((3 << 11) | 20) & 0xFu; }
#define XB_SPIN(cond, bar) do { unsigned _sp = 0; while (cond) { __builtin_amdgcn_s_sleep(1); \
    if ((++_sp & 255u) == 0u) { if (xb_ld(&(bar)[XB_TMO])) break; if (_sp > XB_SPIN_CAP) { atomicAdd(&(bar)[XB_TMO], 1u); break; } } } } while (0)

struct XcdBarrier {
    unsigned* bar; unsigned x;
    volatile LAS unsigned* st;
    int wv;
};
__device__ __forceinline__ bool xb_leader(const XcdBarrier& b) { int l; asm volatile("v_mbcnt_lo_u32_b32 %0, -1, 0\n\tv_mbcnt_hi_u32_b32 %0, -1, %0" : "=v"(l)); return b.wv == 0 && l == 0; }

__device__ __forceinline__ XcdBarrier xcd_barrier_post(unsigned* bar, volatile LAS unsigned* st, int wv) {
    XcdBarrier b; b.bar = bar; b.x = xb_xcc_id(); b.st = st; b.wv = wv;
    if (xb_leader(b)) (void)xb_add(&bar[XB_XCNT(b.x)], 1u);
    return b;
}
__device__ __forceinline__ void xcd_barrier_complete(unsigned* bar, unsigned x, unsigned& nloc, unsigned& nx) {
    const unsigned G = gridDim.x * gridDim.y * gridDim.z;
    unsigned sum, cnt, mine, sp = 0u;
    for (;;) {
        sum = 0u; cnt = 0u; mine = 0u;
#pragma unroll
        for (unsigned j = 0; j < 16; ++j) { const unsigned c = xb_ld(&bar[XB_XCNT(j)]); sum += c; cnt += (c > 0u) ? 1u : 0u; mine = (j == x) ? c : mine; }
        if (sum == G) break;
        __builtin_amdgcn_s_sleep(1);
        if ((++sp & 255u) == 0u) { if (xb_ld(&bar[XB_TMO])) break; if (sp > XB_SPIN_CAP) { atomicAdd(&bar[XB_TMO], 1u); break; } }
    }
    nloc = mine > 0u ? mine : 1u; nx = cnt > 0u ? cnt : 1u;
}

__device__ __forceinline__ void xcd_barrier(const XcdBarrier& b) {
    asm volatile("s_waitcnt vmcnt(0)" ::: "memory");
    __syncthreads();
    if (xb_leader(b)) {
        unsigned* bar = b.bar; asm volatile("" : "+s"(bar));
        __builtin_amdgcn_s_waitcnt(0);
        unsigned nloc = b.st[0], nx = b.st[1];
        if (nloc == 0u) { xcd_barrier_complete(bar, b.x, nloc, nx); b.st[0] = nloc; b.st[1] = nx; }
        const unsigned old = xb_add(&bar[XB_XSUB(b.x)], 1u);
        const unsigned gen = old / nloc;
        if (old + 1u == (gen + 1u) * nloc) {
            __builtin_amdgcn_fence(__ATOMIC_RELEASE, "agent");
            asm volatile("s_waitcnt vmcnt(0)" ::: "memory");
            const unsigned og = xb_add(&bar[XB_TOP], 1u);
            const unsigned tg = og / nx;
            if (og + 1u == (tg + 1u) * nx) xb_add(&bar[XB_TOPGEN], 1u);
            else XB_SPIN(xb_ld(&bar[XB_TOPGEN]) == tg, bar);
            __builtin_amdgcn_fence(__ATOMIC_ACQUIRE, "agent");
            xb_add(&bar[XB_XGEN(b.x)], 1u);
            asm volatile("s_waitcnt vmcnt(0)" ::: "memory");
        } else {
            XB_SPIN(xb_ld(&bar[XB_XGEN(b.x)]) == gen, bar);
            __builtin_amdgcn_fence(__ATOMIC_ACQUIRE, "agent");
            asm volatile("s_waitcnt vmcnt(0)" ::: "memory");
        }
    }
    __syncthreads();
}
namespace pg8 {
#define PG8_LAS __attribute__((address_space(3)))
typedef unsigned short bf16_t;
typedef short bf16x8 __attribute__((ext_vector_type(8)));
typedef float f32x4 __attribute__((ext_vector_type(4)));
typedef unsigned u32x4 __attribute__((ext_vector_type(4)));
constexpr int BM = 256, BK = 64, HALF = 128, HTB = HALF * BK * 2  , STAGE_BYTES = 8 * HTB, NXCD = 8, WGM = 8;

__host__ __device__ __forceinline__ int lds_byte(int r, int c) { const int st = (r >> 4) * 2 + (c >> 5), rr = r & 15, cc = c & 31, ob = rr * 64 + cc * 2; return st * 1024 + (ob ^ (((ob >> 9) & 1) << 5)); }
__host__ __device__ __forceinline__ void stage_rc(int b, int& R, int& C) { const int st = b / 1024, sb = b % 1024, swz = sb ^ (((sb >> 9) & 1) << 5); R = (st >> 1) * 16 + swz / 64; C = (st & 1) * 32 + (swz % 64) / 2; }
__host__ __device__ __forceinline__ int perm32(int rho) { const int n = rho >> 4, i = rho & 15; return 8 * (i >> 2) + 4 * n + (i & 3); }

struct Unit { int pm, pn; };
struct Gemm { const bf16_t* A; const bf16_t* Bt; int M, N, K; int lda, ldb; int amask; int astride; };

struct StaticOrder {
    int nM, nN, nwg, G, c;
    __host__ __device__ __forceinline__ void init(int M, int N, int G_, int c_) { nM = M / BM; nN = N / BM; nwg = nM * nN; G = G_; c = c_; }
    __host__ __device__ __forceinline__ bool next(int i, Unit& u) const {
        const long L = (long)i * G + c; if (L >= nwg) return false;
        int wgid = (int)L; { const int q = nwg / NXCD, r = nwg % NXCD, xcd = wgid % NXCD, off = wgid / NXCD; wgid = (xcd < r ? xcd * (q + 1) : r * (q + 1) + (xcd - r) * q) + off; }
        const int nig = WGM * nN, gid = wgid / nig, fm = gid * WGM, gsz = (nM - fm) < WGM ? (nM - fm) : WGM;
        u.pm = fm + ((wgid % nig) % gsz); u.pn = (wgid % nig) / gsz; return true;
    }
    __device__ __forceinline__ void a_ready(const Unit&) const {}
    __device__ __forceinline__ void done(const Unit&) const {}
};
struct CountedOrder : StaticOrder {
    const unsigned* ready; unsigned need; unsigned* tmo;
    __device__ __forceinline__ void a_ready(const Unit& u) const {
        if (threadIdx.x < 64) {
            const unsigned long long t0 = __builtin_amdgcn_s_memrealtime(); unsigned polls = 0;
            while ((unsigned)__builtin_amdgcn_readfirstlane(__hip_atomic_load(ready + 64 * u.pm, __ATOMIC_RELAXED, __HIP_MEMORY_SCOPE_AGENT)) < need) {
                if ((++polls & 255u) == 0u && __builtin_amdgcn_readfirstlane(__hip_atomic_load(tmo, __ATOMIC_RELAXED, __HIP_MEMORY_SCOPE_AGENT)) != 0u) break;
                if (__builtin_amdgcn_s_memrealtime() - t0 > 2000000ull) {
                    if (threadIdx.x == 0) { unsigned expect = 0u; __hip_atomic_compare_exchange_strong(tmo + 1, &expect, 0x600u | (unsigned)(u.pm & 0xff), __ATOMIC_RELAXED, __ATOMIC_RELAXED, __HIP_MEMORY_SCOPE_AGENT); __hip_atomic_store(tmo, 1u, __ATOMIC_RELAXED, __HIP_MEMORY_SCOPE_AGENT); }
                    break; }
                __builtin_amdgcn_s_sleep(2); }
            __builtin_amdgcn_fence(__ATOMIC_ACQUIRE, "agent");
            asm volatile("s_waitcnt vmcnt(0)" ::: "memory");
        }
#if !defined(BROKEN_HOOK_NO_BARRIER)
        asm volatile("" ::: "memory"); __builtin_amdgcn_s_barrier(); asm volatile("" ::: "memory");
#endif
    }
};

__device__ __forceinline__ unsigned cvt_pk_bf16(float lo, float hi) { unsigned r; asm volatile("v_cvt_pk_bf16_f32 %0, %1, %2" : "=v"(r) : "v"(lo), "v"(hi)); return r; }
typedef float f32x2 __attribute__((ext_vector_type(2)));
__device__ __forceinline__ f32x2 gelu_pk(f32x2 v) {
    const f32x2 av = __builtin_elementwise_abs(v), d = av * 0.2316418882f + 1.0f;
    f32x2 t; t.x = __builtin_amdgcn_rcpf(d.x); t.y = __builtin_amdgcn_rcpf(d.y);
    f32x2 q = t * 0.5307027145f + (-0.7265760135f); q = q * t + 0.7107068705f; q = q * t + (-0.142248368f); q = q * t + 0.127414796f; q = q * t;
    const f32x2 s = (v * v) * (-0.72134752044f);
    f32x2 e; e.x = __builtin_amdgcn_exp2f(s.x); e.y = __builtin_amdgcn_exp2f(s.y);
    const f32x2 m = v * (q * e), r = v - m;
    f32x2 o; o.x = v.x < 0.f ? m.x : r.x; o.y = v.y < 0.f ? m.y : r.y; return o;
}

struct EpiF32 {
    static constexpr bool PERM = false, AFTER_DRAIN = false;
    float* C; int ldc; const float* bias;
    __device__ __forceinline__ void operator()(const f32x4 (&acc)[2][2][4][2], const Unit& u, int wr, int wc, int fr, int fq) const {
        const int row0 = u.pm * BM + wr * 64 + fr, col0 = u.pn * BM + wc * 32 + 4 * fq;
        f32x4 bv[2][2];
#pragma unroll
        for (int bj = 0; bj < 2; ++bj)
#pragma unroll
            for (int n = 0; n < 2; ++n) bv[bj][n] = bias ? *(const f32x4*)(bias + col0 + bj * HALF + n * 16) : (f32x4){0.f, 0.f, 0.f, 0.f};
#pragma unroll
        for (int ai = 0; ai < 2; ++ai)
#pragma unroll
            for (int m = 0; m < 4; ++m) { float* rowp = C + (size_t)(row0 + ai * HALF + m * 16) * ldc + col0;
#pragma unroll
                for (int bj = 0; bj < 2; ++bj)
#pragma unroll
                    for (int n = 0; n < 2; ++n) *(f32x4*)(rowp + bj * HALF + n * 16) = acc[ai][bj][m][n] + bv[bj][n]; }
    }
};
template <int ACT  > struct EpiBf16 {
    static constexpr bool PERM = true, AFTER_DRAIN = false;
    bf16_t* O; int ldc; const float* bias; int split_cols; size_t split_stride;
    __device__ __forceinline__ void operator()(const f32x4 (&acc)[2][2][4][2], const Unit& u, int wr, int wc, int fr, int fq) const {
        const int row0 = u.pm * BM + wr * 64 + fr; int colt = u.pn * BM; bf16_t* base = O;
        if (split_cols) { const int t = colt / split_cols; base += (size_t)t * split_stride; colt -= t * split_cols; }
        const int col0 = colt + wc * 32 + 8 * fq, bcol0 = u.pn * BM + wc * 32 + 8 * fq;
        f32x4 bv[2][2];
#pragma unroll
        for (int bj = 0; bj < 2; ++bj)
#pragma unroll
            for (int n = 0; n < 2; ++n) bv[bj][n] = bias ? *(const f32x4*)(bias + bcol0 + bj * HALF + 4 * n) : (f32x4){0.f, 0.f, 0.f, 0.f};
#pragma unroll
        for (int ai = 0; ai < 2; ++ai)
#pragma unroll
            for (int m = 0; m < 4; ++m) { bf16_t* rowp = base + (size_t)(row0 + ai * HALF + m * 16) * ldc + col0;
#pragma unroll
                for (int bj = 0; bj < 2; ++bj) { f32x4 v0 = acc[ai][bj][m][0] + bv[bj][0], v1 = acc[ai][bj][m][1] + bv[bj][1];
                    if (ACT == 1) { f32x2 a = gelu_pk((f32x2){v0[0], v0[1]}), b = gelu_pk((f32x2){v0[2], v0[3]}), c = gelu_pk((f32x2){v1[0], v1[1]}), d = gelu_pk((f32x2){v1[2], v1[3]});
                        v0 = (f32x4){a.x, a.y, b.x, b.y}; v1 = (f32x4){c.x, c.y, d.x, d.y}; }
                    if (ACT == 2) {
#pragma unroll
                        for (int j = 0; j < 4; ++j) { v0[j] = 0.5f * v0[j] * (1.0f + erff(v0[j] * 0.70710678f)); v1[j] = 0.5f * v1[j] * (1.0f + erff(v1[j] * 0.70710678f)); } }
                    u32x4 w; w.x = cvt_pk_bf16(v0[0], v0[1]); w.y = cvt_pk_bf16(v0[2], v0[3]); w.z = cvt_pk_bf16(v1[0], v1[1]); w.w = cvt_pk_bf16(v1[2], v1[3]);
                    *(u32x4*)(rowp + bj * HALF) = w; } }
    }
};

struct RowScale { PG8_LAS const float* rsl; int pm0; const float* ssqp;
    __device__ __forceinline__ float operator()(int row) const { if ((row >> 8) == pm0) return rsl[row & 255];
        const f32x4* p = (const f32x4*)(ssqp + (size_t)row * 32); float s = 0.f;
#pragma unroll
        for (int q = 0; q < 8; ++q) { const f32x4 v = p[q]; s += (v.x + v.y) + (v.z + v.w); }
        return __builtin_amdgcn_rsqf(s * (1.0f / 2048.0f) + 1e-6f); } };
__device__ __forceinline__ float silu_f(float x) { return x * __builtin_amdgcn_rcpf(1.0f + __expf(-x)); }
struct EpiSwiGLU {
    static constexpr bool PERM = true, AFTER_DRAIN = false;
    bf16_t* O; int ldc; RowScale rsc;
    __device__ __forceinline__ void operator()(const f32x4 (&acc)[2][2][4][2], const Unit& u, int wr, int wc, int fr, int fq) const {
        const int row0 = u.pm * BM + wr * 64 + fr, col0 = u.pn * HALF + wc * 32 + 8 * fq;
#pragma unroll
        for (int ai = 0; ai < 2; ++ai)
#pragma unroll
            for (int m = 0; m < 4; ++m) { const int row = row0 + ai * HALF + m * 16; bf16_t* rowp = O + (size_t)row * ldc + col0;
                const float rs = rsc(row), c1 = -1.4426950408889634f * rs, rs2 = rs * rs;
                const f32x4 g0 = acc[ai][0][m][0], g1 = acc[ai][0][m][1], u0 = acc[ai][1][m][0], u1 = acc[ai][1][m][1];
                float r[8];
#pragma unroll
                for (int j = 0; j < 4; ++j) { r[j] = (g0[j] * u0[j]) * rs2 * __builtin_amdgcn_rcpf(1.0f + __builtin_amdgcn_exp2f(g0[j] * c1));
                                              r[4 + j] = (g1[j] * u1[j]) * rs2 * __builtin_amdgcn_rcpf(1.0f + __builtin_amdgcn_exp2f(g1[j] * c1)); }
                u32x4 w; w.x = cvt_pk_bf16(r[0], r[1]); w.y = cvt_pk_bf16(r[2], r[3]); w.z = cvt_pk_bf16(r[4], r[5]); w.w = cvt_pk_bf16(r[6], r[7]);
                *(u32x4*)rowp = w; }
    }
};
struct EpiResid {
    static constexpr bool PERM = true, AFTER_DRAIN = false;
    float* H; int ldc; bf16_t* HB; float* ssqp; PG8_LAS float* red; bool last;
    __device__ __forceinline__ void operator()(const f32x4 (&acc)[2][2][4][2], const Unit& u, int wr, int wc, int fr, int fq) const {
        const int row0 = u.pm * BM + wr * 64 + fr, col0 = u.pn * BM + wc * 32 + 8 * fq;
        PG8_LAS float* myred = red + (wr * 4 + wc) * 384;
        float part[8];
#pragma unroll
        for (int ai = 0; ai < 2; ++ai) {
            u32x4 t[4][2];
#pragma unroll
            for (int m = 0; m < 4; ++m) { const bf16_t* rowp = HB + (size_t)(row0 + ai * HALF + m * 16) * ldc + col0;
#pragma unroll
                for (int bj = 0; bj < 2; ++bj) t[m][bj] = *(const u32x4*)(rowp + bj * HALF); }
            asm volatile("" ::: "memory");
#pragma unroll
            for (int m = 0; m < 4; ++m) { const size_t off = (size_t)(row0 + ai * HALF + m * 16) * ldc + col0; float s = 0.f;
#pragma unroll
                for (int bj = 0; bj < 2; ++bj) { const u32x4 w0 = t[m][bj];
                    const f32x4 h0 = {__builtin_bit_cast(float, w0.x << 16), __builtin_bit_cast(float, w0.x & 0xFFFF0000u), __builtin_bit_cast(float, w0.y << 16), __builtin_bit_cast(float, w0.y & 0xFFFF0000u)};
                    const f32x4 h1 = {__builtin_bit_cast(float, w0.z << 16), __builtin_bit_cast(float, w0.z & 0xFFFF0000u), __builtin_bit_cast(float, w0.w << 16), __builtin_bit_cast(float, w0.w & 0xFFFF0000u)};
                    const f32x4 v0 = h0 + acc[ai][bj][m][0], v1 = h1 + acc[ai][bj][m][1];
                    if (last) { __builtin_nontemporal_store(v0, (f32x4*)(H + off + bj * HALF)); __builtin_nontemporal_store(v1, (f32x4*)(H + off + bj * HALF + 4)); }
                    else { u32x4 w; w.x = cvt_pk_bf16(v0[0], v0[1]); w.y = cvt_pk_bf16(v0[2], v0[3]); w.z = cvt_pk_bf16(v1[0], v1[1]); w.w = cvt_pk_bf16(v1[2], v1[3]); *(u32x4*)(HB + off + bj * HALF) = w; }
                    s += ((v0[0] * v0[0] + v0[1] * v0[1]) + (v0[2] * v0[2] + v0[3] * v0[3])) + ((v1[0] * v1[0] + v1[1] * v1[1]) + (v1[2] * v1[2] + v1[3] * v1[3])); }
                part[ai * 4 + m] = s; }
            asm volatile("" ::: "memory");
        }
        if (last) return;
#pragma unroll
        for (int r = 0; r < 8; ++r) if (fq > 0) myred[(r * 16 + fr) * 3 + (fq - 1)] = part[r];
        asm volatile("s_waitcnt lgkmcnt(0)" ::: "memory");
        if (fq == 0) {
#pragma unroll
            for (int r = 0; r < 8; ++r) { const float s = part[r] + (myred[(r * 16 + fr) * 3 + 0] + myred[(r * 16 + fr) * 3 + 1]) + myred[(r * 16 + fr) * 3 + 2];
                ssqp[(size_t)(row0 + (r >> 2) * HALF + (r & 3) * 16) * 32 + u.pn * 4 + wc] = s; } }
        asm volatile("s_waitcnt lgkmcnt(0)" ::: "memory");
    }
};
struct EpiPlainBf16 {
    static constexpr bool PERM = true, AFTER_DRAIN = false;
    bf16_t* O; int ldc; RowScale rsc; bool scaled;
    __device__ __forceinline__ void operator()(const f32x4 (&acc)[2][2][4][2], const Unit& u, int wr, int wc, int fr, int fq) const {
        const int row0 = u.pm * BM + wr * 64 + fr, col0 = u.pn * BM + wc * 32 + 8 * fq;
#pragma unroll
        for (int ai = 0; ai < 2; ++ai)
#pragma unroll
            for (int m = 0; m < 4; ++m) { const int row = row0 + ai * HALF + m * 16; bf16_t* rowp = O + (size_t)row * ldc + col0;
                const float rs = scaled ? rsc(row) : 1.0f;
#pragma unroll
                for (int bj = 0; bj < 2; ++bj) { const f32x4 v0 = acc[ai][bj][m][0] * rs, v1 = acc[ai][bj][m][1] * rs;
                    u32x4 w; w.x = cvt_pk_bf16(v0[0], v0[1]); w.y = cvt_pk_bf16(v0[2], v0[3]); w.z = cvt_pk_bf16(v1[0], v1[1]); w.w = cvt_pk_bf16(v1[2], v1[3]);
                    *(u32x4*)(rowp + bj * HALF) = w; } }
    }
};
struct EpiSlots {
    static constexpr bool PERM = true, AFTER_DRAIN = false;
    bf16_t* O; int Mrows; RowScale rsc;
    __device__ __forceinline__ void operator()(const f32x4 (&acc)[2][2][4][2], const Unit& u, int wr, int wc, int fr, int fq) const {
        const int row0 = u.pm * BM + wr * 64 + fr, d0 = wc * 32 + 8 * fq;
#pragma unroll
        for (int ai = 0; ai < 2; ++ai)
#pragma unroll
            for (int m = 0; m < 4; ++m) { const float rs = rsc(row0 + ai * HALF + m * 16);
#pragma unroll
                for (int bj = 0; bj < 2; ++bj) { const f32x4 v0 = acc[ai][bj][m][0] * rs, v1 = acc[ai][bj][m][1] * rs;
                    bf16_t* p = O + ((size_t)(2 * u.pn + bj) * Mrows + (row0 + ai * HALF + m * 16)) * 128 + d0;
                    u32x4 w; w.x = cvt_pk_bf16(v0[0], v0[1]); w.y = cvt_pk_bf16(v0[2], v0[3]); w.z = cvt_pk_bf16(v1[0], v1[1]); w.w = cvt_pk_bf16(v1[2], v1[3]);
                    *(u32x4*)p = w; } }
    }
};
struct EpiSiluBias {
    static constexpr bool PERM = true, AFTER_DRAIN = false;
    bf16_t* O; int ldc; const float* bias;
    __device__ __forceinline__ void operator()(const f32x4 (&acc)[2][2][4][2], const Unit& u, int wr, int wc, int fr, int fq) const {
        const int row0 = u.pm * BM + wr * 64 + fr, col0 = u.pn * BM + wc * 32 + 8 * fq;
        f32x4 bv[2][2];
#pragma unroll
        for (int bj = 0; bj < 2; ++bj)
#pragma unroll
            for (int n = 0; n < 2; ++n) bv[bj][n] = *(const f32x4*)(bias + col0 + bj * HALF + 4 * n);
#pragma unroll
        for (int ai = 0; ai < 2; ++ai)
#pragma unroll
            for (int m = 0; m < 4; ++m) { bf16_t* rowp = O + (size_t)(row0 + ai * HALF + m * 16) * ldc + col0;
#pragma unroll
                for (int bj = 0; bj < 2; ++bj) { const f32x4 v0 = acc[ai][bj][m][0] + bv[bj][0], v1 = acc[ai][bj][m][1] + bv[bj][1];
                    u32x4 w; w.x = cvt_pk_bf16(silu_f(v0[0]), silu_f(v0[1])); w.y = cvt_pk_bf16(silu_f(v0[2]), silu_f(v0[3])); w.z = cvt_pk_bf16(silu_f(v1[0]), silu_f(v1[1])); w.w = cvt_pk_bf16(silu_f(v1[2]), silu_f(v1[3]));
                    *(u32x4*)(rowp + bj * HALF) = w; } }
    }
};

template <class Epi, class Sched, bool STAMP = false>
__device__ __forceinline__ void gemm_phase(PG8_LAS unsigned char* lds, const Gemm g, const Sched& S, const Epi& E, unsigned long long* stamps, int tid_in) {
    int tid_ = tid_in; asm volatile("" : "+v"(tid_));
    const int tid = tid_, wid = __builtin_amdgcn_readfirstlane(tid >> 6), lane = tid & 63, wr = wid >> 2, wc = wid & 3, fr = lane & 15, fq = lane >> 4;
    const int K = g.K, nt = K / BK;
    int ts_lo = 0, ts_hi = 0, nts = 0; const unsigned long long rt_entry = STAMP ? (unsigned long long)wall_clock64() : 0ull;
#define PG8_STAMP() do { if (STAMP && wid == 0 && nts < 64) { const unsigned long long _c = (unsigned long long)clock64(); \
        ts_lo = (lane == nts) ? (int)(unsigned)_c : ts_lo; ts_hi = (lane == nts) ? (int)(unsigned)(_c >> 32) : ts_hi; ++nts; } } while (0)
    PG8_STAMP();
    unsigned voffA[2], voffB[2];
#pragma unroll
    for (int i = 0; i < 2; ++i) { int R, C; stage_rc(tid * 16 + i * 8192, R, C); const int Rb = Epi::PERM ? ((R & ~31) + perm32(R & 31)) : R;
        voffA[i] = (unsigned)(R * g.lda + C) * 2u; voffB[i] = (unsigned)(Rb * g.ldb + C) * 2u; }
    const size_t kstep = (size_t)(BK * 2);
    const size_t hstepA = (size_t)HALF * g.lda * 2, hstepB = (size_t)HALF * g.ldb * 2;
    const size_t tstepA = 2 * hstepA, tstepB = 2 * hstepB;
    const unsigned ldsw = (unsigned)wid * 1024u;
    const int aoff = lds_byte(wr * 64 + fr, fq * 8), boff = lds_byte(wc * 32 + fr, fq * 8);
#define PG8_SA(b, h) (((b) * 2 + (h)) * HTB)
#define PG8_SB(b, h) ((4 + (b) * 2 + (h)) * HTB)
#define PG8_STAGE(bufoff, gbase, voff) do { _Pragma("unroll") for (int _i = 0; _i < 2; ++_i) \
        __builtin_amdgcn_global_load_lds((const unsigned*)((const char*)(gbase) + (voff)[_i]), (PG8_LAS unsigned*)(lds + (bufoff) + ldsw + _i * 8192), 16, 0, 0); } while (0)
#define PG8_LDA(dst, b, h) do { _Pragma("unroll") for (int m = 0; m < 4; ++m) _Pragma("unroll") for (int k = 0; k < 2; ++k) dst[m][k] = *(const PG8_LAS bf16x8*)(lds + PG8_SA(b, h) + aoff + m * 2048 + k * 1024); } while (0)
#define PG8_LDB(dst, b, h) do { _Pragma("unroll") for (int n = 0; n < 2; ++n) _Pragma("unroll") for (int k = 0; k < 2; ++k) dst[n][k] = *(const PG8_LAS bf16x8*)(lds + PG8_SB(b, h) + boff + n * 2048 + k * 1024); } while (0)
#define PG8_MMA(ai, bj, At, Bt) do { __builtin_amdgcn_s_setprio(1); _Pragma("unroll") for (int m = 0; m < 4; ++m) _Pragma("unroll") for (int n = 0; n < 2; ++n) _Pragma("unroll") for (int k = 0; k < 2; ++k) \
        acc[ai][bj][m][n] = __builtin_amdgcn_mfma_f32_16x16x32_bf16(Bt[n][k], At[m][k], acc[ai][bj][m][n], 0, 0, 0); __builtin_amdgcn_s_setprio(0); } while (0)
#define PG8_WAIT_V(n) asm volatile("s_waitcnt vmcnt(" #n ")" ::: "memory")
#define PG8_WAIT_L(n) asm volatile("s_waitcnt lgkmcnt(" #n ")" ::: "memory")
#define PG8_BAR __builtin_amdgcn_s_barrier()
#define PG8_SCHED __builtin_amdgcn_sched_barrier(0)
    Unit cur, nxt; int ui = 0;
    if (!S.next(0, cur)) return;
    f32x4 acc[2][2][4][2];
#pragma unroll
    for (int a = 0; a < 2; ++a)
#pragma unroll
        for (int b = 0; b < 2; ++b)
#pragma unroll
            for (int m = 0; m < 4; ++m)
#pragma unroll
                for (int n = 0; n < 2; ++n) acc[a][b][m][n] = (f32x4){0.f, 0.f, 0.f, 0.f};
    bf16x8 At[4][2], B0[2][2], B1[2][2];
    const char* cA = (const char*)g.A + (size_t)cur.pm * tstepA + (size_t)((cur.pn & g.amask) * g.astride) * 2; const char* cB = (const char*)g.Bt + (size_t)cur.pn * tstepB;
    S.a_ready(cur);
    PG8_STAGE(PG8_SB(0, 0), cB, voffB); PG8_STAGE(PG8_SA(0, 0), cA, voffA); PG8_STAGE(PG8_SB(0, 1), cB + hstepB, voffB); PG8_STAGE(PG8_SA(0, 1), cA + hstepA, voffA);
    if (wr == 1) PG8_BAR;
    PG8_WAIT_V(4); PG8_BAR;
    PG8_STAGE(PG8_SB(1, 0), cB + kstep, voffB); PG8_STAGE(PG8_SA(1, 0), cA + kstep, voffA); PG8_STAGE(PG8_SB(1, 1), cB + hstepB + kstep, voffB);
    PG8_WAIT_V(6); PG8_BAR;
    PG8_STAMP();
    for (;;) {
        const bool has_next = S.next(ui + 1, nxt);
        const char* nA = has_next ? (const char*)g.A + (size_t)nxt.pm * tstepA + (size_t)((nxt.pn & g.amask) * g.astride) * 2 : cA; const char* nB = has_next ? (const char*)g.Bt + (size_t)nxt.pn * tstepB : cB;
        for (int t = 0; t < nt; t += 2) {
            const bool last = (t == nt - 2);
            const char* a1 = cA + (size_t)(t + 1) * kstep;
            const char* a2 = last ? nA : cA + (size_t)(t + 2) * kstep; const char* b2 = last ? nB : cB + (size_t)(t + 2) * kstep;
            const char* a3 = a2 + kstep; const char* b3 = b2 + kstep;
            if (last && has_next) S.a_ready(nxt);
            PG8_LDB(B0, 0, 0); PG8_SCHED; PG8_LDA(At, 0, 0); PG8_STAGE(PG8_SA(1, 1), a1 + hstepA, voffA);
            PG8_WAIT_L(8); PG8_BAR; PG8_WAIT_L(0); PG8_MMA(0, 0, At, B0); PG8_BAR; PG8_SCHED;
            PG8_LDB(B1, 0, 1); PG8_STAGE(PG8_SB(0, 0), b2, voffB);
            PG8_BAR; PG8_WAIT_L(0); PG8_MMA(0, 1, At, B1); PG8_BAR;
            PG8_LDA(At, 0, 1); PG8_STAGE(PG8_SA(0, 0), a2, voffA);
            PG8_BAR; PG8_WAIT_L(0); PG8_MMA(1, 0, At, B0); PG8_BAR; PG8_SCHED;
            PG8_STAGE(PG8_SB(0, 1), b2 + hstepB, voffB);
            PG8_WAIT_V(6); PG8_BAR; PG8_MMA(1, 1, At, B1); PG8_BAR;
            PG8_LDB(B0, 1, 0); PG8_SCHED; PG8_LDA(At, 1, 0); PG8_STAGE(PG8_SA(0, 1), a2 + hstepA, voffA);
            PG8_WAIT_L(8); PG8_BAR; PG8_WAIT_L(0); PG8_MMA(0, 0, At, B0); PG8_BAR; PG8_SCHED;
            PG8_LDB(B1, 1, 1); PG8_STAGE(PG8_SB(1, 0), b3, voffB);
            PG8_BAR; PG8_WAIT_L(0); PG8_MMA(0, 1, At, B1); PG8_BAR;
            PG8_LDA(At, 1, 1); PG8_STAGE(PG8_SA(1, 0), a3, voffA);
            PG8_BAR; PG8_WAIT_L(0); PG8_MMA(1, 0, At, B0); PG8_BAR; PG8_SCHED;
            PG8_STAGE(PG8_SB(1, 1), b3 + hstepB, voffB);
            PG8_WAIT_V(6); PG8_BAR; PG8_MMA(1, 1, At, B1); PG8_BAR;
        }
        PG8_STAMP();
        if constexpr (!Epi::AFTER_DRAIN) { E(acc, cur, wr, wc, fr, fq); S.done(cur); }
        PG8_STAMP();
        if (!has_next) break;
#pragma unroll
        for (int a = 0; a < 2; ++a)
#pragma unroll
            for (int b = 0; b < 2; ++b)
#pragma unroll
                for (int m = 0; m < 4; ++m)
#pragma unroll
                    for (int n = 0; n < 2; ++n) acc[a][b][m][n] = (f32x4){0.f, 0.f, 0.f, 0.f};
        cur = nxt; cA = nA; cB = nB; ++ui;
    }
    PG8_WAIT_V(0);
    if (wr == 0) PG8_BAR;
    PG8_BAR;
    if constexpr (Epi::AFTER_DRAIN) { E.fused(acc, cur, wr, wc, fr, fq, lds, wid, lane); S.done(cur); }
    PG8_STAMP();
    if (STAMP && wid == 0) { stamps[lane] = lane < nts ? (((unsigned long long)(unsigned)ts_hi << 32) | (unsigned)ts_lo) : 0ull;
        if (lane == 62) stamps[62] = rt_entry; if (lane == 63) stamps[63] = (unsigned long long)wall_clock64(); }
#undef PG8_STAMP
#undef PG8_SA
#undef PG8_SB
#undef PG8_STAGE
#undef PG8_LDA
#undef PG8_LDB
#undef PG8_MMA
#undef PG8_WAIT_V
#undef PG8_WAIT_L
#undef PG8_BAR
#undef PG8_SCHED
}
}

using pg8::Gemm; using pg8::StaticOrder; using pg8::gemm_phase;

constexpr size_t MiB = 1u << 20;
constexpr size_t WS_CTL = 0, CTL_ZERO_BYTES = 1 * MiB;
constexpr int CW_BAR = 4096;
constexpr size_t GU_BYTES = (size_t)2 * FF * D * 2, DN_BYTES = (size_t)D * FF * 2, ABIN_BYTES = (size_t)AB_N * D * 2, SQ_BYTES = (size_t)D * D * 2, CIN_BYTES = (size_t)C_N * D * 2;
constexpr size_t CMP1_BYTES = (size_t)256 * 4096 * 2, WQK_BYTES = (size_t)2048 * 256 * 2;
constexpr size_t WS_WGU = 1 * MiB;
constexpr size_t WS_WD = WS_WGU + 8 * GU_BYTES;
constexpr size_t WS_WABIN = WS_WD + 8 * DN_BYTES;
constexpr size_t WS_WABOUT = WS_WABIN + 2 * ABIN_BYTES;
constexpr size_t WS_WCIN = WS_WABOUT + 2 * SQ_BYTES;
constexpr size_t WS_WCOUT = WS_WCIN + 2 * CIN_BYTES;
constexpr size_t WS_WCMP1 = WS_WCOUT + 2 * SQ_BYTES;
constexpr size_t WS_WQK = WS_WCMP1 + 4 * CMP1_BYTES;
constexpr int ROPE_ROWS = 8208;
constexpr size_t WS_ROPE = WS_WQK + 2 * WQK_BYTES;
constexpr size_t WS_CB = WS_ROPE + 5 * MiB;
constexpr size_t WS_WSK = WS_CB + 64 * 1024;
constexpr size_t WS_HN = WS_CB + 2 * MiB;
static_assert(WS_WSK + (size_t)4 * 64 * D * 2 <= WS_HN, "skinny weights");
constexpr size_t WS_ACT = WS_HN + 64 * MiB;
constexpr size_t WS_MIX = WS_ACT + 224 * MiB;
constexpr size_t MX_C = 0, MX_QK = 32 * MiB, MX_CST = 96 * MiB, MX_SST = 224 * MiB, MX_Y = 288 * MiB, MX_GIF = 352 * MiB, MX_NST = 353 * MiB, MX_SCL = 354 * MiB, MX_HDEC = 355 * MiB;
constexpr size_t MX_GP = 0, MX_HID = 4 * MiB, MX_KCMP = 8 * MiB, MX_VCMP = 9 * MiB, MX_O = 288 * MiB;
constexpr size_t WS_SSQP = WS_MIX + 356 * MiB;
constexpr size_t SSQP_V = (size_t)T * 32 * 4;
constexpr size_t WS_END = WS_SSQP + 28 * MiB;
static_assert(WS_ROPE + (size_t)ROPE_ROWS * 64 * 2 * 4 <= WS_CB, "rope table");

__device__ __forceinline__ float ssqp_rstd(const float* ssqp, int row) {
    const f32x4* p = (const f32x4*)(ssqp + (size_t)row * 32); float s = 0.f;
#pragma unroll
    for (int q = 0; q < 8; ++q) { const f32x4 v = p[q]; s += (v.x + v.y) + (v.z + v.w); }
    return __builtin_amdgcn_rsqf(s * (1.0f / 2048.0f) + 1e-6f);
}
constexpr int NWAVES = 8, NTHREADS = 512;
constexpr int LDS_BYTES = 147456;
constexpr int RING_BYTES = 131072, MISC_OFF = RING_BYTES + 320, RED_OFF = RING_BYTES + 1024;

struct Args { const float* in[31]; float* out; unsigned char* ws; int ph_lo, ph_hi; };
static_assert(sizeof(Args) == 31 * 8 + 8 + 8 + 8, "Args has no padding");

typedef const Args __attribute__((address_space(4)))* CArgsP;
struct Frame {
    LAS unsigned char* lds;
    int tid, lane, wave, G, bx, gw, NGW;
};
__device__ __forceinline__ Frame make_frame(unsigned char* lds_raw, int wave_s) {
    Frame F; int w = wave_s, bx = blockIdx.x, G = gridDim.x;
    asm volatile("" : "+s"(w)); asm volatile("" : "+s"(bx)); asm volatile("" : "+s"(G));
    int tid = w * 64 + lane_id(); asm volatile("" : "+v"(tid));
    F.lds = (LAS unsigned char*)lds_raw; F.tid = tid; F.lane = tid & 63; F.wave = w;
    F.G = G; F.bx = bx; F.gw = bx * NWAVES + F.wave; F.NGW = G * NWAVES;
    return F;
}
__device__ __forceinline__ CArgsP get_args() { CArgsP p = (CArgsP)__builtin_amdgcn_kernarg_segment_ptr(); asm volatile("" : "+s"(p)); return p; }
#define LDS_WAIT() asm volatile("s_waitcnt lgkmcnt(0)" ::: "memory")

struct Job { const float* src; int ldn, K, col0, ncols; bf16_t* dst; int dst_ld, row0, mode; float scale; const float* kgain; };
constexpr int NJOBS = 64;
__device__ __forceinline__ Job make_job(int j, CArgsP ap) {
    Job J; J.scale = 1.0f; J.row0 = 0; J.mode = 0; J.col0 = 0; J.kgain = nullptr;
    unsigned char* ws = ap->ws;
    if (j < 24) { const int f = j / 3, kind = j % 3, layer = f >> 1, half = f & 1;
        if (kind < 2) { J.src = ap->in[(half ? 7 : 2) + kind] + (size_t)layer * D * FF; J.ldn = FF; J.K = D; J.ncols = FF; J.dst = (bf16_t*)(ws + WS_WGU + (size_t)f * GU_BYTES); J.dst_ld = D; J.mode = 1 + kind; J.kgain = ap->in[half ? 6 : 1] + (size_t)layer * D; }
        else { J.src = ap->in[half ? 9 : 4] + (size_t)layer * FF * D; J.ldn = D; J.K = FF; J.ncols = D; J.dst = (bf16_t*)(ws + WS_WD + (size_t)f * DN_BYTES); J.dst_ld = FF; J.scale = 0.5f; }
    } else if (j < 38) { const int q = j - 24, l = q / 7, seg = q % 7;
        J.src = ap->in[10] + (size_t)l * D * AB_COLS; J.ldn = AB_COLS; J.K = D; J.col0 = seg < 3 ? seg * 1024 : 3080 + (seg - 3) * 1024; J.ncols = 1024;
        J.dst = (bf16_t*)(ws + WS_WABIN + (size_t)l * ABIN_BYTES); J.dst_ld = D; J.row0 = seg * 1024; J.kgain = ap->in[5] + (size_t)(2 * l) * D;
    } else if (j < 40) { const int l = j - 38; J.src = ap->in[11] + (size_t)l * D * D; J.ldn = D; J.K = D; J.ncols = D; J.dst = (bf16_t*)(ws + WS_WABOUT + (size_t)l * SQ_BYTES); J.dst_ld = D;
    } else if (j < 42) { const int l = j - 40; J.src = ap->in[22] + (size_t)l * D * C_COLS; J.ldn = C_COLS; J.K = D; J.ncols = C_N; J.dst = (bf16_t*)(ws + WS_WCIN + (size_t)l * CIN_BYTES); J.dst_ld = D; J.kgain = ap->in[5] + (size_t)(2 * l + 1) * D;
    } else if (j < 44) { const int l = j - 42; J.src = ap->in[23] + (size_t)l * D * D; J.ldn = D; J.K = D; J.ncols = D; J.dst = (bf16_t*)(ws + WS_WCOUT + (size_t)l * SQ_BYTES); J.dst_ld = D;
    } else if (j < 48) { const int q = j - 44; J.src = ap->in[27] + (size_t)q * 4096 * 256; J.ldn = 256; J.K = 4096; J.ncols = 256; J.dst = (bf16_t*)(ws + WS_WCMP1 + (size_t)q * CMP1_BYTES); J.dst_ld = 4096;
    } else { const int q = j - 48, l = q / 8, r = q % 8, isk = r / 4, hh = r % 4;
        J.src = ap->in[isk ? 15 : 14] + (size_t)(l * 4 + hh) * 65536; J.ldn = 256; J.K = 256; J.ncols = 256; J.dst = (bf16_t*)(ws + WS_WQK + (size_t)l * WQK_BYTES); J.dst_ld = 256; J.row0 = isk * 1024 + hh * 256; J.scale = isk ? 0.0625f : 1.0f; }
    return J;
}
__device__ __forceinline__ void transpose_item(const Job& J, LAS float* scr, int item, int lane) {
    const int nblk = J.ncols / 64, kb = item / nblk, nb = item % nblk, k0 = 64 * kb, n0 = 64 * nb;
    const float* W = J.src + J.col0 + n0 + 4 * (lane & 15);
    f32x4 wv[16];
#pragma unroll
    for (int i = 0; i < 16; ++i) { const int kk = 4 * i + (lane >> 4); wv[i] = __builtin_nontemporal_load((const f32x4*)(W + (size_t)(k0 + kk) * J.ldn)); }
#pragma unroll
    for (int i = 0; i < 16; ++i) { const int kk = 4 * i + (lane >> 4); *(LAS f32x4*)(scr + kk * 64 + (((lane & 15) ^ ((kk >> 3) & 7)) << 2)) = wv[i]; }
    LDS_WAIT();
    const int c = lane & 7;
    const int drow0 = J.mode == 0 ? J.row0 + n0 : (n0 >> 7) * 256 + (n0 & 127) + (J.mode == 2 ? 128 : 0);
    const float sc = J.scale;
    f32x4 g0 = (f32x4){sc, sc, sc, sc}, g1 = g0;
    if (J.kgain) { g0 = *(const f32x4*)(J.kgain + k0 + 8 * c) * sc; g1 = *(const f32x4*)(J.kgain + k0 + 8 * c + 4) * sc; }
#pragma unroll
    for (int jj = 0; jj < 8; ++jj) { const int n = (lane >> 3) + 8 * jj; const LAS float* s = scr + (8 * c) * 64 + ((((n >> 2) ^ c) << 2) | (n & 3));
        v4u o; o.x = pk2(s[0 * 64] * g0.x, s[1 * 64] * g0.y); o.y = pk2(s[2 * 64] * g0.z, s[3 * 64] * g0.w); o.z = pk2(s[4 * 64] * g1.x, s[5 * 64] * g1.y); o.w = pk2(s[6 * 64] * g1.z, s[7 * 64] * g1.w);
        __builtin_nontemporal_store(o, (v4u*)(J.dst + (size_t)(drow0 + n) * J.dst_ld + k0 + 8 * c)); }
    LDS_WAIT();
}
__device__ __forceinline__ void ph_prologue(Frame& F, CArgsP ap) {
    LAS float* scr = (LAS float*)(F.lds + F.wave * 16384);
    for (int j = 0; j < NJOBS; ++j) {
        const Job J = make_job(j, ap);
        const int nitems = (J.K / 64) * (J.ncols / 64);
        for (int it = F.gw; it < nitems; it += F.NGW) transpose_item(J, scr, it, F.lane);
    }
    float* rope = (float*)(ap->ws + WS_ROPE);
    for (int idx = F.bx * NTHREADS + F.tid; idx < ROPE_ROWS * 64; idx += F.G * NTHREADS) {
        const int p = idx >> 6, i = idx & 63;
        const float inv = powf(10000.0f, -(float)i / 64.0f), ang = (float)p * inv;
        float sn, cs; sincosf(ang, &sn, &cs);
        rope[2 * idx] = cs; rope[2 * idx + 1] = sn;
    }
    float* cb = (float*)(ap->ws + WS_CB);
    for (int idx = F.gw; idx < 4 * 256; idx += F.NGW) {
        const int q = idx >> 8, c = idx & 255;
        const float* pos = ap->in[26] + (size_t)q * 4096; const float* w1 = ap->in[27] + (size_t)q * 4096 * 256 + c;
        float s = 0.f;
#pragma unroll 16
        for (int f = F.lane; f < 4096; f += 64) s += pos[f] * w1[(size_t)f * 256];
        s = wave_sum(s);
        if (F.lane == 0) cb[idx] = s + ap->in[28][idx];
    }
    { bf16_t* wsk = (bf16_t*)(ap->ws + WS_WSK);
      for (int idx = F.bx * NTHREADS + F.tid; idx < 4 * 64 * D; idx += F.G * NTHREADS) {
          const int q = idx / (64 * D), r = idx - q * 64 * D, n = r / D, k = r - n * D;
          const float* src = q < 2 ? ap->in[10] + (size_t)q * D * AB_COLS + (size_t)k * AB_COLS + 3072 : ap->in[22] + (size_t)(q - 2) * D * C_COLS + (size_t)k * C_COLS + 5120;
          const int nj = q < 2 ? 8 : 48;
          const float gk = ap->in[5][(size_t)(q < 2 ? 2 * q : 2 * (q - 2) + 1) * D + k];
          wsk[idx] = n < nj ? (bf16_t)f2bf(src[n] * gk) : (bf16_t)0; } }
    { bf16_t* HB = (bf16_t*)(ap->ws + WS_HN); float* ssq0 = (float*)(ap->ws + WS_SSQP);
      for (int row = F.gw; row < T; row += F.NGW) {
          const f32x4* xr = (const f32x4*)(ap->in[0] + (size_t)row * D) + F.lane; v2u* o8 = (v2u*)(HB + (size_t)row * D) + F.lane;
          float s = 0.f;
#pragma unroll
          for (int j = 0; j < 8; ++j) { const f32x4 v = __builtin_nontemporal_load(xr + 64 * j); v2u o; o.x = pk2(v.x, v.y); o.y = pk2(v.z, v.w); o8[64 * j] = o; s += (v.x * v.x + v.y * v.y) + (v.z * v.z + v.w * v.w); }
          s = wave_sum(s);
          if (F.lane < 32) ssq0[(size_t)row * 32 + F.lane] = F.lane == 0 ? s : 0.f; } }
}

template <int NJ>
__device__ __forceinline__ void ph_skinny(Frame& F, const bf16_t* HB, const float* ssqp, const bf16_t* Wsk, float* outp) {
    for (int blk = F.bx; blk < T / 64; blk += F.G) {
        const int lane = F.lane, l15 = lane & 15, quad = lane >> 4, mt = F.wave >> 1, nt0 = (F.wave & 1) * 2;
        const bf16_t* ap_ = HB + (size_t)(blk * 64 + mt * 16 + l15) * D + 8 * quad;
        const bf16_t* b0p = Wsk + (size_t)(nt0 * 16 + l15) * D + 8 * quad; const bf16_t* b1p = b0p + (size_t)16 * D;
        f32x4 a0 = (f32x4){0.f, 0.f, 0.f, 0.f}, a1 = (f32x4){0.f, 0.f, 0.f, 0.f};
        const bool t0on = nt0 * 16 < NJ, t1on = (nt0 + 1) * 16 < NJ;
        if (t0on && t1on) {
#pragma unroll 8
            for (int ks = 0; ks < D / 32; ++ks) { const bf16x8 a = *(const bf16x8*)(ap_ + 32 * ks), b0 = *(const bf16x8*)(b0p + 32 * ks), b1 = *(const bf16x8*)(b1p + 32 * ks);
                a0 = __builtin_amdgcn_mfma_f32_16x16x32_bf16(a, b0, a0, 0, 0, 0); a1 = __builtin_amdgcn_mfma_f32_16x16x32_bf16(a, b1, a1, 0, 0, 0); }
        } else if (t0on) {
#pragma unroll 8
            for (int ks = 0; ks < D / 32; ++ks) { const bf16x8 a = *(const bf16x8*)(ap_ + 32 * ks), b0 = *(const bf16x8*)(b0p + 32 * ks);
                a0 = __builtin_amdgcn_mfma_f32_16x16x32_bf16(a, b0, a0, 0, 0, 0); }
        }
#pragma unroll
        for (int e = 0; e < 4; ++e) { const int row = blk * 64 + mt * 16 + 4 * quad + e; const int c0 = nt0 * 16 + l15, c1 = c0 + 16;
            const float rs = ssqp_rstd(ssqp, row);
            if (c0 < NJ) outp[(size_t)row * NJ + c0] = a0[e] * rs; if (c1 < NJ) outp[(size_t)row * NJ + c1] = a1[e] * rs; }
    }
}

__device__ __forceinline__ void panel_rstd(Frame& F, const float* ssqp, int pm, LAS float* rsl) {
    const int row = pm * 256 + (F.tid >> 1); const f32x4* p = (const f32x4*)(ssqp + (size_t)row * 32 + (F.tid & 1) * 16); float s = 0.f;
#pragma unroll
    for (int q = 0; q < 4; ++q) { const f32x4 v = p[q]; s += (v.x + v.y) + (v.z + v.w); }
    const float o = DPP_F(s, 0xB1);
    const float t = (F.tid & 1) ? o + s : s + o;
    if ((F.tid & 1) == 0) rsl[F.tid >> 1] = __builtin_amdgcn_rsqf(t * (1.0f / 2048.0f) + 1e-6f);
    __syncthreads();
}

__device__ __forceinline__ void unpack8(const v4u u, float (&f)[8]) { f[0] = bflo(u.x); f[1] = bfhi(u.x); f[2] = bflo(u.y); f[3] = bfhi(u.y); f[4] = bflo(u.z); f[5] = bfhi(u.z); f[6] = bflo(u.w); f[7] = bfhi(u.w); }
__device__ __forceinline__ void ph_conv(Frame& F, const bf16_t* P, const float* cw, const float* cbias, bf16_t* cbuf) {
    const int idx0 = F.bx * NTHREADS + F.tid, c0 = (idx0 & 127) * 8, stride = F.G * NTHREADS;
    if ((stride & 127) != 0) {
        for (int idx = idx0; idx < T * 128; idx += stride) { const int t = idx >> 7, cc = (idx & 127) * 8, tl = t & (SEQ - 1); float acc[8];
#pragma unroll
            for (int e = 0; e < 8; ++e) acc[e] = cbias[cc + e];
#pragma unroll
            for (int jj = 0; jj < 4; ++jj) { if (tl - 3 + jj >= 0) { float uf[8]; unpack8(*(const v4u*)(P + (size_t)(t - 3 + jj) * AB_N + cc), uf);
#pragma unroll
                    for (int e = 0; e < 8; ++e) acc[e] += uf[e] * cw[jj * 1024 + cc + e]; } }
            v4u o; o.x = pk2(siluf_(acc[0]), siluf_(acc[1])); o.y = pk2(siluf_(acc[2]), siluf_(acc[3])); o.z = pk2(siluf_(acc[4]), siluf_(acc[5])); o.w = pk2(siluf_(acc[6]), siluf_(acc[7]));
            *(v4u*)(cbuf + (size_t)t * 1024 + cc) = o; }
        return; }
    float wt[4][8], bs[8];
#pragma unroll
    for (int e = 0; e < 8; ++e) { bs[e] = cbias[c0 + e];
#pragma unroll
        for (int jj = 0; jj < 4; ++jj) wt[jj][e] = cw[jj * 1024 + c0 + e]; }
    const int tstride = stride >> 7;
    for (int t0 = idx0 >> 7; t0 < T; t0 += 4 * tstride) {
        v4u in[4][4];
#pragma unroll
        for (int u = 0; u < 4; ++u) { const int t = t0 + u * tstride, tl = t & (SEQ - 1);
#pragma unroll
            for (int jj = 0; jj < 4; ++jj) { in[u][jj] = (v4u){0u, 0u, 0u, 0u}; if (t < T && tl - 3 + jj >= 0) in[u][jj] = *(const v4u*)(P + (size_t)(t - 3 + jj) * AB_N + c0); } }
#pragma unroll
        for (int u = 0; u < 4; ++u) { const int t = t0 + u * tstride;
            if (t < T) { float acc[8];
#pragma unroll
                for (int e = 0; e < 8; ++e) acc[e] = bs[e];
#pragma unroll
                for (int jj = 0; jj < 4; ++jj) { float uf[8]; unpack8(in[u][jj], uf);
#pragma unroll
                    for (int e = 0; e < 8; ++e) acc[e] += uf[e] * wt[jj][e]; }
                v4u o; o.x = pk2(siluf_(acc[0]), siluf_(acc[1])); o.y = pk2(siluf_(acc[2]), siluf_(acc[3])); o.z = pk2(siluf_(acc[4]), siluf_(acc[5])); o.w = pk2(siluf_(acc[6]), siluf_(acc[7]));
                *(v4u*)(cbuf + (size_t)t * 1024 + c0) = o; } }
    }
}

#ifndef CK_DUP_ML3
#define CK_DUP_ML3 0
#endif
#ifndef CK_DUP_HG3
#define CK_DUP_HG3 0
#endif
namespace ck {
typedef short s16x4 __attribute__((ext_vector_type(4)));
constexpr int CL = 64;
constexpr int NCH = SEQ / CL;
constexpr int NU_ML = BATCH * 4 * NCH, NU_HG = BATCH * 8 * NCH;
__device__ __forceinline__ bf16x8 frag_rowk(const LAS bf16_t* base, int pitch, int r0, int k0, int lane) { return *(const LAS bf16x8*)(base + (r0 + (lane & 15)) * pitch + k0 + 8 * (lane >> 4)); }
__device__ __forceinline__ bf16x8 frag_rowk_g(const bf16_t* base, int ld, int r0, int k0, int lane) { return *(const bf16x8*)(base + (size_t)(r0 + (lane & 15)) * ld + k0 + 8 * (lane >> 4)); }
__device__ __forceinline__ bf16x8 frag_tr(const LAS bf16_t* base, int pitch, int k0, int c0, int lane) {
    const int i = lane & 15, quad = lane >> 4;
    const unsigned a0 = (unsigned)(uintptr_t)(base + (k0 + 8 * quad + (i >> 2)) * pitch + c0 + 4 * (i & 3));
    s16x4 lo, hi;
    asm volatile("ds_read_b64_tr_b16 %0, %1" : "=&v"(lo) : "v"(a0) : "memory");
    asm volatile("ds_read_b64_tr_b16 %0, %1" : "=&v"(hi) : "v"(a0 + (unsigned)(4 * pitch * 2)) : "memory");
    asm volatile("s_waitcnt lgkmcnt(0)" : "+v"(lo), "+v"(hi) :: "memory");
    return (bf16x8){lo[0], lo[1], lo[2], lo[3], hi[0], hi[1], hi[2], hi[3]};
}
#define MMA16(a, b, c) __builtin_amdgcn_mfma_f32_16x16x32_bf16((a), (b), (c), 0, 0, 0)
__device__ __forceinline__ float log_sig(float x) { return fminf(x, 0.f) - log1pf(expf(-fabsf(x))); }
__device__ __forceinline__ void hg_gate(float z, float one_minus_lb, float& k2, float& lf) {
    const float e = __expf(-fabsf(z)), r = __builtin_amdgcn_rcpf(1.0f + e), sp = __logf(1.0f + e);
    k2 = one_minus_lb * (z >= 0.f ? e * r : r);
    const float t = fminf(k2, 0.999999f);
    const float la = t < 0.0625f ? -t * (1.0f + t * (0.5f + t * (0.33333334f + t * 0.25f))) : __logf(1.0f - t);
    lf = fmaxf(la, fminf(z, 0.f) - sp);
}
__device__ __forceinline__ float wave_scan_add(float x, LAS float* sc, int lane) {
#pragma unroll
    for (int o = 1; o < 64; o <<= 1) { sc[lane] = x; asm volatile("s_waitcnt lgkmcnt(0)" ::: "memory"); const float y = sc[lane >= o ? lane - o : lane]; asm volatile("s_waitcnt lgkmcnt(0)" ::: "memory"); x += lane >= o ? y : 0.f; }
    return x;
}
__device__ __forceinline__ float wave_scan_max(float x, LAS float* sc, int lane) {
#pragma unroll
    for (int o = 1; o < 64; o <<= 1) { sc[lane] = x; asm volatile("s_waitcnt lgkmcnt(0)" ::: "memory"); const float y = sc[lane >= o ? lane - o : lane]; asm volatile("s_waitcnt lgkmcnt(0)" ::: "memory"); x = lane >= o ? fmaxf(x, y) : x; }
    return x;
}
}

__device__ __forceinline__ void ph_chunk_r1(Frame& F, const bf16_t* P, const bf16_t* QK, const float* gif, const float* i_bias, const float* f_bias, const float* lb_logits, int jpair,
                                            bf16_t* CST, float* NST, float* SCL  , bf16_t* SST, float* HDEC) {
    using namespace ck;
    LAS unsigned char* lds = F.lds;
    for (int u = F.bx; u < NU_ML + NU_HG; u += F.G) {
        int tid = F.tid; asm volatile("" : "+v"(tid));
        const int lane = tid & 63, w = __builtin_amdgcn_readfirstlane(tid >> 6);
        if (u < NU_ML) {
            const int bh = u / NCH, j = u - bh * NCH, b = bh >> 2, hh = bh & 3, t0 = b * SEQ + j * CL;
            constexpr int PT = 264;
            LAS bf16_t* Vs = (LAS bf16_t*)lds;
            LAS bf16_t* Ks = Vs + 64 * PT;
            LAS float* av = (LAS float*)(Ks + 64 * PT);
            v4u kq[4], vq[4];
            { const int s = tid >> 3, c0 = (tid & 7) * 32;
              const bf16_t* kp = QK + (size_t)(t0 + s) * 2048 + 1024 + hh * 256 + c0; const bf16_t* vp = P + (size_t)(t0 + s) * AB_N + 1024 + hh * 256 + c0;
#pragma unroll
              for (int q = 0; q < 4; ++q) { kq[q] = *(const v4u*)(kp + 8 * q); vq[q] = *(const v4u*)(vp + 8 * q); } }
            if (w == 0) {
                const float ig = gif[(size_t)(t0 + lane) * 8 + hh] + i_bias[hh];
                const float lf = log_sig(gif[(size_t)(t0 + lane) * 8 + 4 + hh] + f_bias[hh]);
                const float bsum = wave_scan_add(lf, av, lane);
                av[lane] = bsum; LDS_WAIT(); const float g = av[63]; LDS_WAIT();
                const float upd = g - bsum + ig, mloc = wave_max(upd);
                av[lane] = expf(upd - mloc);
                if (lane == 0) { SCL[u * 4 + 0] = g; SCL[u * 4 + 1] = mloc; }
            }
            __syncthreads();
            { const int s = tid >> 3, c0 = (tid & 7) * 32; const float a = av[s];
#pragma unroll
              for (int q = 0; q < 4; ++q) { *(LAS v4u*)(Ks + s * PT + c0 + 8 * q) = kq[q];
                  float f[8]; unpack8(vq[q], f); v4u o; o.x = pk2(f[0] * a, f[1] * a); o.y = pk2(f[2] * a, f[3] * a); o.z = pk2(f[4] * a, f[5] * a); o.w = pk2(f[6] * a, f[7] * a);
                  *(LAS v4u*)(Vs + s * PT + c0 + 8 * q) = o; } }
            __syncthreads();
            if (tid < 256) { float s = 0.f;
                for (int ss = 0; ss < 64; ++ss) s += av[ss] * bf2f(Ks[ss * PT + tid]);
                NST[(size_t)u * 256 + tid] = s; }
            f32x4 acc[16][2];
#pragma unroll
            for (int m = 0; m < 16; ++m) { acc[m][0] = (f32x4){0.f, 0.f, 0.f, 0.f}; acc[m][1] = (f32x4){0.f, 0.f, 0.f, 0.f}; }
#pragma unroll
            for (int ks = 0; ks < 2; ++ks) {
                const bf16x8 b0 = frag_tr(Vs, PT, 32 * ks, 32 * w, lane), b1 = frag_tr(Vs, PT, 32 * ks, 32 * w + 16, lane);
#pragma unroll
                for (int m = 0; m < 16; ++m) { const bf16x8 a = frag_tr(Ks, PT, 32 * ks, 16 * m, lane); acc[m][0] = MMA16(a, b0, acc[m][0]); acc[m][1] = MMA16(a, b1, acc[m][1]); }
            }
            { char* cp = (char*)(CST + (size_t)u * 65536 + (size_t)(32 * w) * 256);
              const unsigned lo0 = (unsigned)(((lane & 15) * 256 + 4 * (lane >> 4)) * 2);
#pragma unroll
              for (int m = 0; m < 16; ++m)
#pragma unroll
                  for (int n = 0; n < 2; ++n) { v2u o; o.x = pk2(acc[m][n][0], acc[m][n][1]); o.y = pk2(acc[m][n][2], acc[m][n][3]); *(v2u*)(cp + (lo0 + (unsigned)((16 * n * 256 + 16 * m) * 2))) = o; } }
            __syncthreads();
        } else {
            const int uu = u - NU_ML, bh = uu / NCH, j = uu - bh * NCH, b = bh >> 3, hh = bh & 7, t0 = b * SEQ + j * CL;
            constexpr int PT = 136;
            LAS float* bS = (LAS float*)lds;
            LAS bf16_t* Kt = (LAS bf16_t*)(bS + 64 * 128);
            LAS bf16_t* Vt = Kt + 64 * PT;
            float k2r[16];
            { const int s = tid >> 3, c0 = (tid & 7) * 16; const bf16_t* pp = P + (size_t)(t0 + s) * AB_N + hh * 128 + c0;
#pragma unroll
              for (int q = 0; q < 2; ++q) { float hf[8]; unpack8(*(const v4u*)(pp + 4096 + 8 * q), hf);
                  *(LAS v4u*)(Vt + s * PT + c0 + 8 * q) = *(const v4u*)(pp + 5120 + 8 * q);
#pragma unroll
                  for (int e = 0; e < 8; ++e) { const int cg = hh * 128 + c0 + 8 * q + e;
                      const float oml = jpair == 0 ? 1.0f : 1.0f - sigmoidf_(lb_logits[1024 + cg] - lb_logits[cg]);
                      float k2, lf; hg_gate(hf[e], oml, k2, lf);
                      k2r[8 * q + e] = k2; bS[s * 128 + c0 + 8 * q + e] = lf; } } }
            __syncthreads();
            { const int c = tid & 127, p = tid >> 7; LAS float* tot = (LAS float*)(Vt + 64 * PT);
              float acc = 0.f;
#pragma unroll
              for (int s = 0; s < 16; ++s) { acc += bS[(16 * p + s) * 128 + c]; bS[(16 * p + s) * 128 + c] = acc; }
              tot[p * 128 + c] = acc;
              __syncthreads();
              float off = 0.f;
#pragma unroll
              for (int pp = 0; pp < 3; ++pp) off += pp < p ? tot[pp * 128 + c] : 0.f;
              if (p > 0) {
#pragma unroll
                  for (int s = 0; s < 16; ++s) bS[(16 * p + s) * 128 + c] += off; }
              if (p == 3) HDEC[(size_t)uu * 128 + c] = __expf(off + acc); }
            __syncthreads();
            { const int s = tid >> 3, c0 = (tid & 7) * 16;
#pragma unroll
              for (int q = 0; q < 2; ++q) { float r[8];
#pragma unroll
                  for (int e = 0; e < 8; ++e) { const int c = c0 + 8 * q + e; r[e] = k2r[8 * q + e] * __expf(bS[63 * 128 + c] - bS[s * 128 + c]); }
                  v4u o; o.x = pk2(r[0], r[1]); o.y = pk2(r[2], r[3]); o.z = pk2(r[4], r[5]); o.w = pk2(r[6], r[7]); *(LAS v4u*)(Kt + s * PT + c0 + 8 * q) = o; } }
            __syncthreads();
            f32x4 acc[8];
#pragma unroll
            for (int m = 0; m < 8; ++m) acc[m] = (f32x4){0.f, 0.f, 0.f, 0.f};
#pragma unroll
            for (int ks = 0; ks < 2; ++ks) { const bf16x8 bb = frag_tr(Vt, PT, 32 * ks, 16 * w, lane);
#pragma unroll
                for (int m = 0; m < 8; ++m) { const bf16x8 a = frag_tr(Kt, PT, 32 * ks, 16 * m, lane); acc[m] = MMA16(a, bb, acc[m]); } }
            { char* sp = (char*)(SST + (size_t)uu * 16384 + (size_t)(16 * w) * 128);
              const unsigned lo0 = (unsigned)(((lane & 15) * 128 + 4 * (lane >> 4)) * 2);
#pragma unroll
              for (int m = 0; m < 8; ++m) { v2u o; o.x = pk2(acc[m][0], acc[m][1]); o.y = pk2(acc[m][2], acc[m][3]); *(v2u*)(sp + (lo0 + (unsigned)(16 * m * 2))) = o; } }
            __syncthreads();
        }
    }
}

__device__ __forceinline__ void ph_chunk_r2(Frame& F, bf16_t* CST, float* NST, float* SCL, bf16_t* SST, const float* HDEC) {
    using namespace ck;
    for (int vb = F.bx; vb < 200; vb += F.G) {
    const int gt = vb * NTHREADS + F.tid;
    if (gt < 65536) {
        const int bh = gt >> 13; const size_t e8 = (size_t)(gt & 8191) * 8;
        float C[8]; float m = 0.f;
#pragma unroll
        for (int e = 0; e < 8; ++e) C[e] = 0.f;
        bf16_t* base = CST + (size_t)bh * NCH * 65536 + e8;
        for (int j0 = 0; j0 < NCH; j0 += 4) {
            v4u d[4]; float gg[4], ml[4];
#pragma unroll
            for (int q = 0; q < 4; ++q) { d[q] = *(const v4u*)(base + (size_t)(j0 + q) * 65536); gg[q] = SCL[(bh * NCH + j0 + q) * 4 + 0]; ml[q] = SCL[(bh * NCH + j0 + q) * 4 + 1]; }
#pragma unroll
            for (int q = 0; q < 4; ++q) {
                v4u o; o.x = pk2(C[0], C[1]); o.y = pk2(C[2], C[3]); o.z = pk2(C[4], C[5]); o.w = pk2(C[6], C[7]);
                *(v4u*)(base + (size_t)(j0 + q) * 65536) = o;
                if ((gt & 8191) == 0) SCL[(bh * NCH + j0 + q) * 4 + 2] = m;
                const float mn = fmaxf(gg[q] + m, ml[q]), a = __expf(gg[q] + m - mn), bc = __expf(ml[q] - mn);
                float f[8]; unpack8(d[q], f);
#pragma unroll
                for (int e = 0; e < 8; ++e) C[e] = a * C[e] + bc * f[e];
                m = mn; }
        }
    } else if (gt < 65536 + 2048) {
        const int idx = gt - 65536, bh = idx >> 8, k = idx & 255; float n = 0.f, m = 0.f;
        for (int j = 0; j < NCH; ++j) { const int u = bh * NCH + j; const float d = NST[(size_t)u * 256 + k], gg = SCL[u * 4 + 0], ml = SCL[u * 4 + 1];
            NST[(size_t)u * 256 + k] = n;
            const float mn = fmaxf(gg + m, ml); n = __expf(gg + m - mn) * n + __expf(ml - mn) * d; m = mn; }
    } else if (gt >= 136 * NTHREADS && gt < 136 * NTHREADS + 32768) {
        const int i = gt - 136 * NTHREADS, bh = i >> 11; const size_t e8 = (size_t)(i & 2047) * 8; const int c0 = (int)(e8 & 127);
        float S[8];
#pragma unroll
        for (int e = 0; e < 8; ++e) S[e] = 0.f;
        bf16_t* base = SST + (size_t)bh * NCH * 16384 + e8; const float* hd = HDEC + (size_t)bh * NCH * 128 + c0;
        for (int j0 = 0; j0 < NCH; j0 += 4) {
            v4u d[4]; f32x4 da[4], db[4];
#pragma unroll
            for (int q = 0; q < 4; ++q) { d[q] = *(const v4u*)(base + (size_t)(j0 + q) * 16384); da[q] = *(const f32x4*)(hd + (size_t)(j0 + q) * 128); db[q] = *(const f32x4*)(hd + (size_t)(j0 + q) * 128 + 4); }
#pragma unroll
            for (int q = 0; q < 4; ++q) {
                v4u o; o.x = pk2(S[0], S[1]); o.y = pk2(S[2], S[3]); o.z = pk2(S[4], S[5]); o.w = pk2(S[6], S[7]);
                *(v4u*)(base + (size_t)(j0 + q) * 16384) = o;
                float f[8]; unpack8(d[q], f);
#pragma unroll
                for (int e = 0; e < 4; ++e) { S[e] = da[q][e] * S[e] + f[e]; S[4 + e] = db[q][e] * S[4 + e] + f[4 + e]; } }
        }
    }
    }
}

__device__ __forceinline__ void ph_chunk_r3(Frame& F, const bf16_t* P, const bf16_t* QK, const bf16_t* cbuf, const float* gif, const float* i_bias, const float* f_bias, const float* lb_logits, int jpair,
                                            const bf16_t* CST, const float* NST, const float* SCL, const bf16_t* SST,
                                            const float* ml_norm, const float* ml_skip, const float* hg_norm, bf16_t* Y) {
    using namespace ck;
    LAS unsigned char* lds = F.lds;
    for (int u = F.bx; u < NU_ML + NU_HG; u += F.G) {
        int tid = F.tid; asm volatile("" : "+v"(tid));
        const int lane = tid & 63, w = __builtin_amdgcn_readfirstlane(tid >> 6), quad = lane >> 4, l15 = lane & 15;
        if (u < NU_ML) { for (int rep_ = 0; rep_ < 1 + CK_DUP_ML3; ++rep_) {
            const int bh = u / NCH, j = u - bh * NCH, b = bh >> 2, hh = bh & 3, t0 = b * SEQ + j * CL;
            constexpr int PT = 264, PW = 72;
            LAS bf16_t* Qs = (LAS bf16_t*)lds; LAS bf16_t* Ks = Qs + 64 * PT; LAS bf16_t* Vs = Ks + 64 * PT; LAS bf16_t* Ws = Vs + 64 * PT;
            LAS float* vec = (LAS float*)(Ws + 64 * PW);
            LAS float* bv = vec, *uv = vec + 64, *rv = vec + 128, *wl = vec + 192, *emt = vec + 256, *qnv = vec + 320, *tmp = vec + 384, *rstd = vec + 448, *part = vec + 512;
            const float mj = SCL[u * 4 + 2];
            bf16x8 cfr[8][2];
            { const bf16_t* Cj = CST + (size_t)u * 65536;
#pragma unroll
              for (int ks = 0; ks < 8; ++ks) { cfr[ks][0] = frag_rowk_g(Cj, 256, 32 * w, 32 * ks, lane); cfr[ks][1] = frag_rowk_g(Cj, 256, 32 * w + 16, 32 * ks, lane); } }
            LAS float* nsl = part + 512;
            if (tid < 64) *(LAS f32x4*)(nsl + 4 * tid) = *(const f32x4*)(NST + (size_t)u * 256 + 4 * tid);
            float ig_raw = 0.f, fg_raw = 0.f;
            if (w == 0) { ig_raw = gif[(size_t)(t0 + lane) * 8 + hh]; fg_raw = gif[(size_t)(t0 + lane) * 8 + 4 + hh]; }
            { const int s = tid >> 3, c0 = (tid & 7) * 32;
              const bf16_t* qp = QK + (size_t)(t0 + s) * 2048 + hh * 256 + c0; const bf16_t* vp = P + (size_t)(t0 + s) * AB_N + 1024 + hh * 256 + c0;
#pragma unroll
              for (int q = 0; q < 4; ++q) { *(LAS v4u*)(Qs + s * PT + c0 + 8 * q) = *(const v4u*)(qp + 8 * q); *(LAS v4u*)(Ks + s * PT + c0 + 8 * q) = *(const v4u*)(qp + 1024 + 8 * q);
                  *(LAS v4u*)(Vs + s * PT + c0 + 8 * q) = *(const v4u*)(vp + 8 * q); }
              { unsigned z0 = 0u; asm volatile("" : "+v"(z0)); *(LAS v4u*)(Ws + s * PW + (tid & 7) * 8) = (v4u){z0, z0, z0, z0}; } }
            if (w == 0) {
                const float ig = ig_raw + i_bias[hh];
                const float lf = log_sig(fg_raw + f_bias[hh]);
                const float bsum = wave_scan_add(lf, tmp, lane);
                const float uu = ig - bsum;
                const float cm = wave_scan_max(uu, tmp, lane);
                const float r = -fmaxf(mj, cm);
                bv[lane] = bsum; uv[lane] = uu; rv[lane] = r; wl[lane] = expf(mj + r); emt[lane] = expf(r - bsum);
            }
            __syncthreads();
            { const int l = tid >> 3, k0 = (tid & 7) * 32; float acc = 0.f;
#pragma unroll 8
              for (int k = 0; k < 32; ++k) acc += nsl[k0 + k] * bf2f(Qs[l * PT + k0 + k]);
              acc += DPP_F(acc, 0xB1); acc += DPP_F(acc, 0x4E); acc += DPP_F(acc, 0x141);
              if ((tid & 7) == 0) qnv[l] = acc; }
            for (int ti = w; ti < 10; ti += 8) {
                const int lt = ti < 1 ? 0 : ti < 3 ? 1 : ti < 6 ? 2 : 3, st = ti - (lt * (lt + 1)) / 2;
                f32x4 acc = (f32x4){0.f, 0.f, 0.f, 0.f};
#pragma unroll
                for (int ks = 0; ks < 8; ++ks) acc = MMA16(frag_rowk(Ks, PT, 16 * st, 32 * ks, lane), frag_rowk(Qs, PT, 16 * lt, 32 * ks, lane), acc);
                const int l = 16 * lt + l15, s0 = 16 * st + 4 * quad; const float rl = rv[l]; float wv[4];
#pragma unroll
                for (int e = 0; e < 4; ++e) wv[e] = (s0 + e <= l) ? acc[e] * __expf(rl + uv[s0 + e]) : 0.f;
                v2u o; o.x = pk2(wv[0], wv[1]); o.y = pk2(wv[2], wv[3]); *(LAS v2u*)(Ws + l * PW + s0) = o;
            }
            __syncthreads();
            f32x4 ai[4][2], ax[4][2], ad[4];
#pragma unroll
            for (int m = 0; m < 4; ++m) { ad[m] = (f32x4){0.f, 0.f, 0.f, 0.f};
#pragma unroll
                for (int n = 0; n < 2; ++n) { ai[m][n] = (f32x4){0.f, 0.f, 0.f, 0.f}; ax[m][n] = (f32x4){0.f, 0.f, 0.f, 0.f}; } }
            { unsigned o1 = 0x3F803F80u; asm volatile("" : "+v"(o1)); const v4u ow = {o1, o1, o1, o1}; const bf16x8 ones = __builtin_bit_cast(bf16x8, ow);
#pragma unroll
              for (int ks = 0; ks < 2; ++ks) { const bf16x8 b0 = frag_tr(Vs, PT, 32 * ks, 32 * w, lane), b1 = frag_tr(Vs, PT, 32 * ks, 32 * w + 16, lane);
#pragma unroll
                  for (int m = 0; m < 4; ++m) { const bf16x8 a = frag_rowk(Ws, PW, 16 * m, 32 * ks, lane); ai[m][0] = MMA16(a, b0, ai[m][0]); ai[m][1] = MMA16(a, b1, ai[m][1]); ad[m] = MMA16(a, ones, ad[m]); } } }
            {
#pragma unroll
              for (int ks = 0; ks < 8; ++ks) { const bf16x8 b0 = cfr[ks][0], b1 = cfr[ks][1];
#pragma unroll
                  for (int m = 0; m < 4; ++m) { const bf16x8 a = frag_rowk(Qs, PT, 16 * m, 32 * ks, lane); ax[m][0] = MMA16(a, b0, ax[m][0]); ax[m][1] = MMA16(a, b1, ax[m][1]); } } }
            v4u gcc[4], gop[4];
            { const int l = tid >> 3, v0 = (tid & 7) * 32; const size_t tk = (size_t)(t0 + l); const int col0 = hh * 256 + v0;
#pragma unroll
              for (int q = 0; q < 4; ++q) { gcc[q] = *(const v4u*)(cbuf + tk * 1024 + col0 + 8 * q); gop[q] = *(const v4u*)(P + tk * AB_N + 2048 + col0 + 8 * q); } }
            float hv[4][2][4];
#pragma unroll
            for (int m = 0; m < 4; ++m)
#pragma unroll
                for (int e = 0; e < 4; ++e) { const int l = 16 * m + 4 * quad + e; const float wi = wl[l], den = fmaxf(fabsf(ad[m][e] + wi * qnv[l]), emt[l]), inv = __builtin_amdgcn_rcpf(den);
                    hv[m][0][e] = (ai[m][0][e] + wi * ax[m][0][e]) * inv; hv[m][1][e] = (ai[m][1][e] + wi * ax[m][1][e]) * inv;
                    const float ss = row16_sum(hv[m][0][e] * hv[m][0][e] + hv[m][1][e] * hv[m][1][e]);
                    if (l15 == 0) part[w * 64 + l] = ss; }
            __syncthreads();
            if (tid < 64) { float t = 0.f;
#pragma unroll
                for (int ww = 0; ww < 8; ++ww) t += part[ww * 64 + tid];
                rstd[tid] = 1.0f / sqrtf(t * (1.0f / 256.0f) + NORM_EPS); }
            __syncthreads();
            { constexpr int PH = 264; LAS float* hs = (LAS float*)lds;
#pragma unroll
              for (int m = 0; m < 4; ++m)
#pragma unroll
                  for (int e = 0; e < 4; ++e) { const int l = 16 * m + 4 * quad + e; const float rs = rstd[l];
                      hs[l * PH + 32 * w + l15] = hv[m][0][e] * rs; hs[l * PH + 32 * w + 16 + l15] = hv[m][1][e] * rs; }
              __syncthreads();
              const int l = tid >> 3, v0 = (tid & 7) * 32; const size_t tk = (size_t)(t0 + l); const int col0 = hh * 256 + v0;
#pragma unroll
              for (int q = 0; q < 4; ++q) { float cc[8], op[8]; unpack8(gcc[q], cc); unpack8(gop[q], op);
                  const f32x4 h0 = *(const LAS f32x4*)(hs + l * PH + v0 + 8 * q), h1 = *(const LAS f32x4*)(hs + l * PH + v0 + 8 * q + 4);
                  const f32x4 n0 = *(const f32x4*)(ml_norm + col0 + 8 * q), n1 = *(const f32x4*)(ml_norm + col0 + 8 * q + 4), k0 = *(const f32x4*)(ml_skip + col0 + 8 * q), k1 = *(const f32x4*)(ml_skip + col0 + 8 * q + 4);
                  float r[8];
#pragma unroll
                  for (int e = 0; e < 4; ++e) { r[e] = sigmoidf_(op[e]) * (h0[e] * n0[e] + k0[e] * cc[e]); r[4 + e] = sigmoidf_(op[4 + e]) * (h1[e] * n1[e] + k1[e] * cc[4 + e]); }
                  v4u o; o.x = pk2(r[0], r[1]); o.y = pk2(r[2], r[3]); o.z = pk2(r[4], r[5]); o.w = pk2(r[6], r[7]); *(v4u*)(Y + tk * 2048 + col0 + 8 * q) = o; } }
            __syncthreads(); }
        } else { for (int rep_ = 0; rep_ < 1 + CK_DUP_HG3; ++rep_) {
            const int uu = u - NU_ML, bh = uu / NCH, j = uu - bh * NCH, b = bh >> 3, hh = bh & 7, t0 = b * SEQ + j * CL;
            constexpr int PT = 136, PA = 72;
            constexpr int BP = 65;
            LAS float* bT = (LAS float*)lds;
            constexpr int QP = 129;
            LAS float* qf = bT + 128 * BP;
            LAS bf16_t* kT = (LAS bf16_t*)(qf + 64 * QP);
            LAS bf16_t* qh = kT + 128 * 64;
            LAS bf16_t* Vt = qh + 64 * PT;
            LAS bf16_t* At = Vt + 64 * PT;
            LAS float* part = (LAS float*)(At + 64 * PA);
            LAS float* rstd = part + 512;
            bf16x8 sfr[4];
            { const bf16_t* Sj = SST + (size_t)uu * 16384;
#pragma unroll
              for (int ks = 0; ks < 4; ++ks) sfr[ks] = frag_rowk_g(Sj, 128, 16 * w, 32 * ks, lane); }
            { const int s = tid >> 3, c0 = (tid & 7) * 16; const bf16_t* pp = P + (size_t)(t0 + s) * AB_N + hh * 128 + c0;
#pragma unroll
              for (int q = 0; q < 2; ++q) { float hq[8], hf[8]; unpack8(*(const v4u*)(pp + 3072 + 8 * q), hq); unpack8(*(const v4u*)(pp + 4096 + 8 * q), hf);
                  *(LAS v4u*)(Vt + s * PT + c0 + 8 * q) = *(const v4u*)(pp + 5120 + 8 * q);
                  if (q == 0) { unsigned z0 = 0u; asm volatile("" : "+v"(z0)); *(LAS v4u*)(At + s * PA + (tid & 7) * 8) = (v4u){z0, z0, z0, z0}; }
#pragma unroll
                  for (int e = 0; e < 8; ++e) { const int c = c0 + 8 * q + e, cg = hh * 128 + c;
                      const float oml = jpair == 0 ? 1.0f : 1.0f - sigmoidf_(lb_logits[1024 + cg] - lb_logits[cg]);
                      float k2, lf; hg_gate(hf[e], oml, k2, lf);
                      bT[c * BP + s] = lf * 1.4426950408889634f; kT[c * 64 + s] = (bf16_t)f2bf(k2);        qf[s * QP + c] = hq[e] * __builtin_amdgcn_rcpf(1.0f + __expf(-hq[e])); } } }
            __syncthreads();
            { const int c = tid & 127, p = tid >> 7; LAS float* tot = part;
              float acc = 0.f;
#pragma unroll
              for (int s = 0; s < 16; ++s) { acc += bT[c * BP + 16 * p + s]; bT[c * BP + 16 * p + s] = acc; }
              tot[p * 128 + c] = acc;
              __syncthreads();
              float off = 0.f;
#pragma unroll
              for (int pp = 0; pp < 3; ++pp) off += pp < p ? tot[pp * 128 + c] : 0.f;
              if (p > 0) {
#pragma unroll
                  for (int s = 0; s < 16; ++s) bT[c * BP + 16 * p + s] += off; } }
            __syncthreads();
            { const int l = tid >> 3, c0 = (tid & 7) * 16;
              float dg = 0.f;
#pragma unroll
              for (int q = 0; q < 2; ++q) { float r[8];
#pragma unroll
                  for (int e = 0; e < 8; ++e) { const int c = c0 + 8 * q + e; const float qv = qf[l * QP + c]; r[e] = qv * __builtin_amdgcn_exp2f(bT[c * BP + l]); dg += qv * bf2f(kT[c * 64 + l]); }
                  v4u o; o.x = pk2(r[0], r[1]); o.y = pk2(r[2], r[3]); o.z = pk2(r[4], r[5]); o.w = pk2(r[6], r[7]); *(LAS v4u*)(qh + l * PT + c0 + 8 * q) = o; }
              dg += DPP_F(dg, 0xB1); dg += DPP_F(dg, 0x4E); dg += DPP_F(dg, 0x141);
              if ((tid & 7) == 0) At[l * PA + l] = (bf16_t)f2bf(dg); }
            if (tid < 480) { const int I = tid / 120, p = tid - I * 120; int lr = (int)((1.0f + sqrtf(1.0f + 8.0f * (float)p)) * 0.5f);
              lr = (lr * (lr - 1)) / 2 > p ? lr - 1 : lr; lr = ((lr + 1) * lr) / 2 <= p ? lr + 1 : lr;
              const int lA = 16 * I + lr, sA = 16 * I + (p - (lr * (lr - 1)) / 2); float a0 = 0.f;
#pragma unroll 4
              for (int c = 0; c < 128; ++c) a0 += qf[lA * QP + c] * bf2f(kT[c * 64 + sA]) * __builtin_amdgcn_exp2f(bT[c * BP + lA] - bT[c * BP + sA]);
              At[lA * PA + sA] = (bf16_t)f2bf(a0); }
            if (w < 6) { const int I = w < 3 ? w + 1 : (w < 5 ? w - 1 : 3), J = w < 3 ? 0 : (w < 5 ? 1 : 2);
                const int sA = 16 * J + l15, lB = 16 * I + l15, eJ = 16 * J + 15;
                f32x4 acc = (f32x4){0.f, 0.f, 0.f, 0.f};
#pragma unroll
                for (int ks = 0; ks < 4; ++ks) { float fa[8], fb[8];
#pragma unroll
                    for (int e = 0; e < 8; ++e) { const int c = 32 * ks + 8 * quad + e; const float Bc = bT[c * BP + eJ];
                        fa[e] = bf2f(kT[c * 64 + sA]) * __builtin_amdgcn_exp2f(Bc - bT[c * BP + sA]); fb[e] = qf[lB * QP + c] * __builtin_amdgcn_exp2f(bT[c * BP + lB] - Bc); }
                    v4u ua, ub; ua.x = pk2(fa[0], fa[1]); ua.y = pk2(fa[2], fa[3]); ua.z = pk2(fa[4], fa[5]); ua.w = pk2(fa[6], fa[7]); ub.x = pk2(fb[0], fb[1]); ub.y = pk2(fb[2], fb[3]); ub.z = pk2(fb[4], fb[5]); ub.w = pk2(fb[6], fb[7]);
                    acc = MMA16(__builtin_bit_cast(bf16x8, ua), __builtin_bit_cast(bf16x8, ub), acc); }
                v2u o; o.x = pk2(acc[0], acc[1]); o.y = pk2(acc[2], acc[3]); *(LAS v2u*)(At + lB * PA + 16 * J + 4 * quad) = o; }
            __syncthreads();
            f32x4 ao[4];
#pragma unroll
            for (int m = 0; m < 4; ++m) ao[m] = (f32x4){0.f, 0.f, 0.f, 0.f};
#pragma unroll
            for (int ks = 0; ks < 2; ++ks) { const bf16x8 bb = frag_tr(Vt, PT, 32 * ks, 16 * w, lane);
#pragma unroll
                for (int m = 0; m < 4; ++m) ao[m] = MMA16(frag_rowk(At, PA, 16 * m, 32 * ks, lane), bb, ao[m]); }
            {
#pragma unroll
              for (int ks = 0; ks < 4; ++ks) { const bf16x8 bb = sfr[ks];
#pragma unroll
                  for (int m = 0; m < 4; ++m) ao[m] = MMA16(frag_rowk(qh, PT, 16 * m, 32 * ks, lane), bb, ao[m]); } }
            v4u ggr[2];
            { const int l = tid >> 3, v0 = (tid & 7) * 16; const size_t tk = (size_t)(t0 + l); const int col0 = hh * 128 + v0;
#pragma unroll
              for (int q = 0; q < 2; ++q) ggr[q] = *(const v4u*)(P + tk * AB_N + 6144 + col0 + 8 * q); }
#pragma unroll
            for (int m = 0; m < 4; ++m)
#pragma unroll
                for (int e = 0; e < 4; ++e) { const int l = 16 * m + 4 * quad + e; const float ss = row16_sum(ao[m][e] * ao[m][e]); if (l15 == 0) part[w * 64 + l] = ss; }
            __syncthreads();
            if (tid < 64) { float t = 0.f;
#pragma unroll
                for (int ww = 0; ww < 8; ++ww) t += part[ww * 64 + tid];
                rstd[tid] = 1.0f / sqrtf(t * (1.0f / 128.0f) + NORM_EPS); }
            __syncthreads();
            { constexpr int PH = 132; LAS float* hs = (LAS float*)lds;
#pragma unroll
              for (int m = 0; m < 4; ++m)
#pragma unroll
                  for (int e = 0; e < 4; ++e) { const int l = 16 * m + 4 * quad + e; hs[l * PH + 16 * w + l15] = ao[m][e] * rstd[l]; }
              __syncthreads();
              const int l = tid >> 3, v0 = (tid & 7) * 16; const size_t tk = (size_t)(t0 + l); const int col0 = hh * 128 + v0;
#pragma unroll
              for (int q = 0; q < 2; ++q) { float gg[8]; unpack8(ggr[q], gg);
                  const f32x4 h0 = *(const LAS f32x4*)(hs + l * PH + v0 + 8 * q), h1 = *(const LAS f32x4*)(hs + l * PH + v0 + 8 * q + 4);
                  const f32x4 n0 = *(const f32x4*)(hg_norm + col0 + 8 * q), n1 = *(const f32x4*)(hg_norm + col0 + 8 * q + 4);
                  float r[8];
#pragma unroll
                  for (int e = 0; e < 4; ++e) { r[e] = h0[e] * n0[e] * siluf_(gg[e]); r[4 + e] = h1[e] * n1[e] * siluf_(gg[4 + e]); }
                  v4u o; o.x = pk2(r[0], r[1]); o.y = pk2(r[2], r[3]); o.z = pk2(r[4], r[5]); o.w = pk2(r[6], r[7]); *(v4u*)(Y + tk * 2048 + 1024 + col0 + 8 * q) = o; } }
            __syncthreads(); }
        }
    }
}


__device__ __forceinline__ void ph_qknorm_rope(Frame& F, bf16_t* slots, const float* q_norm, const float* k_norm, const float* rope) {
    const int sub = F.lane & 15, rsel = F.lane >> 4;
    const int skip = F.G == 256 ? 32 : 0;
    if (F.bx < skip) return;
    const int gw = (F.bx - skip) * 8 + F.wave, ngw = (F.G - skip) * 8;
    constexpr int NIT = 24 * T / 4;
    for (int it0 = gw; it0 < NIT; it0 += 4 * ngw) {
        v4u xin[4]; f32x4 cs[4][4];
#pragma unroll
        for (int u = 0; u < 4; ++u) { const int it = it0 + u * ngw;
            if (it < NIT) { const int rowi = it * 4 + rsel, sl = rowi / T, m = rowi - sl * T, pos = m & (SEQ - 1);
                const int slot = sl < 16 ? sl : (sl < 20 ? 24 + (sl - 16) : 32 + (sl - 20));
                xin[u] = *(const v4u*)(slots + ((size_t)slot * T + m) * 128 + 8 * sub);
                const f32x4* cp = (const f32x4*)(rope + ((size_t)pos * 64 + 8 * (sub & 7)) * 2);
#pragma unroll
                for (int q = 0; q < 4; ++q) cs[u][q] = cp[q]; } }
#pragma unroll
        for (int u = 0; u < 4; ++u) { const int it = it0 + u * ngw;
            if (it < NIT) { const int rowi = it * 4 + rsel, sl = rowi / T, m = rowi - sl * T;
                const int slot = sl < 16 ? sl : (sl < 20 ? 24 + (sl - 16) : 32 + (sl - 20));
                const float* w = (sl < 16 ? q_norm : (sl < 20 ? k_norm + 128 : k_norm + 256)) + 8 * sub;
                bf16_t* p = slots + ((size_t)slot * T + m) * 128 + 8 * sub;
                float x[8]; unpack8(xin[u], x);
                float ss = 0.f;
#pragma unroll
                for (int e = 0; e < 8; ++e) ss += x[e] * x[e];
                const float rstd = __builtin_amdgcn_rsqf(row16_sum(ss) * (1.0f / 128.0f) + NORM_EPS);
                const f32x4 w0 = *(const f32x4*)w, w1 = *(const f32x4*)(w + 4);
                float a[8], bpart[8];
#pragma unroll
                for (int e = 0; e < 8; ++e) { a[e] = x[e] * rstd * (e < 4 ? w0[e] : w1[e - 4]); bpart[e] = DPP_F(a[e], 0x128); }
                const float sgn = sub < 8 ? -1.0f : 1.0f;
                float y[8];
#pragma unroll
                for (int q = 0; q < 4; ++q) { const f32x4 c2 = cs[u][q]; y[2 * q] = a[2 * q] * c2.x + sgn * bpart[2 * q] * c2.y; y[2 * q + 1] = a[2 * q + 1] * c2.z + sgn * bpart[2 * q + 1] * c2.w; }
                v4u o; o.x = pk2(y[0], y[1]); o.y = pk2(y[2], y[3]); o.z = pk2(y[4], y[5]); o.w = pk2(y[6], y[7]);
                *(v4u*)p = o; } }
    }
}
__device__ __forceinline__ void ph_compress2(Frame& F, const bf16_t* hid, const float* w2  , const float* k_norm0, const float* rope, bf16_t* kcmp, bf16_t* vcmp) {
    for (int g4 = F.gw; g4 < 2 * 1024; g4 += F.NGW) {
        const int kv = g4 >> 10, r0 = 4 * (g4 & 1023);
        float h[4][4];
#pragma unroll
        for (int i = 0; i < 4; ++i) { const v2u hu = *(const v2u*)(hid + ((size_t)kv * 4096 + r0 + i) * 256 + 4 * F.lane); h[i][0] = bflo(hu.x); h[i][1] = bfhi(hu.x); h[i][2] = bflo(hu.y); h[i][3] = bfhi(hu.y); }
        const float* w = w2 + (size_t)kv * 256 * 128;
        float a0[4] = {0.f, 0.f, 0.f, 0.f}, a1[4] = {0.f, 0.f, 0.f, 0.f};
        for (int c4 = 0; c4 < 64; ++c4) {
            const float* wr = w + (size_t)(4 * c4) * 128 + F.lane;
            const float w00 = wr[0], w01 = wr[128], w02 = wr[256], w03 = wr[384], w10 = wr[64], w11 = wr[192], w12 = wr[320], w13 = wr[448];
#pragma unroll
            for (int i = 0; i < 4; ++i) {
                const float x0 = __builtin_bit_cast(float, __builtin_amdgcn_readlane(__builtin_bit_cast(int, h[i][0]), c4)), x1 = __builtin_bit_cast(float, __builtin_amdgcn_readlane(__builtin_bit_cast(int, h[i][1]), c4));
                const float x2 = __builtin_bit_cast(float, __builtin_amdgcn_readlane(__builtin_bit_cast(int, h[i][2]), c4)), x3 = __builtin_bit_cast(float, __builtin_amdgcn_readlane(__builtin_bit_cast(int, h[i][3]), c4));
                a0[i] += x0 * w00 + x1 * w01 + x2 * w02 + x3 * w03;
                a1[i] += x0 * w10 + x1 * w11 + x2 * w12 + x3 * w13; }
        }
#pragma unroll
        for (int i = 0; i < 4; ++i) { const int r = r0 + i;
            if (kv == 0) {
                const float rstd = 1.0f / sqrtf(wave_sum(a0[i] * a0[i] + a1[i] * a1[i]) * (1.0f / 128.0f) + NORM_EPS);
                const float a = a0[i] * rstd * k_norm0[F.lane], b = a1[i] * rstd * k_norm0[64 + F.lane];
                const int pos = 16 * (r & 511) + 31;
                const f32x2 cs = *(const f32x2*)(rope + ((size_t)pos * 64 + F.lane) * 2);
                kcmp[(size_t)r * 128 + F.lane] = (bf16_t)f2bf(a * cs.x - b * cs.y); kcmp[(size_t)r * 128 + 64 + F.lane] = (bf16_t)f2bf(b * cs.x + a * cs.y);
            } else { vcmp[(size_t)r * 128 + F.lane] = (bf16_t)f2bf(a0[i]); vcmp[(size_t)r * 128 + 64 + F.lane] = (bf16_t)f2bf(a1[i]); } }
    }
}

namespace nsa {
typedef short s16x4 __attribute__((ext_vector_type(4)));
typedef float f32x16 __attribute__((ext_vector_type(16)));
#define KSWZ(row, colB) ((row) * 256 + ((colB) ^ (((row) & 7) << 4)))
#define SBAR() __builtin_amdgcn_sched_barrier(0)
constexpr float SCALE = 0.08838834764831845f, CLOG = SCALE * 1.4426950408889634f;
constexpr int SHM_T = 64 * 128 * 2;
constexpr int L_V = 0, L_K = 2 * SHM_T, L_WREG = 4 * SHM_T, WREG = 8192, IMP_LD = 144, L_SELW = 132096, L_SCR = 133120, L_END = L_SCR + 8 * 64 * 4;
static_assert(L_WREG + 8 * WREG <= RING_BYTES && 8 * IMP_LD * 4 <= WREG && L_END <= LDS_BYTES && L_SELW >= MISC_OFF + 128, "attention LDS map");
__device__ __forceinline__ int crow(int r, int hi) { return (r & 3) + 8 * (r >> 2) + 4 * hi; }
__device__ __forceinline__ unsigned cvtpk(float lo, float hi) { unsigned r; asm volatile("v_cvt_pk_bf16_f32 %0, %1, %2" : "=v"(r) : "v"(lo), "v"(hi)); return r; }
__device__ __forceinline__ void qkt(f32x16& p0, f32x16& p1, const LAS char* Ks, const bf16x8* qr, int r32, int hi) {
    p0 = f32x16{}; p1 = f32x16{};
#pragma unroll
    for (int d0 = 0; d0 < 8; ++d0) { const int cb = (d0 * 16 + hi * 8) * 2;
        const bf16x8 b0 = *(const LAS bf16x8*)(Ks + KSWZ(r32, cb)), b1 = *(const LAS bf16x8*)(Ks + KSWZ(32 + r32, cb));
        p0 = __builtin_amdgcn_mfma_f32_32x32x16_bf16(b0, qr[d0], p0, 0, 0, 0);
        p1 = __builtin_amdgcn_mfma_f32_32x32x16_bf16(b1, qr[d0], p1, 0, 0, 0); }
}
__device__ __forceinline__ int v_st(int k, int c) { const int kk = (k & ~0xC) | ((k & 4) << 1) | ((k & 8) >> 1); return ((kk >> 3) * 4 + (c >> 5)) * 512 + ((kk & 7) * 32 + (c & 31)) * 2; }
__device__ __forceinline__ int v_rd_base(int lane) { return ((lane & 3) << 3) | (((lane >> 2) & 3) << 6) | (((lane >> 4) & 1) << 5) | (((lane >> 5) & 1) << 8); }
constexpr int v_rd_off(int d0, int ks, int half) { return d0 * 512 + ks * 4096 + half * 2048; }
template <int OFF> __device__ __forceinline__ s16x4 tr_read(int vb) { s16x4 r; asm volatile("ds_read_b64_tr_b16 %0, %1 offset:%2" : "=&v"(r) : "v"(vb), "i"(OFF) : "memory"); return r; }
template <int D0> __device__ __forceinline__ void pv_one(f32x16& od, int vb, bf16x8 pa0, bf16x8 pa1, bf16x8 pa2, bf16x8 pa3) {
    const s16x4 l0 = tr_read<v_rd_off(D0, 0, 0)>(vb), h0 = tr_read<v_rd_off(D0, 0, 1)>(vb), l1 = tr_read<v_rd_off(D0, 1, 0)>(vb), h1 = tr_read<v_rd_off(D0, 1, 1)>(vb);
    const s16x4 l2 = tr_read<v_rd_off(D0, 2, 0)>(vb), h2 = tr_read<v_rd_off(D0, 2, 1)>(vb), l3 = tr_read<v_rd_off(D0, 3, 0)>(vb), h3 = tr_read<v_rd_off(D0, 3, 1)>(vb);
    asm volatile("s_waitcnt lgkmcnt(0)" ::: "memory"); SBAR();
#define PK(L, H) (bf16x8){L[0], L[1], L[2], L[3], H[0], H[1], H[2], H[3]}
    od = __builtin_amdgcn_mfma_f32_32x32x16_bf16(pa0, PK(l0, h0), od, 0, 0, 0);
    od = __builtin_amdgcn_mfma_f32_32x32x16_bf16(pa1, PK(l1, h1), od, 0, 0, 0);
    od = __builtin_amdgcn_mfma_f32_32x32x16_bf16(pa2, PK(l2, h2), od, 0, 0, 0);
    od = __builtin_amdgcn_mfma_f32_32x32x16_bf16(pa3, PK(l3, h3), od, 0, 0, 0);
#undef PK
}
__device__ __forceinline__ void pack_p(const f32x16& p0, const f32x16& p1, bf16x8& pa0, bf16x8& pa1, bf16x8& pa2, bf16x8& pa3) {
#define PK4(P, BASE, OUT) do { const unsigned a0 = cvtpk(P[BASE + 0], P[BASE + 1]), a1 = cvtpk(P[BASE + 2], P[BASE + 3]), b0 = cvtpk(P[BASE + 4], P[BASE + 5]), b1 = cvtpk(P[BASE + 6], P[BASE + 7]); \
    auto r0 = __builtin_amdgcn_permlane32_swap(a0, b0, false, false); auto r1 = __builtin_amdgcn_permlane32_swap(a1, b1, false, false); \
    v4u w = {r0[0], r1[0], r0[1], r1[1]}; OUT = __builtin_bit_cast(bf16x8, w); } while (0)
    PK4(p0, 0, pa0); PK4(p0, 8, pa1); PK4(p1, 0, pa2); PK4(p1, 8, pa3);
#undef PK4
}
__device__ __forceinline__ void qk_half(f32x16& p, const LAS char* Ks, const bf16x8* qr, int row, int hi) {
#pragma unroll
    for (int d0 = 0; d0 < 8; ++d0) { const int cb = (d0 * 16 + hi * 8) * 2; const bf16x8 b = *(const LAS bf16x8*)(Ks + KSWZ(row, cb)); p = __builtin_amdgcn_mfma_f32_32x32x16_bf16(b, qr[d0], p, 0, 0, 0); }
}
template <bool RANGE>
__device__ __forceinline__ float exp_half(f32x16& p, float bias, int klo, int khi, int hi, int koff) {
    float ps = 0.f;
#pragma unroll
    for (int r = 0; r < 16; ++r) { const int k = koff + crow(r, hi); float x = fmaf(p[r], CLOG, bias);
        if (RANGE) x = (k >= klo && k <= khi) ? x : -INFINITY;
        p[r] = __builtin_amdgcn_exp2f(x); ps += p[r]; }
    return ps;
}
__device__ __forceinline__ void pack_half(const f32x16& p, bf16x8& pa, bf16x8& pb) {
#define PK4(P, BASE, OUT) do { const unsigned a0 = cvtpk(P[BASE + 0], P[BASE + 1]), a1 = cvtpk(P[BASE + 2], P[BASE + 3]), b0 = cvtpk(P[BASE + 4], P[BASE + 5]), b1 = cvtpk(P[BASE + 6], P[BASE + 7]); \
    auto r0 = __builtin_amdgcn_permlane32_swap(a0, b0, false, false); auto r1 = __builtin_amdgcn_permlane32_swap(a1, b1, false, false); \
    v4u w = {r0[0], r1[0], r0[1], r1[1]}; OUT = __builtin_bit_cast(bf16x8, w); } while (0)
    PK4(p, 0, pa); PK4(p, 8, pb);
#undef PK4
}
template <int KH>
__device__ __forceinline__ void pv_half(f32x16 (&o)[4], int vb, bf16x8 pa, bf16x8 pb) {
    s16x4 l00 = tr_read<v_rd_off(0, 2 * KH, 0)>(vb), h00 = tr_read<v_rd_off(0, 2 * KH, 1)>(vb), l01 = tr_read<v_rd_off(0, 2 * KH + 1, 0)>(vb), h01 = tr_read<v_rd_off(0, 2 * KH + 1, 1)>(vb);
    const s16x4 l10 = tr_read<v_rd_off(1, 2 * KH, 0)>(vb), h10 = tr_read<v_rd_off(1, 2 * KH, 1)>(vb), l11 = tr_read<v_rd_off(1, 2 * KH + 1, 0)>(vb), h11 = tr_read<v_rd_off(1, 2 * KH + 1, 1)>(vb);
    const s16x4 l20 = tr_read<v_rd_off(2, 2 * KH, 0)>(vb), h20 = tr_read<v_rd_off(2, 2 * KH, 1)>(vb), l21 = tr_read<v_rd_off(2, 2 * KH + 1, 0)>(vb), h21 = tr_read<v_rd_off(2, 2 * KH + 1, 1)>(vb);
    const s16x4 l30 = tr_read<v_rd_off(3, 2 * KH, 0)>(vb), h30 = tr_read<v_rd_off(3, 2 * KH, 1)>(vb), l31 = tr_read<v_rd_off(3, 2 * KH + 1, 0)>(vb), h31 = tr_read<v_rd_off(3, 2 * KH + 1, 1)>(vb);
    asm volatile("s_waitcnt lgkmcnt(0)" ::: "memory"); SBAR();
#define PK(L, H) (bf16x8){L[0], L[1], L[2], L[3], H[0], H[1], H[2], H[3]}
    o[0] = __builtin_amdgcn_mfma_f32_32x32x16_bf16(pa, PK(l00, h00), o[0], 0, 0, 0); o[1] = __builtin_amdgcn_mfma_f32_32x32x16_bf16(pa, PK(l10, h10), o[1], 0, 0, 0);
    o[2] = __builtin_amdgcn_mfma_f32_32x32x16_bf16(pa, PK(l20, h20), o[2], 0, 0, 0); o[3] = __builtin_amdgcn_mfma_f32_32x32x16_bf16(pa, PK(l30, h30), o[3], 0, 0, 0);
    o[0] = __builtin_amdgcn_mfma_f32_32x32x16_bf16(pb, PK(l01, h01), o[0], 0, 0, 0); o[1] = __builtin_amdgcn_mfma_f32_32x32x16_bf16(pb, PK(l11, h11), o[1], 0, 0, 0);
    o[2] = __builtin_amdgcn_mfma_f32_32x32x16_bf16(pb, PK(l21, h21), o[2], 0, 0, 0); o[3] = __builtin_amdgcn_mfma_f32_32x32x16_bf16(pb, PK(l31, h31), o[3], 0, 0, 0);
#undef PK
}
template <bool RANGE>
__device__ __forceinline__ float exp_tile(f32x16& p0, f32x16& p1, float bias, int klo, int khi, int hi) {
    float ps = 0.f;
#pragma unroll
    for (int r = 0; r < 16; ++r) { const int k0 = crow(r, hi), k1 = 32 + k0;
        float x0 = fmaf(p0[r], CLOG, bias), x1 = fmaf(p1[r], CLOG, bias);
        if (RANGE) { x0 = (k0 >= klo && k0 <= khi) ? x0 : -INFINITY; x1 = (k1 >= klo && k1 <= khi) ? x1 : -INFINITY; }
        p0[r] = __builtin_amdgcn_exp2f(x0); p1[r] = __builtin_amdgcn_exp2f(x1); ps += p0[r] + p1[r]; }
    return ps;
}
struct Stg { bf16x8 k0, k1, v0, v1; };
__device__ __forceinline__ void tile_load(Stg& s, const bf16_t* Kg, const bf16_t* Vg, unsigned loff) {
    const char* kb = (const char*)Kg; const char* vb = (const char*)Vg;
    s.k0 = *(const bf16x8*)(kb + loff); s.k1 = *(const bf16x8*)(kb + loff + 8192u);
    s.v0 = *(const bf16x8*)(vb + loff); s.v1 = *(const bf16x8*)(vb + loff + 8192u);
}
__device__ __forceinline__ void tile_write(const Stg& s, LAS char* lds, int buf, int sr, int sc, int vst0, int vst1) {
    *(LAS bf16x8*)(lds + L_V + buf * SHM_T + vst0) = s.v0; *(LAS bf16x8*)(lds + L_V + buf * SHM_T + vst1) = s.v1;
    *(LAS bf16x8*)(lds + L_K + buf * SHM_T + KSWZ(sr, sc * 2)) = s.k0; *(LAS bf16x8*)(lds + L_K + buf * SHM_T + KSWZ(32 + sr, sc * 2)) = s.k1;
}
__device__ __forceinline__ void tile_dma(const bf16_t* Kg, const bf16_t* Vg, LAS char* lds, int buf, int w, unsigned dk0, unsigned dv0, unsigned dv1) {
    LAS char* kd = lds + L_K + buf * SHM_T + w * 1024; LAS char* vd = lds + L_V + buf * SHM_T + w * 1024;
    __builtin_amdgcn_global_load_lds((const unsigned*)((const char*)Kg + dk0), (LAS unsigned*)kd, 16, 0, 0);
    __builtin_amdgcn_global_load_lds((const unsigned*)((const char*)Kg + dk0 + 8192u), (LAS unsigned*)(kd + 8192), 16, 0, 0);
    __builtin_amdgcn_global_load_lds((const unsigned*)((const char*)Vg + dv0), (LAS unsigned*)vd, 16, 0, 0);
    __builtin_amdgcn_global_load_lds((const unsigned*)((const char*)Vg + dv1), (LAS unsigned*)(vd + 8192), 16, 0, 0);
}
__device__ __forceinline__ unsigned grp8_max(unsigned v) {
    v = max(v, (unsigned)__builtin_amdgcn_mov_dpp((int)v, 0xB1, 0xf, 0xf, true));
    v = max(v, (unsigned)__builtin_amdgcn_mov_dpp((int)v, 0x4E, 0xf, 0xf, true));
    v = max(v, (unsigned)__builtin_amdgcn_mov_dpp((int)v, 0x141, 0xf, 0xf, true));
    return v;
}
enum { BR_CMP1 = 0, BR_CMP2 = 1, BR_SEL = 2, BR_WIN = 3 };
}


struct NsaLane { int lane, w, r32, hi, tl, vb0; unsigned dk0, dv0, dv1; };
__device__ __forceinline__ NsaLane nsa_lane(int tid_in, LAS char* lds) {
    using namespace nsa;
    int tid = tid_in; asm volatile("" : "+v"(tid));
    NsaLane L; L.lane = tid & 63; L.w = __builtin_amdgcn_readfirstlane(tid >> 6); L.r32 = L.lane & 31; L.hi = L.lane >> 5; L.tl = 8 * L.w + (L.r32 >> 2);
    { const int r = L.w * 4 + (L.lane >> 4), x = L.lane & 15; L.dk0 = (unsigned)(r * 256 + ((x ^ (r & 7)) << 4));
#pragma unroll
      for (int i = 0; i < 2; ++i) { const int P = i * 512 + L.w * 64 + L.lane, blk = P >> 5, kk = (blk >> 2) * 8 + ((P & 31) >> 2), c = (blk & 3) * 32 + (P & 3) * 8;
          const int k = (kk & ~0xC) | ((kk & 4) << 1) | ((kk & 8) >> 1); const unsigned d = (unsigned)(k * 256 + c * 2); if (i == 0) L.dv0 = d; else L.dv1 = d; } }
    L.vb0 = (int)(uintptr_t)(lds + L_V) + v_rd_base(L.lane);
    return L;
}
__device__ __forceinline__ float nsa_load_q(bf16x8 (&qr)[8], const bf16_t* slots, int g, size_t mrow, int r32, int hi, LAS float* scr, int lane) {
    const bf16_t* qp = slots + ((size_t)(g * 4 + (r32 & 3)) * T + mrow) * 128 + hi * 8;
#pragma unroll
    for (int d0 = 0; d0 < 8; ++d0) qr[d0] = *(const bf16x8*)(qp + d0 * 16);
    float ss = 0.f;
#pragma unroll
    for (int d0 = 0; d0 < 8; ++d0) {
#pragma unroll
        for (int e = 0; e < 8; ++e) { const float x = bf2f((unsigned short)qr[d0][e]); ss += x * x; } }
    ss = half_swap_sum(ss, scr, lane);
    return sqrtf(ss) * nsa::CLOG;
}
__device__ __forceinline__ float nsa_kbound(const float* k_norm_br, int lane) {
    const float a = fmaxf(fabsf(k_norm_br[lane]), fabsf(k_norm_br[64 + lane]));
    return __builtin_bit_cast(float, __builtin_amdgcn_readfirstlane(__builtin_bit_cast(int, wave_max(a)))) * 11.54f;
}

__device__ __forceinline__ void ph_attn_mfma(Frame& F, const bf16_t* slots, const float* gp, const float* gbias, const float* k_norm, const bf16_t* kcmp, const bf16_t* vcmp, bf16_t* O) {
    using namespace nsa;
    LAS char* lds = (LAS char*)F.lds;
    const int vcu = (F.G % 8 == 0) ? (F.bx % 8) * (F.G / 8) + F.bx / 8 : F.bx;
    const int NU = BATCH * 4 * (SEQ / 64);
    for (int ui = 0; ui < (NU + F.G - 1) / F.G; ++ui) {
        if (ui * F.G + vcu >= NU) break;
        int bg, qb;
        if (F.G == 256) { const int v = vcu & 31; bg = vcu >> 5; qb = ui == 0 ? v : ui == 1 ? 63 - v : ui == 2 ? 64 + v : 127 - v; }
        else { const int u = ui * F.G + vcu; bg = u >> 7; qb = u & 127; }
        const int b = bg >> 2, g = bg & 3, q0 = qb * 64;

#define TILE_LOOP(BR, Kg, Vg, kt0, kt1) do { \
        int buf = 0; \
        __syncthreads(); \
        tile_dma((Kg) + (size_t)(kt0) * 64 * 128, (Vg) + (size_t)(kt0) * 64 * 128, lds, 0, L.w, L.dk0, L.dv0, L.dv1); \
        asm volatile("s_waitcnt vmcnt(0)" ::: "memory"); __syncthreads(); \
        for (int kt = (kt0); kt <= (kt1); ++kt) { \
            if (kt < (kt1)) tile_dma((Kg) + (size_t)(kt + 1) * 64 * 128, (Vg) + (size_t)(kt + 1) * 64 * 128, lds, buf ^ 1, L.w, L.dk0, L.dv0, L.dv1);        \
            float bias = -qn * kb; int klo = 0, khi = 63; bool rng = false, wave_on = true; \
            if (BR == BR_CMP1 || BR == BR_CMP2) { khi = nmax_t - 64 * kt; rng = (64 * kt + 63 > 4 * qb - 2); } \
            else if (BR == BR_SEL) { const unsigned wsel = selw[(L.r32 >> 2) * 4 + (kt >> 5)]; const bool on = ((wsel >> (kt & 31)) & 1u) != 0u; bias = on ? bias : -INFINITY; if (kt == qb) { khi = L.tl; rng = true; } \
                wave_on = __builtin_amdgcn_ballot_w64(on) != 0ull; }        \
            else { if (kt == qb) { khi = L.tl; rng = true; } else if (kt == qb - 8) { klo = L.tl + 1; rng = true; } } \
            { \
            const LAS char* Kt_ = lds + L_K + buf * SHM_T; const int vb = L.vb0 + buf * SHM_T; \
            f32x16 p0 = f32x16{}, p1 = f32x16{}; \
            qk_half(p0, Kt_, qr, L.r32, L.hi); qk_half(p1, Kt_, qr, 32 + L.r32, L.hi); \
            float ps = rng ? exp_half<true>(p0, bias, klo, khi, L.hi, 0) : exp_half<false>(p0, bias, klo, khi, L.hi, 0); \
            if (BR == BR_CMP1) { ps += rng ? exp_half<true>(p1, bias, klo, khi, L.hi, 32) : exp_half<false>(p1, bias, klo, khi, L.hi, 32); lsum += ps; } \
            else { \
                bf16x8 pa0, pa1, pa2, pa3; \
                if (BR == BR_CMP2) { _Pragma("unroll") for (int r = 0; r < 16; ++r) p0[r] *= inv_lc; } \
                pack_half(p0, pa0, pa1); \
                if (wave_on) pv_half<0>(o, vb, pa0, pa1); \
                ps += rng ? exp_half<true>(p1, bias, klo, khi, L.hi, 32) : exp_half<false>(p1, bias, klo, khi, L.hi, 32); \
                if (BR == BR_CMP2) { _Pragma("unroll") for (int r = 0; r < 16; ++r) p1[r] *= inv_lc; } else lsum += ps; \
                pack_half(p1, pa2, pa3); \
                if (wave_on) pv_half<1>(o, vb, pa2, pa3); \
                if (BR == BR_CMP2) { \
                      \
                    f32x16 d2 = f32x16{}; \
                    int r32o = L.r32, hio = L.hi; asm volatile("" : "+v"(r32o), "+v"(hio)); \
                    _Pragma("unroll") for (int s = 0; s < 4; ++s) { const int c = r32o - 4 * s; bf16x8 cv; \
                        _Pragma("unroll") for (int jj = 0; jj < 8; ++jj) { const int k = 8 * hio + jj; cv[jj] = (c >= 0 && c <= 4 && k >= 4 * c - 1 && k <= 4 * c + 3) ? (short)0x3F80 : (short)0; } \
                        d2 = __builtin_amdgcn_mfma_f32_32x32x16_bf16(s == 0 ? pa0 : s == 1 ? pa1 : s == 2 ? pa2 : pa3, cv, d2, 0, 0, 0); } \
                    if (L.r32 <= 16) { \
                        _Pragma("unroll") for (int q4 = 0; q4 < 4; ++q4) { const float sum = (d2[4 * q4] + d2[4 * q4 + 1]) + (d2[4 * q4 + 2] + d2[4 * q4 + 3]); \
                            LAS float* ip = imp + (2 * q4 + L.hi) * IMP_LD + 16 * kt + L.r32; *ip = *ip + sum; } } \
                    asm volatile("s_waitcnt lgkmcnt(0)" ::: "memory"); \
                } \
            } \
            } \
            asm volatile("s_waitcnt vmcnt(0)" ::: "memory"); \
            __syncthreads(); buf ^= 1; \
        } } while (0)
#define ROW_FACTORS(f) do { if (L.hi == 0) scr[L.r32] = (f); asm volatile("s_waitcnt lgkmcnt(0)" ::: "memory"); } while (0)

        {
            const NsaLane L = nsa_lane(F.tid, lds);
            LAS float* imp = (LAS float*)(lds + L_WREG + L.w * WREG); LAS bf16_t* park = (LAS bf16_t*)imp; LAS float* scr = (LAS float*)(lds + L_SCR) + L.w * 64; LAS unsigned* selw = nullptr; (void)selw;
            const int t = q0 + L.tl; const size_t mrow = (size_t)b * SEQ + t;
            bf16x8 qr[8]; const float qn = nsa_load_q(qr, slots, g, mrow, L.r32, L.hi, scr, L.lane);
            const float kb = nsa_kbound(k_norm, L.lane);
            for (int i = L.lane; i < 8 * IMP_LD; i += 64) imp[i] = 0.f;
            const bf16_t* Kc = kcmp + (size_t)(g * 1024 + b * 512) * 128; const bf16_t* Vc = vcmp + (size_t)(g * 1024 + b * 512) * 128;
            const int nmax_t = t >= 31 ? (t - 31) >> 4 : -1;
            const int nct = ((4 * qb + 2) >> 6) + 1;
            float lsum = 0.f, inv_lc = 0.f;
            { f32x16 o[4]; (void)o; TILE_LOOP(BR_CMP1, Kc, Vc, 0, nct - 1); }
            lsum = half_swap_sum(lsum, scr, L.lane); inv_lc = lsum > 0.f ? 1.0f / lsum : 0.f;
            f32x16 o[4];
#pragma unroll
            for (int d = 0; d < 4; ++d) o[d] = f32x16{};
            TILE_LOOP(BR_CMP2, Kc, Vc, 0, nct - 1);
            unsigned key[16];
            { const int tok = L.lane >> 3, sub = L.lane & 7;
#pragma unroll
              for (int e4 = 0; e4 < 4; ++e4) { const f32x4 vv = *(const LAS f32x4*)(imp + tok * IMP_LD + 16 * sub + 4 * e4);
#pragma unroll
                  for (int e = 0; e < 4; ++e) { const int s = 16 * sub + 4 * e4 + e; const bool forced = (s == 0) || (s == qb) || (s == qb - 1);
                      const float f = vv[e] + (forced ? 1e4f : 0.f);
                      key[4 * e4 + e] = s <= qb ? ((__builtin_bit_cast(unsigned, f) & 0xFFFFFF80u) | (unsigned)(127 - s)) : 0u; } }
              asm volatile("s_waitcnt lgkmcnt(0)" ::: "memory"); }
            { const int hd = g * 4 + (L.r32 & 3); const float g0 = sigmoidf_(gp[mrow * 48 + hd * 3 + 0] + gbias[hd * 3 + 0]);
              ROW_FACTORS(g0);
#pragma unroll
              for (int r = 0; r < 16; ++r) { const int row = crow(r, L.hi); const float fr = scr[row];
#pragma unroll
                  for (int h2 = 0; h2 < 2; ++h2) ((LAS unsigned*)park)[row * 64 + h2 * 32 + L.r32] = pk2(o[2 * h2][r] * fr, o[2 * h2 + 1][r] * fr); }
              asm volatile("s_waitcnt lgkmcnt(0)" ::: "memory"); }
            { LAS unsigned* sw = (LAS unsigned*)(lds + L_SELW) + L.w * 32; const int tok = L.lane >> 3, sub = L.lane & 7;
              unsigned m0 = 0u, m1 = 0u, m2 = 0u, m3 = 0u;
              for (int k = 0; k < 16; ++k) {
                  unsigned mx = key[0];
#pragma unroll
                  for (int e = 1; e < 16; ++e) mx = max(mx, key[e]);
                  mx = grp8_max(mx);
                  if (mx != 0u) { const unsigned s = 127u - (mx & 127u); const unsigned bit = 1u << (s & 31u);
                      m0 |= (s >> 5) == 0u ? bit : 0u; m1 |= (s >> 5) == 1u ? bit : 0u; m2 |= (s >> 5) == 2u ? bit : 0u; m3 |= (s >> 5) == 3u ? bit : 0u; }
#pragma unroll
                  for (int e = 0; e < 16; ++e) key[e] = key[e] == mx ? 0u : key[e];
              }
              if (sub == 0) { sw[tok * 4 + 0] = m0; sw[tok * 4 + 1] = m1; sw[tok * 4 + 2] = m2; sw[tok * 4 + 3] = m3; }
              asm volatile("s_waitcnt lgkmcnt(0)" ::: "memory"); }
        }
        {
            const NsaLane L = nsa_lane(F.tid, lds);
            LAS float* imp = nullptr; (void)imp; LAS bf16_t* park = (LAS bf16_t*)(lds + L_WREG + L.w * WREG); LAS float* scr = (LAS float*)(lds + L_SCR) + L.w * 64; LAS unsigned* selw = (LAS unsigned*)(lds + L_SELW) + L.w * 32;
            const int t = q0 + L.tl; const size_t mrow = (size_t)b * SEQ + t;
            bf16x8 qr[8]; const float qn = nsa_load_q(qr, slots, g, mrow, L.r32, L.hi, scr, L.lane);
            const float kb = nsa_kbound(k_norm + 128, L.lane);
            const bf16_t* Ks = slots + ((size_t)(24 + g) * T + (size_t)b * SEQ) * 128; const bf16_t* Vs = slots + ((size_t)(28 + g) * T + (size_t)b * SEQ) * 128;
            const int nmax_t = 0; (void)nmax_t; float lsum = 0.f; const float inv_lc = 0.f; (void)inv_lc;
            f32x16 o[4];
#pragma unroll
            for (int d = 0; d < 4; ++d) o[d] = f32x16{};
            TILE_LOOP(BR_SEL, Ks, Vs, 0, qb);
            lsum = half_swap_sum(lsum, scr, L.lane);
            { const int hd = g * 4 + (L.r32 & 3); const float g1 = sigmoidf_(gp[mrow * 48 + hd * 3 + 1] + gbias[hd * 3 + 1]);
              ROW_FACTORS(lsum > 0.f ? g1 / lsum : 0.f);
#pragma unroll
              for (int r = 0; r < 16; ++r) { const int row = crow(r, L.hi); const float fr = scr[row];
#pragma unroll
                  for (int h2 = 0; h2 < 2; ++h2) { LAS unsigned* pw = (LAS unsigned*)park + row * 64 + h2 * 32 + L.r32; const unsigned w = *pw; *pw = pk2(bflo(w) + o[2 * h2][r] * fr, bfhi(w) + o[2 * h2 + 1][r] * fr); } }
              asm volatile("s_waitcnt lgkmcnt(0)" ::: "memory"); }
        }
        {
            const NsaLane L = nsa_lane(F.tid, lds);
            LAS float* imp = nullptr; (void)imp; LAS bf16_t* park = (LAS bf16_t*)(lds + L_WREG + L.w * WREG); LAS float* scr = (LAS float*)(lds + L_SCR) + L.w * 64; LAS unsigned* selw = nullptr; (void)selw;
            const int t = q0 + L.tl; const size_t mrow = (size_t)b * SEQ + t;
            bf16x8 qr[8]; const float qn = nsa_load_q(qr, slots, g, mrow, L.r32, L.hi, scr, L.lane);
            const float kb = nsa_kbound(k_norm + 256, L.lane);
            const bf16_t* Kw = slots + ((size_t)(32 + g) * T + (size_t)b * SEQ) * 128; const bf16_t* Vw = slots + ((size_t)(36 + g) * T + (size_t)b * SEQ) * 128;
            const int nmax_t = 0; (void)nmax_t; float lsum = 0.f; const float inv_lc = 0.f; (void)inv_lc;
            f32x16 o[4];
#pragma unroll
            for (int d = 0; d < 4; ++d) o[d] = f32x16{};
            TILE_LOOP(BR_WIN, Kw, Vw, (qb - 8 < 0 ? 0 : qb - 8), qb);
            lsum = half_swap_sum(lsum, scr, L.lane);
            { const int hd = g * 4 + (L.r32 & 3); const float g2 = sigmoidf_(gp[mrow * 48 + hd * 3 + 2] + gbias[hd * 3 + 2]);
              ROW_FACTORS(lsum > 0.f ? g2 / lsum : 0.f);
              char* Ow = (char*)(O + ((size_t)b * SEQ + q0 + 8 * L.w) * 2048 + g * 512);
#pragma unroll
              for (int r = 0; r < 16; ++r) { const int row = crow(r, L.hi); const float fr = scr[row];
#pragma unroll
                  for (int h2 = 0; h2 < 2; ++h2) { const unsigned w = ((LAS unsigned*)park)[row * 64 + h2 * 32 + L.r32];
                      *(bf16_t*)(Ow + (unsigned)(((row >> 2) * 2048 + (row & 3) * 128 + (2 * h2) * 32 + L.r32) * 2)) = (bf16_t)f2bf(bflo(w) + o[2 * h2][r] * fr);
                      *(bf16_t*)(Ow + (unsigned)(((row >> 2) * 2048 + (row & 3) * 128 + (2 * h2 + 1) * 32 + L.r32) * 2)) = (bf16_t)f2bf(bfhi(w) + o[2 * h2 + 1][r] * fr); } }
              asm volatile("s_waitcnt lgkmcnt(0)" ::: "memory"); }
        }
#undef TILE_LOOP
#undef ROW_FACTORS
    }
}

#ifndef MK_MULTI_LAUNCH
#define MK_MULTI_LAUNCH 0
#endif
constexpr int NPS = 8, NSLOTS_PH = 1 + 12 * NPS;
__global__ void __launch_bounds__(NTHREADS, 2) fwd_kernel(Args a) {
    extern __shared__ __attribute__((aligned(16))) unsigned char lds_raw[];
    volatile LAS unsigned* MISC = (volatile LAS unsigned*)((LAS unsigned char*)lds_raw + MISC_OFF);
    if (threadIdx.x < 32) MISC[threadIdx.x] = 0u;
    const int g_wave = __builtin_amdgcn_readfirstlane((int)(threadIdx.x >> 6));
    __syncthreads();
    const int lo = a.ph_lo, hi = a.ph_hi;
    const bool use_bar = (hi - lo) > 1;
    XcdBarrier bar; bar.bar = (unsigned*)(a.ws + WS_CTL) + CW_BAR; bar.x = 0; bar.st = MISC + 8; bar.wv = g_wave;
    if (use_bar) bar = xcd_barrier_post((unsigned*)(a.ws + WS_CTL) + CW_BAR, MISC + 8, g_wave);
#define IN(k) (lo <= (k) && (k) < hi)
#define SEAM(k) do { if (IN((k) + 1) && use_bar) xcd_barrier(bar); } while (0)
#define PH_ENTER() Frame F = make_frame(lds_raw, g_wave); CArgsP ap = get_args(); unsigned char* ws = ap->ws; float* h = ap->out; bf16_t* HN = (bf16_t*)(ws + WS_HN); bf16_t* ACT = (bf16_t*)(ws + WS_ACT); float* SSQ = (float*)(ws + WS_SSQP); LAS float* RED = (LAS float*)(F.lds + RED_OFF); (void)h; (void)HN; (void)ACT; LAS float* RSL = RED + 3072; (void)SSQ; (void)RED; (void)RSL

    if (IN(0)) { PH_ENTER(); ph_prologue(F, ap); }
    SEAM(0);

    for (int step = 0; step < 12; ++step) {
        const int layer = step / 3, sub = step - 3 * layer, base = 1 + NPS * step, jp = layer >> 1;
        if (sub != 1) {
            const int half = sub >> 1, f = layer * 2 + half;
            const int vin = 3 * layer + 2 * half;
            if (IN(base + 1)) { PH_ENTER(); Gemm g{HN, (const bf16_t*)(ws + WS_WGU + (size_t)f * GU_BYTES), T, 2 * FF, D, D, D, 0, 0}; StaticOrder S; S.init(T, 2 * FF, F.G, F.bx);
                pg8::Unit u0; const bool any = S.next(0, u0); const int pm0 = any ? u0.pm : 0; const float* sq = SSQ + (size_t)vin * T * 32; panel_rstd(F, sq, pm0, RSL);
                pg8::EpiSwiGLU E{ACT, FF, pg8::RowScale{RSL, pm0, sq}}; gemm_phase<pg8::EpiSwiGLU, StaticOrder>(F.lds, g, S, E, nullptr, F.tid); }
            SEAM(base + 1);
            if (IN(base + 2)) { PH_ENTER(); Gemm g{ACT, (const bf16_t*)(ws + WS_WD + (size_t)f * DN_BYTES), T, D, FF, FF, FF, 0, 0}; StaticOrder S; S.init(T, D, F.G, F.bx);
                pg8::EpiResid E{h, D, HN, SSQ + (size_t)(vin + 1) * T * 32, RED, step == 11}; gemm_phase<pg8::EpiResid, StaticOrder>(F.lds, g, S, E, nullptr, F.tid); }
            SEAM(base + 2);
        } else if ((layer & 1) == 0) {
#define AB_PTRS() bf16_t* P = ACT; unsigned char* mx = ws + WS_MIX; bf16_t* CB = (bf16_t*)(mx + MX_C); bf16_t* QK = (bf16_t*)(mx + MX_QK); bf16_t* CST = (bf16_t*)(mx + MX_CST); bf16_t* SST = (bf16_t*)(mx + MX_SST); float* GIF = (float*)(mx + MX_GIF); float* NST = (float*)(mx + MX_NST); float* SCL = (float*)(mx + MX_SCL); float* HDEC = (float*)(mx + MX_HDEC); bf16_t* Y = (bf16_t*)(mx + MX_Y); (void)P; (void)CB; (void)QK; (void)CST; (void)SST; (void)GIF; (void)NST; (void)SCL; (void)HDEC; (void)Y
            if (IN(base + 1)) { PH_ENTER(); AB_PTRS(); const float* ssq = SSQ + (size_t)(3 * layer + 1) * T * 32;
                { Gemm g{HN, (const bf16_t*)(ws + WS_WABIN + (size_t)jp * ABIN_BYTES), T, AB_N, D, D, D, 0, 0}; StaticOrder S; S.init(T, AB_N, F.G, F.bx);
                  pg8::Unit u0; const bool any = S.next(0, u0); const int pm0 = any ? u0.pm : 0; panel_rstd(F, ssq, pm0, RSL);
                  pg8::EpiPlainBf16 E{P, AB_N, pg8::RowScale{RSL, pm0, ssq}, true}; gemm_phase<pg8::EpiPlainBf16, StaticOrder>(F.lds, g, S, E, nullptr, F.tid); }
                ph_skinny<8>(F, HN, ssq, (const bf16_t*)(ws + WS_WSK) + (size_t)jp * 64 * D, GIF); }
            SEAM(base + 1);
            if (IN(base + 2)) { PH_ENTER(); AB_PTRS(); ph_conv(F, P, ap->in[12] + (size_t)jp * 4096, ap->in[13] + (size_t)jp * 1024, CB); }
            SEAM(base + 2);
            if (IN(base + 3)) { PH_ENTER(); AB_PTRS(); Gemm g{CB, (const bf16_t*)(ws + WS_WQK + (size_t)jp * WQK_BYTES), T, 2048, 256, 1024, 256, 3, 256}; StaticOrder S; S.init(T, 2048, F.G, F.bx);
                pg8::EpiPlainBf16 E{QK, 2048, pg8::RowScale{nullptr, -1, nullptr}, false}; gemm_phase<pg8::EpiPlainBf16, StaticOrder>(F.lds, g, S, E, nullptr, F.tid); }
            SEAM(base + 3);
            if (IN(base + 4)) { PH_ENTER(); AB_PTRS(); ph_chunk_r1(F, P, QK, GIF, ap->in[16] + jp * 4, ap->in[17] + jp * 4, ap->in[20], jp, CST, NST, SCL, SST, HDEC); }
            SEAM(base + 4);
            if (IN(base + 5)) { PH_ENTER(); AB_PTRS(); ph_chunk_r2(F, CST, NST, SCL, SST, HDEC); }
            SEAM(base + 5);
            if (IN(base + 6)) { PH_ENTER(); AB_PTRS(); ph_chunk_r3(F, P, QK, CB, GIF, ap->in[16] + jp * 4, ap->in[17] + jp * 4, ap->in[20], jp, CST, NST, SCL, SST, ap->in[18] + (size_t)jp * 1024, ap->in[19] + (size_t)jp * 1024, ap->in[21] + (size_t)jp * 1024, Y); }
            SEAM(base + 6);
            if (IN(base + 7)) { PH_ENTER(); AB_PTRS(); Gemm g{Y, (const bf16_t*)(ws + WS_WABOUT + (size_t)jp * SQ_BYTES), T, D, D, D, D, 0, 0}; StaticOrder S; S.init(T, D, F.G, F.bx);
                pg8::EpiResid E{h, D, HN, SSQ + (size_t)(3 * layer + 2) * T * 32, RED, false}; gemm_phase<pg8::EpiResid, StaticOrder>(F.lds, g, S, E, nullptr, F.tid); }
            SEAM(base + 7);
        } else {
#define C_PTRS() bf16_t* SL = ACT; unsigned char* mx = ws + WS_MIX; float* GP = (float*)(mx + MX_GP); bf16_t* HID = (bf16_t*)(mx + MX_HID); bf16_t* KC = (bf16_t*)(mx + MX_KCMP); bf16_t* VC = (bf16_t*)(mx + MX_VCMP); bf16_t* O = (bf16_t*)(mx + MX_O); const float* rope = (const float*)(ws + WS_ROPE); (void)SL; (void)GP; (void)HID; (void)KC; (void)VC; (void)O; (void)rope
            if (IN(base + 1)) { PH_ENTER(); C_PTRS(); const float* ssq = SSQ + (size_t)(3 * layer + 1) * T * 32;
                { Gemm g{HN, (const bf16_t*)(ws + WS_WCIN + (size_t)jp * CIN_BYTES), T, C_N, D, D, D, 0, 0}; StaticOrder S; S.init(T, C_N, F.G, F.bx);
                  pg8::Unit u0; const bool any = S.next(0, u0); const int pm0 = any ? u0.pm : 0; panel_rstd(F, ssq, pm0, RSL);
                  pg8::EpiSlots E{SL, T, pg8::RowScale{RSL, pm0, ssq}}; gemm_phase<pg8::EpiSlots, StaticOrder>(F.lds, g, S, E, nullptr, F.tid); }
                ph_skinny<48>(F, HN, ssq, (const bf16_t*)(ws + WS_WSK) + (size_t)(2 + jp) * 64 * D, GP); }
            SEAM(base + 1);
            if (IN(base + 2)) {
                { PH_ENTER(); C_PTRS(); const int kv = F.bx >= 16 ? 1 : 0;
                  const float* cbias = (const float*)(ws + WS_CB) + (size_t)jp * 512 + kv * 256;
                  Gemm g{SL + (size_t)(16 + 4 * kv) * T * 128, (const bf16_t*)(ws + WS_WCMP1 + (size_t)(jp * 2 + kv) * CMP1_BYTES), 4096, 256, 4096, 2048, 4096, 0, 0};
                  StaticOrder S; S.init(4096, 256, F.G, kv ? F.bx - 16 : F.bx);
                  pg8::EpiSiluBias E{HID + (size_t)kv * 4096 * 256, 256, cbias}; gemm_phase<pg8::EpiSiluBias, StaticOrder>(F.lds, g, S, E, nullptr, F.tid); }
                { PH_ENTER(); C_PTRS(); ph_qknorm_rope(F, SL, ap->in[24] + (size_t)jp * 128, ap->in[25] + (size_t)jp * 384, rope); } }
            SEAM(base + 2);
            if (IN(base + 3)) { PH_ENTER(); C_PTRS(); ph_compress2(F, HID, ap->in[29] + (size_t)jp * 2 * 256 * 128, ap->in[25] + (size_t)jp * 384, rope, KC, VC); }
            SEAM(base + 3);
            if (IN(base + 4)) { PH_ENTER(); C_PTRS(); ph_attn_mfma(F, SL, GP, ap->in[30] + (size_t)jp * 48, ap->in[25] + (size_t)jp * 384, KC, VC, O); }
            SEAM(base + 4);
            if (IN(base + 6)) { PH_ENTER(); C_PTRS(); Gemm g{O, (const bf16_t*)(ws + WS_WCOUT + (size_t)jp * SQ_BYTES), T, D, D, D, D, 0, 0}; StaticOrder S; S.init(T, D, F.G, F.bx);
                pg8::EpiResid E{h, D, HN, SSQ + (size_t)(3 * layer + 2) * T * 32, RED, false}; gemm_phase<pg8::EpiResid, StaticOrder>(F.lds, g, S, E, nullptr, F.tid); }
            SEAM(base + 6);
        }
    }
#undef IN
#undef SEAM
}

extern "C" void kernel_launch(void* const* d_in, const int* in_sizes, int n_in, void* d_out, int out_size, void* d_ws, size_t ws_size, hipStream_t stream) {
    static int grid = 0;
    if (grid == 0) {
        if (n_in != 31 || in_sizes[0] != T * D || out_size != T * D || ws_size < WS_END) { fprintf(stderr, "kernel_launch: unexpected problem shape (n_in %d, in0 %d, out %d, ws %zu < %zu)\n", n_in, n_in > 0 ? in_sizes[0] : -1, out_size, ws_size, (size_t)WS_END); grid = -1; return; }
        int dev = 0, cus = 0, per_cu = 0;
        if (hipGetDevice(&dev) != hipSuccess || hipDeviceGetAttribute(&cus, hipDeviceAttributeMultiprocessorCount, dev) != hipSuccess) { grid = -1; return; }
        if (hipFuncSetAttribute((const void*)fwd_kernel, hipFuncAttributeMaxDynamicSharedMemorySize, LDS_BYTES) != hipSuccess) { fprintf(stderr, "kernel_launch: hipFuncSetAttribute failed\n"); grid = -1; return; }
        if (hipOccupancyMaxActiveBlocksPerMultiprocessor(&per_cu, (const void*)fwd_kernel, NTHREADS, LDS_BYTES) != hipSuccess || per_cu < 1) { fprintf(stderr, "kernel_launch: occupancy query reports %d workgroups per CU\n", per_cu); }
        (void)hipGetLastError();
        grid = cus;
    }
    if (grid < 0) return;
    if (hipMemsetAsync((char*)d_ws + WS_CTL, 0, CTL_ZERO_BYTES, stream) != hipSuccess) return;
    Args a{};
    for (int i = 0; i < 31; ++i) a.in[i] = (const float*)d_in[i];
    a.out = (float*)d_out; a.ws = (unsigned char*)d_ws;
#if MK_MULTI_LAUNCH
    for (int p = 0; p < NSLOTS_PH; ++p) {
        if (p > 0) { const int step = (p - 1) / NPS, q = (p - 1) % NPS, sub = step % 3, layer = step / 3;
            if (q == 0) continue; if (sub != 1 && q > 2) continue; if (sub == 1 && (layer & 1) == 1 && (q == 5 || q == 7)) continue; }
        a.ph_lo = p; a.ph_hi = p + 1;
        hipLaunchKernelGGL(fwd_kernel, dim3(grid), dim3(NTHREADS), LDS_BYTES, stream, a);
    }
#else
    a.ph_lo = 0; a.ph_hi = NSLOTS_PH;
    hipLaunchKernelGGL(fwd_kernel, dim3(grid), dim3(NTHREADS), LDS_BYTES, stream, a);
#endif
}
```

```cpp
#include <hip/hip_runtime.h>
#include <cstdio>
#include <cstdint>

constexpr int BATCH = 2, SEQ = 8192, T = BATCH * SEQ, D = 2048, FF = 5504, DEPTH = 4;
constexpr int AB_COLS = 7176, AB_N = 7168;
constexpr int C_COLS = 5168, C_N = 5120;
constexpr int NSLOT = 40;
constexpr int NCMP = 512;
constexpr float NORM_EPS = 1e-6f;

#define GAS __attribute__((address_space(1)))
#define LAS __attribute__((address_space(3)))
typedef unsigned short bf16_t;
typedef unsigned v4u __attribute__((ext_vector_type(4)));
typedef unsigned v2u __attribute__((ext_vector_type(2)));
typedef float f32x4 __attribute__((ext_vector_type(4)));
typedef float f32x2 __attribute__((ext_vector_type(2)));
typedef short bf16x8 __attribute__((ext_vector_type(8)));

__device__ __forceinline__ unsigned f2bf(float f) { return (unsigned)__builtin_bit_cast(unsigned short, (__bf16)f); }
typedef float pk_f2_t __attribute__((ext_vector_type(2)));
typedef __bf16 pk_b2_t __attribute__((ext_vector_type(2)));
__device__ __forceinline__ unsigned pk2(float lo, float hi) { const pk_f2_t v = {lo, hi}; return __builtin_bit_cast(unsigned, __builtin_convertvector(v, pk_b2_t)); }
__device__ __forceinline__ float bf2f(unsigned short b) { return __builtin_bit_cast(float, ((unsigned)b) << 16); }
__device__ __forceinline__ float bflo(unsigned w) { return __builtin_bit_cast(float, w << 16); }
__device__ __forceinline__ float bfhi(unsigned w) { return __builtin_bit_cast(float, w & 0xffff0000u); }
#define DPP_F(v, ctrl) __builtin_bit_cast(float, __builtin_amdgcn_mov_dpp(__builtin_bit_cast(int, (v)), (ctrl), 0xf, 0xf, true))
__device__ __forceinline__ float wave_sum(float v) {
    v += DPP_F(v, 0xB1); v += DPP_F(v, 0x4E); v += DPP_F(v, 0x124); v += DPP_F(v, 0x128);
    const int b = __builtin_bit_cast(int, v);
    return (__builtin_bit_cast(float, __builtin_amdgcn_readlane(b, 0)) + __builtin_bit_cast(float, __builtin_amdgcn_readlane(b, 16))) + (__builtin_bit_cast(float, __builtin_amdgcn_readlane(b, 32)) + __builtin_bit_cast(float, __builtin_amdgcn_readlane(b, 48)));
}
__device__ __forceinline__ float wave_max(float v) {
    v = fmaxf(v, DPP_F(v, 0xB1)); v = fmaxf(v, DPP_F(v, 0x4E)); v = fmaxf(v, DPP_F(v, 0x124)); v = fmaxf(v, DPP_F(v, 0x128));
    const int b = __builtin_bit_cast(int, v);
    return fmaxf(fmaxf(__builtin_bit_cast(float, __builtin_amdgcn_readlane(b, 0)), __builtin_bit_cast(float, __builtin_amdgcn_readlane(b, 16))), fmaxf(__builtin_bit_cast(float, __builtin_amdgcn_readlane(b, 32)), __builtin_bit_cast(float, __builtin_amdgcn_readlane(b, 48))));
}
__device__ __forceinline__ float half_swap_sum(float x, LAS float* scr64, int lane) {
    scr64[lane] = x; asm volatile("s_waitcnt lgkmcnt(0)" ::: "memory"); const float y = scr64[lane ^ 32]; asm volatile("s_waitcnt lgkmcnt(0)" ::: "memory"); return x + y; }
__device__ __forceinline__ float opaque_one() { float one = 1.0f; asm volatile("" : "+v"(one)); return one; }
__device__ __forceinline__ float sigmoidf_(float x) { return __builtin_amdgcn_rcpf(1.0f + __expf(-x)); }
__device__ __forceinline__ float siluf_(float x) { return x * __builtin_amdgcn_rcpf(1.0f + __expf(-x)); }
__device__ __forceinline__ float row16_sum(float v) {
    v += __builtin_bit_cast(float, __builtin_amdgcn_mov_dpp(__builtin_bit_cast(int, v), 0xB1, 0xf, 0xf, true));
    v += __builtin_bit_cast(float, __builtin_amdgcn_mov_dpp(__builtin_bit_cast(int, v), 0x4E, 0xf, 0xf, true));
    v += __builtin_bit_cast(float, __builtin_amdgcn_mov_dpp(__builtin_bit_cast(int, v), 0x124, 0xf, 0xf, true));
    v += __builtin_bit_cast(float, __builtin_amdgcn_mov_dpp(__builtin_bit_cast(int, v), 0x128, 0xf, 0xf, true));
    return v;
}

__device__ __forceinline__ int lane_id() { int l; asm volatile("v_mbcnt_lo_u32_b32 %0, -1, 0\n\tv_mbcnt_hi_u32_b32 %0, -1, %0" : "=v"(l)); return l; }
#define XB_TMO      128
#define XB_XCNT(j)  (256  + 64 * (j))
#define XB_XSUB(j)  (1280 + 64 * (j))
#define XB_XGEN(j)  (2304 + 64 * (j))
#define XB_TOP      3328
#define XB_TOPGEN   3392
#define XCD_BAR_WORDS 3456
#define XB_SPIN_CAP (1u << 18)

__device__ __forceinline__ unsigned xb_ld(unsigned* p)              { return __hip_atomic_load(p, __ATOMIC_RELAXED, __HIP_MEMORY_SCOPE_AGENT); }
__device__ __forceinline__ unsigned xb_add(unsigned* p, unsigned v) { return __hip_atomic_fetch_add(p, v, __ATOMIC_RELAXED, __HIP_MEMORY_SCOPE_AGENT); }
__device__ __forceinline__ unsigned xb_xcc_id() { return (unsigned)__builtin_amdgcn_s_getreg((3 << 11) | 20) & 0xFu; }
#define XB_SPIN(cond, bar) do { unsigned _sp = 0; while (cond) { __builtin_amdgcn_s_sleep(1); \
    if ((++_sp & 255u) == 0u) { if (xb_ld(&(bar)[XB_TMO])) break; if (_sp > XB_SPIN_CAP) { atomicAdd(&(bar)[XB_TMO], 1u); break; } } } } while (0)

struct XcdBarrier {
    unsigned* bar; unsigned x;
    volatile LAS unsigned* st;
    int wv;
};
__device__ __forceinline__ bool xb_leader(const XcdBarrier& b) { int l; asm volatile("v_mbcnt_lo_u32_b32 %0, -1, 0\n\tv_mbcnt_hi_u32_b32 %0, -1, %0" : "=v"(l)); return b.wv == 0 && l == 0; }

__device__ __forceinline__ XcdBarrier xcd_barrier_post(unsigned* bar, volatile LAS unsigned* st, int wv) {
    XcdBarrier b; b.bar = bar; b.x = xb_xcc_id(); b.st = st; b.wv = wv;
    if (xb_leader(b)) (void)xb_add(&bar[XB_XCNT(b.x)], 1u);
    return b;
}
__device__ __forceinline__ void xcd_barrier_complete(unsigned* bar, unsigned x, unsigned& nloc, unsigned& nx) {
    const unsigned G = gridDim.x * gridDim.y * gridDim.z;
    unsigned sum, cnt, mine, sp = 0u;
    for (;;) {
        sum = 0u; cnt = 0u; mine = 0u;
#pragma unroll
        for (unsigned j = 0; j < 16; ++j) { const unsigned c = xb_ld(&bar[XB_XCNT(j)]); sum += c; cnt += (c > 0u) ? 1u : 0u; mine = (j == x) ? c : mine; }
        if (sum == G) break;
        __builtin_amdgcn_s_sleep(1);
        if ((++sp & 255u) == 0u) { if (xb_ld(&bar[XB_TMO])) break; if (sp > XB_SPIN_CAP) { atomicAdd(&bar[XB_TMO], 1u); break; } }
    }
    nloc = mine > 0u ? mine : 1u; nx = cnt > 0u ? cnt : 1u;
}

__device__ __forceinline__ void xcd_barrier(const XcdBarrier& b) {
    asm volatile("s_waitcnt vmcnt(0)" ::: "memory");
    __syncthreads();
    if (xb_leader(b)) {
        unsigned* bar = b.bar; asm volatile("" : "+s"(bar));
        __builtin_amdgcn_s_waitcnt(0);
        unsigned nloc = b.st[0], nx = b.st[1];
        if (nloc == 0u) { xcd_barrier_complete(bar, b.x, nloc, nx); b.st[0] = nloc; b.st[1] = nx; }
        const unsigned old = xb_add(&bar[XB_XSUB(b.x)], 1u);
        const unsigned gen = old / nloc;
        if (old + 1u == (gen + 1u) * nloc) {
            __builtin_amdgcn_fence(__ATOMIC_RELEASE, "agent");
            asm volatile("s_waitcnt vmcnt(0)" ::: "memory");
            const unsigned og = xb_add(&bar[XB_TOP], 1u);
            const unsigned tg = og / nx;
            if (og + 1u == (tg + 1u) * nx) xb_add(&bar[XB_TOPGEN], 1u);
            else XB_SPIN(xb_ld(&bar[XB_TOPGEN]) == tg, bar);
            __builtin_amdgcn_fence(__ATOMIC_ACQUIRE, "agent");
            xb_add(&bar[XB_XGEN(b.x)], 1u);
            asm volatile("s_waitcnt vmcnt(0)" ::: "memory");
        } else {
            XB_SPIN(xb_ld(&bar[XB_XGEN(b.x)]) == gen, bar);
            __builtin_amdgcn_fence(__ATOMIC_ACQUIRE, "agent");
            asm volatile("s_waitcnt vmcnt(0)" ::: "memory");
        }
    }
    __syncthreads();
}
namespace pg8 {
#define PG8_LAS __attribute__((address_space(3)))
typedef unsigned short bf16_t;
typedef short bf16x8 __attribute__((ext_vector_type(8)));
typedef float f32x4 __attribute__((ext_vector_type(4)));
typedef unsigned u32x4 __attribute__((ext_vector_type(4)));
constexpr int BM = 256, BK = 64, HALF = 128, HTB = HALF * BK * 2  , STAGE_BYTES = 8 * HTB, NXCD = 8, WGM = 8;

__host__ __device__ __forceinline__ int lds_byte(int r, int c) { const int st = (r >> 4) * 2 + (c >> 5), rr = r & 15, cc = c & 31, ob = rr * 64 + cc * 2; return st * 1024 + (ob ^ (((ob >> 9) & 1) << 5)); }
__host__ __device__ __forceinline__ void stage_rc(int b, int& R, int& C) { const int st = b / 1024, sb = b % 1024, swz = sb ^ (((sb >> 9) & 1) << 5); R = (st >> 1) * 16 + swz / 64; C = (st & 1) * 32 + (swz % 64) / 2; }
__host__ __device__ __forceinline__ int perm32(int rho) { const int n = rho >> 4, i = rho & 15; return 8 * (i >> 2) + 4 * n + (i & 3); }

struct Unit { int pm, pn; };
struct Gemm { const bf16_t* A; const bf16_t* Bt; int M, N, K; int lda, ldb; int amask; int astride; };

struct StaticOrder {
    int nM, nN, nwg, G, c;
    __host__ __device__ __forceinline__ void init(int M, int N, int G_, int c_) { nM = M / BM; nN = N / BM; nwg = nM * nN; G = G_; c = c_; }
    __host__ __device__ __forceinline__ bool next(int i, Unit& u) const {
        const long L = (long)i * G + c; if (L >= nwg) return false;
        int wgid = (int)L; { const int q = nwg / NXCD, r = nwg % NXCD, xcd = wgid % NXCD, off = wgid / NXCD; wgid = (xcd < r ? xcd * (q + 1) : r * (q + 1) + (xcd - r) * q) + off; }
        const int nig = WGM * nN, gid = wgid / nig, fm = gid * WGM, gsz = (nM - fm) < WGM ? (nM - fm) : WGM;
        u.pm = fm + ((wgid % nig) % gsz); u.pn = (wgid % nig) / gsz; return true;
    }
    __device__ __forceinline__ void a_ready(const Unit&) const {}
    __device__ __forceinline__ void done(const Unit&) const {}
};
struct CountedOrder : StaticOrder {
    const unsigned* ready; unsigned need; unsigned* tmo;
    __device__ __forceinline__ void a_ready(const Unit& u) const {
        if (threadIdx.x < 64) {
            const unsigned long long t0 = __builtin_amdgcn_s_memrealtime(); unsigned polls = 0;
            while ((unsigned)__builtin_amdgcn_readfirstlane(__hip_atomic_load(ready + 64 * u.pm, __ATOMIC_RELAXED, __HIP_MEMORY_SCOPE_AGENT)) < need) {
                if ((++polls & 255u) == 0u && __builtin_amdgcn_readfirstlane(__hip_atomic_load(tmo, __ATOMIC_RELAXED, __HIP_MEMORY_SCOPE_AGENT)) != 0u) break;
                if (__builtin_amdgcn_s_memrealtime() - t0 > 2000000ull) {
                    if (threadIdx.x == 0) { unsigned expect = 0u; __hip_atomic_compare_exchange_strong(tmo + 1, &expect, 0x600u | (unsigned)(u.pm & 0xff), __ATOMIC_RELAXED, __ATOMIC_RELAXED, __HIP_MEMORY_SCOPE_AGENT); __hip_atomic_store(tmo, 1u, __ATOMIC_RELAXED, __HIP_MEMORY_SCOPE_AGENT); }
                    break; }
                __builtin_amdgcn_s_sleep(2); }
            __builtin_amdgcn_fence(__ATOMIC_ACQUIRE, "agent");
            asm volatile("s_waitcnt vmcnt(0)" ::: "memory");
        }
#if !defined(BROKEN_HOOK_NO_BARRIER)
        asm volatile("" ::: "memory"); __builtin_amdgcn_s_barrier(); asm volatile("" ::: "memory");
#endif
    }
};

__device__ __forceinline__ unsigned cvt_pk_bf16(float lo, float hi) { unsigned r; asm volatile("v_cvt_pk_bf16_f32 %0, %1, %2" : "=v"(r) : "v"(lo), "v"(hi)); return r; }
typedef float f32x2 __attribute__((ext_vector_type(2)));
__device__ __forceinline__ f32x2 gelu_pk(f32x2 v) {
    const f32x2 av = __builtin_elementwise_abs(v), d = av * 0.2316418882f + 1.0f;
    f32x2 t; t.x = __builtin_amdgcn_rcpf(d.x); t.y = __builtin_amdgcn_rcpf(d.y);
    f32x2 q = t * 0.5307027145f + (-0.7265760135f); q = q * t + 0.7107068705f; q = q * t + (-0.142248368f); q = q * t + 0.127414796f; q = q * t;
    const f32x2 s = (v * v) * (-0.72134752044f);
    f32x2 e; e.x = __builtin_amdgcn_exp2f(s.x); e.y = __builtin_amdgcn_exp2f(s.y);
    const f32x2 m = v * (q * e), r = v - m;
    f32x2 o; o.x = v.x < 0.f ? m.x : r.x; o.y = v.y < 0.f ? m.y : r.y; return o;
}

struct EpiF32 {
    static constexpr bool PERM = false, AFTER_DRAIN = false;
    float* C; int ldc; const float* bias;
    __device__ __forceinline__ void operator()(const f32x4 (&acc)[2][2][4][2], const Unit& u, int wr, int wc, int fr, int fq) const {
        const int row0 = u.pm * BM + wr * 64 + fr, col0 = u.pn * BM + wc * 32 + 4 * fq;
        f32x4 bv[2][2];
#pragma unroll
        for (int bj = 0; bj < 2; ++bj)
#pragma unroll
            for (int n = 0; n < 2; ++n) bv[bj][n] = bias ? *(const f32x4*)(bias + col0 + bj * HALF + n * 16) : (f32x4){0.f, 0.f, 0.f, 0.f};
#pragma unroll
        for (int ai = 0; ai < 2; ++ai)
#pragma unroll
            for (int m = 0; m < 4; ++m) { float* rowp = C + (size_t)(row0 + ai * HALF + m * 16) * ldc + col0;
#pragma unroll
                for (int bj = 0; bj < 2; ++bj)
#pragma unroll
                    for (int n = 0; n < 2; ++n) *(f32x4*)(rowp + bj * HALF + n * 16) = acc[ai][bj][m][n] + bv[bj][n]; }
    }
};
template <int ACT  > struct EpiBf16 {
    static constexpr bool PERM = true, AFTER_DRAIN = false;
    bf16_t* O; int ldc; const float* bias; int split_cols; size_t split_stride;
    __device__ __forceinline__ void operator()(const f32x4 (&acc)[2][2][4][2], const Unit& u, int wr, int wc, int fr, int fq) const {
        const int row0 = u.pm * BM + wr * 64 + fr; int colt = u.pn * BM; bf16_t* base = O;
        if (split_cols) { const int t = colt / split_cols; base += (size_t)t * split_stride; colt -= t * split_cols; }
        const int col0 = colt + wc * 32 + 8 * fq, bcol0 = u.pn * BM + wc * 32 + 8 * fq;
        f32x4 bv[2][2];
#pragma unroll
        for (int bj = 0; bj < 2; ++bj)
#pragma unroll
            for (int n = 0; n < 2; ++n) bv[bj][n] = bias ? *(const f32x4*)(bias + bcol0 + bj * HALF + 4 * n) : (f32x4){0.f, 0.f, 0.f, 0.f};
#pragma unroll
        for (int ai = 0; ai < 2; ++ai)
#pragma unroll
            for (int m = 0; m < 4; ++m) { bf16_t* rowp = base + (size_t)(row0 + ai * HALF + m * 16) * ldc + col0;
#pragma unroll
                for (int bj = 0; bj < 2; ++bj) { f32x4 v0 = acc[ai][bj][m][0] + bv[bj][0], v1 = acc[ai][bj][m][1] + bv[bj][1];
                    if (ACT == 1) { f32x2 a = gelu_pk((f32x2){v0[0], v0[1]}), b = gelu_pk((f32x2){v0[2], v0[3]}), c = gelu_pk((f32x2){v1[0], v1[1]}), d = gelu_pk((f32x2){v1[2], v1[3]});
                        v0 = (f32x4){a.x, a.y, b.x, b.y}; v1 = (f32x4){c.x, c.y, d.x, d.y}; }
                    if (ACT == 2) {
#pragma unroll
                        for (int j = 0; j < 4; ++j) { v0[j] = 0.5f * v0[j] * (1.0f + erff(v0[j] * 0.70710678f)); v1[j] = 0.5f * v1[j] * (1.0f + erff(v1[j] * 0.70710678f)); } }
                    u32x4 w; w.x = cvt_pk_bf16(v0[0], v0[1]); w.y = cvt_pk_bf16(v0[2], v0[3]); w.z = cvt_pk_bf16(v1[0], v1[1]); w.w = cvt_pk_bf16(v1[2], v1[3]);
                    *(u32x4*)(rowp + bj * HALF) = w; } }
    }
};

struct RowScale { PG8_LAS const float* rsl; int pm0; const float* ssqp;
    __device__ __forceinline__ float operator()(int row) const { if ((row >> 8) == pm0) return rsl[row & 255];
        const f32x4* p = (const f32x4*)(ssqp + (size_t)row * 32); float s = 0.f;
#pragma unroll
        for (int q = 0; q < 8; ++q) { const f32x4 v = p[q]; s += (v.x + v.y) + (v.z + v.w); }
        return __builtin_amdgcn_rsqf(s * (1.0f / 2048.0f) + 1e-6f); } };
__device__ __forceinline__ float silu_f(float x) { return x * __builtin_amdgcn_rcpf(1.0f + __expf(-x)); }
struct EpiSwiGLU {
    static constexpr bool PERM = true, AFTER_DRAIN = false;
    bf16_t* O; int ldc; RowScale rsc;
    __device__ __forceinline__ void operator()(const f32x4 (&acc)[2][2][4][2], const Unit& u, int wr, int wc, int fr, int fq) const {
        const int row0 = u.pm * BM + wr * 64 + fr, col0 = u.pn * HALF + wc * 32 + 8 * fq;
#pragma unroll
        for (int ai = 0; ai < 2; ++ai)
#pragma unroll
            for (int m = 0; m < 4; ++m) { const int row = row0 + ai * HALF + m * 16; bf16_t* rowp = O + (size_t)row * ldc + col0;
                const float rs = rsc(row), c1 = -1.4426950408889634f * rs, rs2 = rs * rs;
                const f32x4 g0 = acc[ai][0][m][0], g1 = acc[ai][0][m][1], u0 = acc[ai][1][m][0], u1 = acc[ai][1][m][1];
                float r[8];
#pragma unroll
                for (int j = 0; j < 4; ++j) { r[j] = (g0[j] * u0[j]) * rs2 * __builtin_amdgcn_rcpf(1.0f + __builtin_amdgcn_exp2f(g0[j] * c1));
                                              r[4 + j] = (g1[j] * u1[j]) * rs2 * __builtin_amdgcn_rcpf(1.0f + __builtin_amdgcn_exp2f(g1[j] * c1)); }
                u32x4 w; w.x = cvt_pk_bf16(r[0], r[1]); w.y = cvt_pk_bf16(r[2], r[3]); w.z = cvt_pk_bf16(r[4], r[5]); w.w = cvt_pk_bf16(r[6], r[7]);
                *(u32x4*)rowp = w; }
    }
};
struct EpiResid {
    static constexpr bool PERM = true, AFTER_DRAIN = false;
    float* H; int ldc; bf16_t* HB; float* ssqp; PG8_LAS float* red; bool last;
    __device__ __forceinline__ void operator()(const f32x4 (&acc)[2][2][4][2], const Unit& u, int wr, int wc, int fr, int fq) const {
        const int row0 = u.pm * BM + wr * 64 + fr, col0 = u.pn * BM + wc * 32 + 8 * fq;
        PG8_LAS float* myred = red + (wr * 4 + wc) * 384;
        float part[8];
#pragma unroll
        for (int ai = 0; ai < 2; ++ai) {
            u32x4 t[4][2];
#pragma unroll
            for (int m = 0; m < 4; ++m) { const bf16_t* rowp = HB + (size_t)(row0 + ai * HALF + m * 16) * ldc + col0;
#pragma unroll
                for (int bj = 0; bj < 2; ++bj) t[m][bj] = *(const u32x4*)(rowp + bj * HALF); }
            asm volatile("" ::: "memory");
#pragma unroll
            for (int m = 0; m < 4; ++m) { const size_t off = (size_t)(row0 + ai * HALF + m * 16) * ldc + col0; float s = 0.f;
#pragma unroll
                for (int bj = 0; bj < 2; ++bj) { const u32x4 w0 = t[m][bj];
                    const f32x4 h0 = {__builtin_bit_cast(float, w0.x << 16), __builtin_bit_cast(float, w0.x & 0xFFFF0000u), __builtin_bit_cast(float, w0.y << 16), __builtin_bit_cast(float, w0.y & 0xFFFF0000u)};
                    const f32x4 h1 = {__builtin_bit_cast(float, w0.z << 16), __builtin_bit_cast(float, w0.z & 0xFFFF0000u), __builtin_bit_cast(float, w0.w << 16), __builtin_bit_cast(float, w0.w & 0xFFFF0000u)};
                    const f32x4 v0 = h0 + acc[ai][bj][m][0], v1 = h1 + acc[ai][bj][m][1];
                    if (last) { __builtin_nontemporal_store(v0, (f32x4*)(H + off + bj * HALF)); __builtin_nontemporal_store(v1, (f32x4*)(H + off + bj * HALF + 4)); }
                    else { u32x4 w; w.x = cvt_pk_bf16(v0[0], v0[1]); w.y = cvt_pk_bf16(v0[2], v0[3]); w.z = cvt_pk_bf16(v1[0], v1[1]); w.w = cvt_pk_bf16(v1[2], v1[3]); *(u32x4*)(HB + off + bj * HALF) = w; }
                    s += ((v0[0] * v0[0] + v0[1] * v0[1]) + (v0[2] * v0[2] + v0[3] * v0[3])) + ((v1[0] * v1[0] + v1[1] * v1[1]) + (v1[2] * v1[2] + v1[3] * v1[3])); }
                part[ai * 4 + m] = s; }
            asm volatile("" ::: "memory");
        }
        if (last) return;
#pragma unroll
        for (int r = 0; r < 8; ++r) if (fq > 0) myred[(r * 16 + fr) * 3 + (fq - 1)] = part[r];
        asm volatile("s_waitcnt lgkmcnt(0)" ::: "memory");
        if (fq == 0) {
#pragma unroll
            for (int r = 0; r < 8; ++r) { const float s = part[r] + (myred[(r * 16 + fr) * 3 + 0] + myred[(r * 16 + fr) * 3 + 1]) + myred[(r * 16 + fr) * 3 + 2];
                ssqp[(size_t)(row0 + (r >> 2) * HALF + (r & 3) * 16) * 32 + u.pn * 4 + wc] = s; } }
        asm volatile("s_waitcnt lgkmcnt(0)" ::: "memory");
    }
};
struct EpiPlainBf16 {
    static constexpr bool PERM = true, AFTER_DRAIN = false;
    bf16_t* O; int ldc; RowScale rsc; bool scaled;
    __device__ __forceinline__ void operator()(const f32x4 (&acc)[2][2][4][2], const Unit& u, int wr, int wc, int fr, int fq) const {
        const int row0 = u.pm * BM + wr * 64 + fr, col0 = u.pn * BM + wc * 32 + 8 * fq;
#pragma unroll
        for (int ai = 0; ai < 2; ++ai)
#pragma unroll
            for (int m = 0; m < 4; ++m) { const int row = row0 + ai * HALF + m * 16; bf16_t* rowp = O + (size_t)row * ldc + col0;
                const float rs = scaled ? rsc(row) : 1.0f;
#pragma unroll
                for (int bj = 0; bj < 2; ++bj) { const f32x4 v0 = acc[ai][bj][m][0] * rs, v1 = acc[ai][bj][m][1] * rs;
                    u32x4 w; w.x = cvt_pk_bf16(v0[0], v0[1]); w.y = cvt_pk_bf16(v0[2], v0[3]); w.z = cvt_pk_bf16(v1[0], v1[1]); w.w = cvt_pk_bf16(v1[2], v1[3]);
                    *(u32x4*)(rowp + bj * HALF) = w; } }
    }
};
struct EpiSlots {
    static constexpr bool PERM = true, AFTER_DRAIN = false;
    bf16_t* O; int Mrows; RowScale rsc;
    __device__ __forceinline__ void operator()(const f32x4 (&acc)[2][2][4][2], const Unit& u, int wr, int wc, int fr, int fq) const {
        const int row0 = u.pm * BM + wr * 64 + fr, d0 = wc * 32 + 8 * fq;
#pragma unroll
        for (int ai = 0; ai < 2; ++ai)
#pragma unroll
            for (int m = 0; m < 4; ++m) { const float rs = rsc(row0 + ai * HALF + m * 16);
#pragma unroll
                for (int bj = 0; bj < 2; ++bj) { const f32x4 v0 = acc[ai][bj][m][0] * rs, v1 = acc[ai][bj][m][1] * rs;
                    bf16_t* p = O + ((size_t)(2 * u.pn + bj) * Mrows + (row0 + ai * HALF + m * 16)) * 128 + d0;
                    u32x4 w; w.x = cvt_pk_bf16(v0[0], v0[1]); w.y = cvt_pk_bf16(v0[2], v0[3]); w.z = cvt_pk_bf16(v1[0], v1[1]); w.w = cvt_pk_bf16(v1[2], v1[3]);
                    *(u32x4*)p = w; } }
    }
};
struct EpiSiluBias {
    static constexpr bool PERM = true, AFTER_DRAIN = false;
    bf16_t* O; int ldc; const float* bias;
    __device__ __forceinline__ void operator()(const f32x4 (&acc)[2][2][4][2], const Unit& u, int wr, int wc, int fr, int fq) const {
        const int row0 = u.pm * BM + wr * 64 + fr, col0 = u.pn * BM + wc * 32 + 8 * fq;
        f32x4 bv[2][2];
#pragma unroll
        for (int bj = 0; bj < 2; ++bj)
#pragma unroll
            for (int n = 0; n < 2; ++n) bv[bj][n] = *(const f32x4*)(bias + col0 + bj * HALF + 4 * n);
#pragma unroll
        for (int ai = 0; ai < 2; ++ai)
#pragma unroll
            for (int m = 0; m < 4; ++m) { bf16_t* rowp = O + (size_t)(row0 + ai * HALF + m * 16) * ldc + col0;
#pragma unroll
                for (int bj = 0; bj < 2; ++bj) { const f32x4 v0 = acc[ai][bj][m][0] + bv[bj][0], v1 = acc[ai][bj][m][1] + bv[bj][1];
                    u32x4 w; w.x = cvt_pk_bf16(silu_f(v0[0]), silu_f(v0[1])); w.y = cvt_pk_bf16(silu_f(v0[2]), silu_f(v0[3])); w.z = cvt_pk_bf16(silu_f(v1[0]), silu_f(v1[1])); w.w = cvt_pk_bf16(silu_f(v1[2]), silu_f(v1[3]));
                    *(u32x4*)(rowp + bj * HALF) = w; } }
    }
};

template <class Epi, class Sched, bool STAMP = false>
__device__ __forceinline__ void gemm_phase(PG8_LAS unsigned char* lds, const Gemm g, const Sched& S, const Epi& E, unsigned long long* stamps, int tid_in) {
    int tid_ = tid_in; asm volatile("" : "+v"(tid_));
    const int tid = tid_, wid = __builtin_amdgcn_readfirstlane(tid >> 6), lane = tid & 63, wr = wid >> 2, wc = wid & 3, fr = lane & 15, fq = lane >> 4;
    const int K = g.K, nt = K / BK;
    int ts_lo = 0, ts_hi = 0, nts = 0; const unsigned long long rt_entry = STAMP ? (unsigned long long)wall_clock64() : 0ull;
#define PG8_STAMP() do { if (STAMP && wid == 0 && nts < 64) { const unsigned long long _c = (unsigned long long)clock64(); \
        ts_lo = (lane == nts) ? (int)(unsigned)_c : ts_lo; ts_hi = (lane == nts) ? (int)(unsigned)(_c >> 32) : ts_hi; ++nts; } } while (0)
    PG8_STAMP();
    unsigned voffA[2], voffB[2];
#pragma unroll
    for (int i = 0; i < 2; ++i) { int R, C; stage_rc(tid * 16 + i * 8192, R, C); const int Rb = Epi::PERM ? ((R & ~31) + perm32(R & 31)) : R;
        voffA[i] = (unsigned)(R * g.lda + C) * 2u; voffB[i] = (unsigned)(Rb * g.ldb + C) * 2u; }
    const size_t kstep = (size_t)(BK * 2);
    const size_t hstepA = (size_t)HALF * g.lda * 2, hstepB = (size_t)HALF * g.ldb * 2;
    const size_t tstepA = 2 * hstepA, tstepB = 2 * hstepB;
    const unsigned ldsw = (unsigned)wid * 1024u;
    const int aoff = lds_byte(wr * 64 + fr, fq * 8), boff = lds_byte(wc * 32 + fr, fq * 8);
#define PG8_SA(b, h) (((b) * 2 + (h)) * HTB)
#define PG8_SB(b, h) ((4 + (b) * 2 + (h)) * HTB)
#define PG8_STAGE(bufoff, gbase, voff) do { _Pragma("unroll") for (int _i = 0; _i < 2; ++_i) \
        __builtin_amdgcn_global_load_lds((const unsigned*)((const char*)(gbase) + (voff)[_i]), (PG8_LAS unsigned*)(lds + (bufoff) + ldsw + _i * 8192), 16, 0, 0); } while (0)
#define PG8_LDA(dst, b, h) do { _Pragma("unroll") for (int m = 0; m < 4; ++m) _Pragma("unroll") for (int k = 0; k < 2; ++k) dst[m][k] = *(const PG8_LAS bf16x8*)(lds + PG8_SA(b, h) + aoff + m * 2048 + k * 1024); } while (0)
#define PG8_LDB(dst, b, h) do { _Pragma("unroll") for (int n = 0; n < 2; ++n) _Pragma("unroll") for (int k = 0; k < 2; ++k) dst[n][k] = *(const PG8_LAS bf16x8*)(lds + PG8_SB(b, h) + boff + n * 2048 + k * 1024); } while (0)
#define PG8_MMA(ai, bj, At, Bt) do { __builtin_amdgcn_s_setprio(1); _Pragma("unroll") for (int m = 0; m < 4; ++m) _Pragma("unroll") for (int n = 0; n < 2; ++n) _Pragma("unroll") for (int k = 0; k < 2; ++k) \
        acc[ai][bj][m][n] = __builtin_amdgcn_mfma_f32_16x16x32_bf16(Bt[n][k], At[m][k], acc[ai][bj][m][n], 0, 0, 0); __builtin_amdgcn_s_setprio(0); } while (0)
#define PG8_WAIT_V(n) asm volatile("s_waitcnt vmcnt(" #n ")" ::: "memory")
#define PG8_WAIT_L(n) asm volatile("s_waitcnt lgkmcnt(" #n ")" ::: "memory")
#define PG8_BAR __builtin_amdgcn_s_barrier()
#define PG8_SCHED __builtin_amdgcn_sched_barrier(0)
    Unit cur, nxt; int ui = 0;
    if (!S.next(0, cur)) return;
    f32x4 acc[2][2][4][2];
#pragma unroll
    for (int a = 0; a < 2; ++a)
#pragma unroll
        for (int b = 0; b < 2; ++b)
#pragma unroll
            for (int m = 0; m < 4; ++m)
#pragma unroll
                for (int n = 0; n < 2; ++n) acc[a][b][m][n] = (f32x4){0.f, 0.f, 0.f, 0.f};
    bf16x8 At[4][2], B0[2][2], B1[2][2];
    const char* cA = (const char*)g.A + (size_t)cur.pm * tstepA + (size_t)((cur.pn & g.amask) * g.astride) * 2; const char* cB = (const char*)g.Bt + (size_t)cur.pn * tstepB;
    S.a_ready(cur);
    PG8_STAGE(PG8_SB(0, 0), cB, voffB); PG8_STAGE(PG8_SA(0, 0), cA, voffA); PG8_STAGE(PG8_SB(0, 1), cB + hstepB, voffB); PG8_STAGE(PG8_SA(0, 1), cA + hstepA, voffA);
    if (wr == 1) PG8_BAR;
    PG8_WAIT_V(4); PG8_BAR;
    PG8_STAGE(PG8_SB(1, 0), cB + kstep, voffB); PG8_STAGE(PG8_SA(1, 0), cA + kstep, voffA); PG8_STAGE(PG8_SB(1, 1), cB + hstepB + kstep, voffB);
    PG8_WAIT_V(6); PG8_BAR;
    PG8_STAMP();
    for (;;) {
        const bool has_next = S.next(ui + 1, nxt);
        const char* nA = has_next ? (const char*)g.A + (size_t)nxt.pm * tstepA + (size_t)((nxt.pn & g.amask) * g.astride) * 2 : cA; const char* nB = has_next ? (const char*)g.Bt + (size_t)nxt.pn * tstepB : cB;
        for (int t = 0; t < nt; t += 2) {
            const bool last = (t == nt - 2);
            const char* a1 = cA + (size_t)(t + 1) * kstep;
            const char* a2 = last ? nA : cA + (size_t)(t + 2) * kstep; const char* b2 = last ? nB : cB + (size_t)(t + 2) * kstep;
            const char* a3 = a2 + kstep; const char* b3 = b2 + kstep;
            if (last && has_next) S.a_ready(nxt);
            PG8_LDB(B0, 0, 0); PG8_SCHED; PG8_LDA(At, 0, 0); PG8_STAGE(PG8_SA(1, 1), a1 + hstepA, voffA);
            PG8_WAIT_L(8); PG8_BAR; PG8_WAIT_L(0); PG8_MMA(0, 0, At, B0); PG8_BAR; PG8_SCHED;
            PG8_LDB(B1, 0, 1); PG8_STAGE(PG8_SB(0, 0), b2, voffB);
            PG8_BAR; PG8_WAIT_L(0); PG8_MMA(0, 1, At, B1); PG8_BAR;
            PG8_LDA(At, 0, 1); PG8_STAGE(PG8_SA(0, 0), a2, voffA);
            PG8_BAR; PG8_WAIT_L(0); PG8_MMA(1, 0, At, B0); PG8_BAR; PG8_SCHED;
            PG8_STAGE(PG8_SB(0, 1), b2 + hstepB, voffB);
            PG8_WAIT_V(6); PG8_BAR; PG8_MMA(1, 1, At, B1); PG8_BAR;
            PG8_LDB(B0, 1, 0); PG8_SCHED; PG8_LDA(At, 1, 0); PG8_STAGE(PG8_SA(0, 1), a2 + hstepA, voffA);
            PG8_WAIT_L(8); PG8_BAR; PG8_WAIT_L(0); PG8_MMA(0, 0, At, B0); PG8_BAR; PG8_SCHED;
            PG8_LDB(B1, 1, 1); PG8_STAGE(PG8_SB(1, 0), b3, voffB);
            PG8_BAR; PG8_WAIT_L(0); PG8_MMA(0, 1, At, B1); PG8_BAR;
            PG8_LDA(At, 1, 1); PG8_STAGE(PG8_SA(1, 0), a3, voffA);
            PG8_BAR; PG8_WAIT_L(0); PG8_MMA(1, 0, At, B0); PG8_BAR; PG8_SCHED;
            PG8_STAGE(PG8_SB(1, 1), b3 + hstepB, voffB);
            PG8_WAIT_V(6); PG8_BAR; PG8_MMA(1, 1, At, B1); PG8_BAR;
        }
        PG8_STAMP();
        if constexpr (!Epi::AFTER_DRAIN) { E(acc, cur, wr, wc, fr, fq); S.done(cur); }
        PG8_STAMP();
        if (!has_next) break;
#pragma unroll
        for (int a = 0; a < 2; ++a)
#pragma unroll
            for (int b = 0; b < 2; ++b)
#pragma unroll
                for (int m = 0; m < 4; ++m)
#pragma unroll
                    for (int n = 0; n < 2; ++n) acc[a][b][m][n] = (f32x4){0.f, 0.f, 0.f, 0.f};
        cur = nxt; cA = nA; cB = nB; ++ui;
    }
    PG8_WAIT_V(0);
    if (wr == 0) PG8_BAR;
    PG8_BAR;
    if constexpr (Epi::AFTER_DRAIN) { E.fused(acc, cur, wr, wc, fr, fq, lds, wid, lane); S.done(cur); }
    PG8_STAMP();
    if (STAMP && wid == 0) { stamps[lane] = lane < nts ? (((unsigned long long)(unsigned)ts_hi << 32) | (unsigned)ts_lo) : 0ull;
        if (lane == 62) stamps[62] = rt_entry; if (lane == 63) stamps[63] = (unsigned long long)wall_clock64(); }
#undef PG8_STAMP
#undef PG8_SA
#undef PG8_SB
#undef PG8_STAGE
#undef PG8_LDA
#undef PG8_LDB
#undef PG8_MMA
#undef PG8_WAIT_V
#undef PG8_WAIT_L
#undef PG8_BAR
#undef PG8_SCHED
}
}

using pg8::Gemm; using pg8::StaticOrder; using pg8::gemm_phase;

constexpr size_t MiB = 1u << 20;
constexpr size_t WS_CTL = 0, CTL_ZERO_BYTES = 1 * MiB;
constexpr int CW_BAR = 4096;
constexpr size_t GU_BYTES = (size_t)2 * FF * D * 2, DN_BYTES = (size_t)D * FF * 2, ABIN_BYTES = (size_t)AB_N * D * 2, SQ_BYTES = (size_t)D * D * 2, CIN_BYTES = (size_t)C_N * D * 2;
constexpr size_t CMP1_BYTES = (size_t)256 * 4096 * 2, WQK_BYTES = (size_t)2048 * 256 * 2;
constexpr size_t WS_WGU = 1 * MiB;
constexpr size_t WS_WD = WS_WGU + 8 * GU_BYTES;
constexpr size_t WS_WABIN = WS_WD + 8 * DN_BYTES;
constexpr size_t WS_WABOUT = WS_WABIN + 2 * ABIN_BYTES;
constexpr size_t WS_WCIN = WS_WABOUT + 2 * SQ_BYTES;
constexpr size_t WS_WCOUT = WS_WCIN + 2 * CIN_BYTES;
constexpr size_t WS_WCMP1 = WS_WCOUT + 2 * SQ_BYTES;
constexpr size_t WS_WQK = WS_WCMP1 + 4 * CMP1_BYTES;
constexpr int ROPE_ROWS = 8208;
constexpr size_t WS_ROPE = WS_WQK + 2 * WQK_BYTES;
constexpr size_t WS_CB = WS_ROPE + 5 * MiB;
constexpr size_t WS_WSK = WS_CB + 64 * 1024;
constexpr size_t WS_HN = WS_CB + 2 * MiB;
static_assert(WS_WSK + (size_t)4 * 64 * D * 2 <= WS_HN, "skinny weights");
constexpr size_t WS_ACT = WS_HN + 64 * MiB;
constexpr size_t WS_MIX = WS_ACT + 224 * MiB;
constexpr size_t MX_C = 0, MX_QK = 32 * MiB, MX_CST = 96 * MiB, MX_SST = 224 * MiB, MX_Y = 288 * MiB, MX_GIF = 352 * MiB, MX_NST = 353 * MiB, MX_SCL = 354 * MiB, MX_HDEC = 355 * MiB;
constexpr size_t MX_GP = 0, MX_HID = 4 * MiB, MX_KCMP = 8 * MiB, MX_VCMP = 9 * MiB, MX_O = 288 * MiB;
constexpr size_t WS_SSQP = WS_MIX + 356 * MiB;
constexpr size_t SSQP_V = (size_t)T * 32 * 4;
constexpr size_t WS_END = WS_SSQP + 28 * MiB;
static_assert(WS_ROPE + (size_t)ROPE_ROWS * 64 * 2 * 4 <= WS_CB, "rope table");

__device__ __forceinline__ float ssqp_rstd(const float* ssqp, int row) {
    const f32x4* p = (const f32x4*)(ssqp + (size_t)row * 32); float s = 0.f;
#pragma unroll
    for (int q = 0; q < 8; ++q) { const f32x4 v = p[q]; s += (v.x + v.y) + (v.z + v.w); }
    return __builtin_amdgcn_rsqf(s * (1.0f / 2048.0f) + 1e-6f);
}
constexpr int NWAVES = 8, NTHREADS = 512;
constexpr int LDS_BYTES = 147456;
constexpr int RING_BYTES = 131072, MISC_OFF = RING_BYTES + 320, RED_OFF = RING_BYTES + 1024;

struct Args { const float* in[31]; float* out; unsigned char* ws; int ph_lo, ph_hi; };
static_assert(sizeof(Args) == 31 * 8 + 8 + 8 + 8, "Args has no padding");

typedef const Args __attribute__((address_space(4)))* CArgsP;
struct Frame {
    LAS unsigned char* lds;
    int tid, lane, wave, G, bx, gw, NGW;
};
__device__ __forceinline__ Frame make_frame(unsigned char* lds_raw, int wave_s) {
    Frame F; int w = wave_s, bx = blockIdx.x, G = gridDim.x;
    asm volatile("" : "+s"(w)); asm volatile("" : "+s"(bx)); asm volatile("" : "+s"(G));
    int tid = w * 64 + lane_id(); asm volatile("" : "+v"(tid));
    F.lds = (LAS unsigned char*)lds_raw; F.tid = tid; F.lane = tid & 63; F.wave = w;
    F.G = G; F.bx = bx; F.gw = bx * NWAVES + F.wave; F.NGW = G * NWAVES;
    return F;
}
__device__ __forceinline__ CArgsP get_args() { CArgsP p = (CArgsP)__builtin_amdgcn_kernarg_segment_ptr(); asm volatile("" : "+s"(p)); return p; }
#define LDS_WAIT() asm volatile("s_waitcnt lgkmcnt(0)" ::: "memory")

struct Job { const float* src; int ldn, K, col0, ncols; bf16_t* dst; int dst_ld, row0, mode; float scale; const float* kgain; };
constexpr int NJOBS = 64;
__device__ __forceinline__ Job make_job(int j, CArgsP ap) {
    Job J; J.scale = 1.0f; J.row0 = 0; J.mode = 0; J.col0 = 0; J.kgain = nullptr;
    unsigned char* ws = ap->ws;
    if (j < 24) { const int f = j / 3, kind = j % 3, layer = f >> 1, half = f & 1;
        if (kind < 2) { J.src = ap->in[(half ? 7 : 2) + kind] + (size_t)layer * D * FF; J.ldn = FF; J.K = D; J.ncols = FF; J.dst = (bf16_t*)(ws + WS_WGU + (size_t)f * GU_BYTES); J.dst_ld = D; J.mode = 1 + kind; J.kgain = ap->in[half ? 6 : 1] + (size_t)layer * D; }
        else { J.src = ap->in[half ? 9 : 4] + (size_t)layer * FF * D; J.ldn = D; J.K = FF; J.ncols = D; J.dst = (bf16_t*)(ws + WS_WD + (size_t)f * DN_BYTES); J.dst_ld = FF; J.scale = 0.5f; }
    } else if (j < 38) { const int q = j - 24, l = q / 7, seg = q % 7;
        J.src = ap->in[10] + (size_t)l * D * AB_COLS; J.ldn = AB_COLS; J.K = D; J.col0 = seg < 3 ? seg * 1024 : 3080 + (seg - 3) * 1024; J.ncols = 1024;
        J.dst = (bf16_t*)(ws + WS_WABIN + (size_t)l * ABIN_BYTES); J.dst_ld = D; J.row0 = seg * 1024; J.kgain = ap->in[5] + (size_t)(2 * l) * D;
    } else if (j < 40) { const int l = j - 38; J.src = ap->in[11] + (size_t)l * D * D; J.ldn = D; J.K = D; J.ncols = D; J.dst = (bf16_t*)(ws + WS_WABOUT + (size_t)l * SQ_BYTES); J.dst_ld = D;
    } else if (j < 42) { const int l = j - 40; J.src = ap->in[22] + (size_t)l * D * C_COLS; J.ldn = C_COLS; J.K = D; J.ncols = C_N; J.dst = (bf16_t*)(ws + WS_WCIN + (size_t)l * CIN_BYTES); J.dst_ld = D; J.kgain = ap->in[5] + (size_t)(2 * l + 1) * D;
    } else if (j < 44) { const int l = j - 42; J.src = ap->in[23] + (size_t)l * D * D; J.ldn = D; J.K = D; J.ncols = D; J.dst = (bf16_t*)(ws + WS_WCOUT + (size_t)l * SQ_BYTES); J.dst_ld = D;
    } else if (j < 48) { const int q = j - 44; J.src = ap->in[27] + (size_t)q * 4096 * 256; J.ldn = 256; J.K = 4096; J.ncols = 256; J.dst = (bf16_t*)(ws + WS_WCMP1 + (size_t)q * CMP1_BYTES); J.dst_ld = 4096;
    } else { const int q = j - 48, l = q / 8, r = q % 8, isk = r / 4, hh = r % 4;
        J.src = ap->in[isk ? 15 : 14] + (size_t)(l * 4 + hh) * 65536; J.ldn = 256; J.K = 256; J.ncols = 256; J.dst = (bf16_t*)(ws + WS_WQK + (size_t)l * WQK_BYTES); J.dst_ld = 256; J.row0 = isk * 1024 + hh * 256; J.scale = isk ? 0.0625f : 1.0f; }
    return J;
}
__device__ __forceinline__ void transpose_item(const Job& J, LAS float* scr, int item, int lane) {
    const int nblk = J.ncols / 64, kb = item / nblk, nb = item % nblk, k0 = 64 * kb, n0 = 64 * nb;
    const float* W = J.src + J.col0 + n0 + 4 * (lane & 15);
    f32x4 wv[16];
#pragma unroll
    for (int i = 0; i < 16; ++i) { const int kk = 4 * i + (lane >> 4); wv[i] = __builtin_nontemporal_load((const f32x4*)(W + (size_t)(k0 + kk) * J.ldn)); }
#pragma unroll
    for (int i = 0; i < 16; ++i) { const int kk = 4 * i + (lane >> 4); *(LAS f32x4*)(scr + kk * 64 + (((lane & 15) ^ ((kk >> 3) & 7)) << 2)) = wv[i]; }
    LDS_WAIT();
    const int c = lane & 7;
    const int drow0 = J.mode == 0 ? J.row0 + n0 : (n0 >> 7) * 256 + (n0 & 127) + (J.mode == 2 ? 128 : 0);
    const float sc = J.scale;
    f32x4 g0 = (f32x4){sc, sc, sc, sc}, g1 = g0;
    if (J.kgain) { g0 = *(const f32x4*)(J.kgain + k0 + 8 * c) * sc; g1 = *(const f32x4*)(J.kgain + k0 + 8 * c + 4) * sc; }
#pragma unroll
    for (int jj = 0; jj < 8; ++jj) { const int n = (lane >> 3) + 8 * jj; const LAS float* s = scr + (8 * c) * 64 + ((((n >> 2) ^ c) << 2) | (n & 3));
        v4u o; o.x = pk2(s[0 * 64] * g0.x, s[1 * 64] * g0.y); o.y = pk2(s[2 * 64] * g0.z, s[3 * 64] * g0.w); o.z = pk2(s[4 * 64] * g1.x, s[5 * 64] * g1.y); o.w = pk2(s[6 * 64] * g1.z, s[7 * 64] * g1.w);
        __builtin_nontemporal_store(o, (v4u*)(J.dst + (size_t)(drow0 + n) * J.dst_ld + k0 + 8 * c)); }
    LDS_WAIT();
}
__device__ __forceinline__ void ph_prologue(Frame& F, CArgsP ap) {
    LAS float* scr = (LAS float*)(F.lds + F.wave * 16384);
    for (int j = 0; j < NJOBS; ++j) {
        const Job J = make_job(j, ap);
        const int nitems = (J.K / 64) * (J.ncols / 64);
        for (int it = F.gw; it < nitems; it += F.NGW) transpose_item(J, scr, it, F.lane);
    }
    float* rope = (float*)(ap->ws + WS_ROPE);
    for (int idx = F.bx * NTHREADS + F.tid; idx < ROPE_ROWS * 64; idx += F.G * NTHREADS) {
        const int p = idx >> 6, i = idx & 63;
        const float inv = powf(10000.0f, -(float)i / 64.0f), ang = (float)p * inv;
        float sn, cs; sincosf(ang, &sn, &cs);
        rope[2 * idx] = cs; rope[2 * idx + 1] = sn;
    }
    float* cb = (float*)(ap->ws + WS_CB);
    for (int idx = F.gw; idx < 4 * 256; idx += F.NGW) {
        const int q = idx >> 8, c = idx & 255;
        const float* pos = ap->in[26] + (size_t)q * 4096; const float* w1 = ap->in[27] + (size_t)q * 4096 * 256 + c;
        float s = 0.f;
#pragma unroll 16
        for (int f = F.lane; f < 4096; f += 64) s += pos[f] * w1[(size_t)f * 256];
        s = wave_sum(s);
        if (F.lane == 0) cb[idx] = s + ap->in[28][idx];
    }
    { bf16_t* wsk = (bf16_t*)(ap->ws + WS_WSK);
      for (int idx = F.bx * NTHREADS + F.tid; idx < 4 * 64 * D; idx += F.G * NTHREADS) {
          const int q = idx / (64 * D), r = idx - q * 64 * D, n = r / D, k = r - n * D;
          const float* src = q < 2 ? ap->in[10] + (size_t)q * D * AB_COLS + (size_t)k * AB_COLS + 3072 : ap->in[22] + (size_t)(q - 2) * D * C_COLS + (size_t)k * C_COLS + 5120;
          const int nj = q < 2 ? 8 : 48;
          const float gk = ap->in[5][(size_t)(q < 2 ? 2 * q : 2 * (q - 2) + 1) * D + k];
          wsk[idx] = n < nj ? (bf16_t)f2bf(src[n] * gk) : (bf16_t)0; } }
    { bf16_t* HB = (bf16_t*)(ap->ws + WS_HN); float* ssq0 = (float*)(ap->ws + WS_SSQP);
      for (int row = F.gw; row < T; row += F.NGW) {
          const f32x4* xr = (const f32x4*)(ap->in[0] + (size_t)row * D) + F.lane; v2u* o8 = (v2u*)(HB + (size_t)row * D) + F.lane;
          float s = 0.f;
#pragma unroll
          for (int j = 0; j < 8; ++j) { const f32x4 v = __builtin_nontemporal_load(xr + 64 * j); v2u o; o.x = pk2(v.x, v.y); o.y = pk2(v.z, v.w); o8[64 * j] = o; s += (v.x * v.x + v.y * v.y) + (v.z * v.z + v.w * v.w); }
          s = wave_sum(s);
          if (F.lane < 32) ssq0[(size_t)row * 32 + F.lane] = F.lane == 0 ? s : 0.f; } }
}

template <int NJ>
__device__ __forceinline__ void ph_skinny(Frame& F, const bf16_t* HB, const float* ssqp, const bf16_t* Wsk, float* outp) {
    for (int blk = F.bx; blk < T / 64; blk += F.G) {
        const int lane = F.lane, l15 = lane & 15, quad = lane >> 4, mt = F.wave >> 1, nt0 = (F.wave & 1) * 2;
        const bf16_t* ap_ = HB + (size_t)(blk * 64 + mt * 16 + l15) * D + 8 * quad;
        const bf16_t* b0p = Wsk + (size_t)(nt0 * 16 + l15) * D + 8 * quad; const bf16_t* b1p = b0p + (size_t)16 * D;
        f32x4 a0 = (f32x4){0.f, 0.f, 0.f, 0.f}, a1 = (f32x4){0.f, 0.f, 0.f, 0.f};
        const bool t0on = nt0 * 16 < NJ, t1on = (nt0 + 1) * 16 < NJ;
        if (t0on && t1on) {
#pragma unroll 8
            for (int ks = 0; ks < D / 32; ++ks) { const bf16x8 a = *(const bf16x8*)(ap_ + 32 * ks), b0 = *(const bf16x8*)(b0p + 32 * ks), b1 = *(const bf16x8*)(b1p + 32 * ks);
                a0 = __builtin_amdgcn_mfma_f32_16x16x32_bf16(a, b0, a0, 0, 0, 0); a1 = __builtin_amdgcn_mfma_f32_16x16x32_bf16(a, b1, a1, 0, 0, 0); }
        } else if (t0on) {
#pragma unroll 8
            for (int ks = 0; ks < D / 32; ++ks) { const bf16x8 a = *(const bf16x8*)(ap_ + 32 * ks), b0 = *(const bf16x8*)(b0p + 32 * ks);
                a0 = __builtin_amdgcn_mfma_f32_16x16x32_bf16(a, b0, a0, 0, 0, 0); }
        }
#pragma unroll
        for (int e = 0; e < 4; ++e) { const int row = blk * 64 + mt * 16 + 4 * quad + e; const int c0 = nt0 * 16 + l15, c1 = c0 + 16;
            const float rs = ssqp_rstd(ssqp, row);
            if (c0 < NJ) outp[(size_t)row * NJ + c0] = a0[e] * rs; if (c1 < NJ) outp[(size_t)row * NJ + c1] = a1[e] * rs; }
    }
}

__device__ __forceinline__ void panel_rstd(Frame& F, const float* ssqp, int pm, LAS float* rsl) {
    const int row = pm * 256 + (F.tid >> 1); const f32x4* p = (const f32x4*)(ssqp + (size_t)row * 32 + (F.tid & 1) * 16); float s = 0.f;
#pragma unroll
    for (int q = 0; q < 4; ++q) { const f32x4 v = p[q]; s += (v.x + v.y) + (v.z + v.w); }
    const float o = DPP_F(s, 0xB1);
    const float t = (F.tid & 1) ? o + s : s + o;
    if ((F.tid & 1) == 0) rsl[F.tid >> 1] = __builtin_amdgcn_rsqf(t * (1.0f / 2048.0f) + 1e-6f);
    __syncthreads();
}

__device__ __forceinline__ void unpack8(const v4u u, float (&f)[8]) { f[0] = bflo(u.x); f[1] = bfhi(u.x); f[2] = bflo(u.y); f[3] = bfhi(u.y); f[4] = bflo(u.z); f[5] = bfhi(u.z); f[6] = bflo(u.w); f[7] = bfhi(u.w); }
__device__ __forceinline__ void ph_conv(Frame& F, const bf16_t* P, const float* cw, const float* cbias, bf16_t* cbuf) {
    const int idx0 = F.bx * NTHREADS + F.tid, c0 = (idx0 & 127) * 8, stride = F.G * NTHREADS;
    if ((stride & 127) != 0) {
        for (int idx = idx0; idx < T * 128; idx += stride) { const int t = idx >> 7, cc = (idx & 127) * 8, tl = t & (SEQ - 1); float acc[8];
#pragma unroll
            for (int e = 0; e < 8; ++e) acc[e] = cbias[cc + e];
#pragma unroll
            for (int jj = 0; jj < 4; ++jj) { if (tl - 3 + jj >= 0) { float uf[8]; unpack8(*(const v4u*)(P + (size_t)(t - 3 + jj) * AB_N + cc), uf);
#pragma unroll
                    for (int e = 0; e < 8; ++e) acc[e] += uf[e] * cw[jj * 1024 + cc + e]; } }
            v4u o; o.x = pk2(siluf_(acc[0]), siluf_(acc[1])); o.y = pk2(siluf_(acc[2]), siluf_(acc[3])); o.z = pk2(siluf_(acc[4]), siluf_(acc[5])); o.w = pk2(siluf_(acc[6]), siluf_(acc[7]));
            *(v4u*)(cbuf + (size_t)t * 1024 + cc) = o; }
        return; }
    float wt[4][8], bs[8];
#pragma unroll
    for (int e = 0; e < 8; ++e) { bs[e] = cbias[c0 + e];
#pragma unroll
        for (int jj = 0; jj < 4; ++jj) wt[jj][e] = cw[jj * 1024 + c0 + e]; }
    const int tstride = stride >> 7;
    for (int t0 = idx0 >> 7; t0 < T; t0 += 4 * tstride) {
        v4u in[4][4];
#pragma unroll
        for (int u = 0; u < 4; ++u) { const int t = t0 + u * tstride, tl = t & (SEQ - 1);
#pragma unroll
            for (int jj = 0; jj < 4; ++jj) { in[u][jj] = (v4u){0u, 0u, 0u, 0u}; if (t < T && tl - 3 + jj >= 0) in[u][jj] = *(const v4u*)(P + (size_t)(t - 3 + jj) * AB_N + c0); } }
#pragma unroll
        for (int u = 0; u < 4; ++u) { const int t = t0 + u * tstride;
            if (t < T) { float acc[8];
#pragma unroll
                for (int e = 0; e < 8; ++e) acc[e] = bs[e];
#pragma unroll
                for (int jj = 0; jj < 4; ++jj) { float uf[8]; unpack8(in[u][jj], uf);
#pragma unroll
                    for (int e = 0; e < 8; ++e) acc[e] += uf[e] * wt[jj][e]; }
                v4u o; o.x = pk2(siluf_(acc[0]), siluf_(acc[1])); o.y = pk2(siluf_(acc[2]), siluf_(acc[3])); o.z = pk2(siluf_(acc[4]), siluf_(acc[5])); o.w = pk2(siluf_(acc[6]), siluf_(acc[7]));
                *(v4u*)(cbuf + (size_t)t * 1024 + c0) = o; } }
    }
}

#ifndef CK_DUP_ML3
#define CK_DUP_ML3 0
#endif
#ifndef CK_DUP_HG3
#define CK_DUP_HG3 0
#endif
namespace ck {
typedef short s16x4 __attribute__((ext_vector_type(4)));
constexpr int CL = 64;
constexpr int NCH = SEQ / CL;
constexpr int NU_ML = BATCH * 4 * NCH, NU_HG = BATCH * 8 * NCH;
__device__ __forceinline__ bf16x8 frag_rowk(const LAS bf16_t* base, int pitch, int r0, int k0, int lane) { return *(const LAS bf16x8*)(base + (r0 + (lane & 15)) * pitch + k0 + 8 * (lane >> 4)); }
__device__ __forceinline__ bf16x8 frag_rowk_g(const bf16_t* base, int ld, int r0, int k0, int lane) { return *(const bf16x8*)(base + (size_t)(r0 + (lane & 15)) * ld + k0 + 8 * (lane >> 4)); }
__device__ __forceinline__ bf16x8 frag_tr(const LAS bf16_t* base, int pitch, int k0, int c0, int lane) {
    const int i = lane & 15, quad = lane >> 4;
    const unsigned a0 = (unsigned)(uintptr_t)(base + (k0 + 8 * quad + (i >> 2)) * pitch + c0 + 4 * (i & 3));
    s16x4 lo, hi;
    asm volatile("ds_read_b64_tr_b16 %0, %1" : "=&v"(lo) : "v"(a0) : "memory");
    asm volatile("ds_read_b64_tr_b16 %0, %1" : "=&v"(hi) : "v"(a0 + (unsigned)(4 * pitch * 2)) : "memory");
    asm volatile("s_waitcnt lgkmcnt(0)" : "+v"(lo), "+v"(hi) :: "memory");
    return (bf16x8){lo[0], lo[1], lo[2], lo[3], hi[0], hi[1], hi[2], hi[3]};
}
#define MMA16(a, b, c) __builtin_amdgcn_mfma_f32_16x16x32_bf16((a), (b), (c), 0, 0, 0)
__device__ __forceinline__ float log_sig(float x) { return fminf(x, 0.f) - log1pf(expf(-fabsf(x))); }
__device__ __forceinline__ void hg_gate(float z, float one_minus_lb, float& k2, float& lf) {
    const float e = __expf(-fabsf(z)), r = __builtin_amdgcn_rcpf(1.0f + e), sp = __logf(1.0f + e);
    k2 = one_minus_lb * (z >= 0.f ? e * r : r);
    const float t = fminf(k2, 0.999999f);
    const float la = t < 0.0625f ? -t * (1.0f + t * (0.5f + t * (0.33333334f + t * 0.25f))) : __logf(1.0f - t);
    lf = fmaxf(la, fminf(z, 0.f) - sp);
}
__device__ __forceinline__ float wave_scan_add(float x, LAS float* sc, int lane) {
#pragma unroll
    for (int o = 1; o < 64; o <<= 1) { sc[lane] = x; asm volatile("s_waitcnt lgkmcnt(0)" ::: "memory"); const float y = sc[lane >= o ? lane - o : lane]; asm volatile("s_waitcnt lgkmcnt(0)" ::: "memory"); x += lane >= o ? y : 0.f; }
    return x;
}
__device__ __forceinline__ float wave_scan_max(float x, LAS float* sc, int lane) {
#pragma unroll
    for (int o = 1; o < 64; o <<= 1) { sc[lane] = x; asm volatile("s_waitcnt lgkmcnt(0)" ::: "memory"); const float y = sc[lane >= o ? lane - o : lane]; asm volatile("s_waitcnt lgkmcnt(0)" ::: "memory"); x = lane >= o ? fmaxf(x, y) : x; }
    return x;
}
}

__device__ __forceinline__ void ph_chunk_r1(Frame& F, const bf16_t* P, const bf16_t* QK, const float* gif, const float* i_bias, const float* f_bias, const float* lb_logits, int jpair,
                                            bf16_t* CST, float* NST, float* SCL  , bf16_t* SST, float* HDEC) {
    using namespace ck;
    LAS unsigned char* lds = F.lds;
    for (int u = F.bx; u < NU_ML + NU_HG; u += F.G) {
        int tid = F.tid; asm volatile("" : "+v"(tid));
        const int lane = tid & 63, w = __builtin_amdgcn_readfirstlane(tid >> 6);
        if (u < NU_ML) {
            const int bh = u / NCH, j = u - bh * NCH, b = bh >> 2, hh = bh & 3, t0 = b * SEQ + j * CL;
            constexpr int PT = 264;
            LAS bf16_t* Vs = (LAS bf16_t*)lds;
            LAS bf16_t* Ks = Vs + 64 * PT;
            LAS float* av = (LAS float*)(Ks + 64 * PT);
            v4u kq[4], vq[4];
            { const int s = tid >> 3, c0 = (tid & 7) * 32;
              const bf16_t* kp = QK + (size_t)(t0 + s) * 2048 + 1024 + hh * 256 + c0; const bf16_t* vp = P + (size_t)(t0 + s) * AB_N + 1024 + hh * 256 + c0;
#pragma unroll
              for (int q = 0; q < 4; ++q) { kq[q] = *(const v4u*)(kp + 8 * q); vq[q] = *(const v4u*)(vp + 8 * q); } }
            if (w == 0) {
                const float ig = gif[(size_t)(t0 + lane) * 8 + hh] + i_bias[hh];
                const float lf = log_sig(gif[(size_t)(t0 + lane) * 8 + 4 + hh] + f_bias[hh]);
                const float bsum = wave_scan_add(lf, av, lane);
                av[lane] = bsum; LDS_WAIT(); const float g = av[63]; LDS_WAIT();
                const float upd = g - bsum + ig, mloc = wave_max(upd);
                av[lane] = expf(upd - mloc);
                if (lane == 0) { SCL[u * 4 + 0] = g; SCL[u * 4 + 1] = mloc; }
            }
            __syncthreads();
            { const int s = tid >> 3, c0 = (tid & 7) * 32; const float a = av[s];
#pragma unroll
              for (int q = 0; q < 4; ++q) { *(LAS v4u*)(Ks + s * PT + c0 + 8 * q) = kq[q];
                  float f[8]; unpack8(vq[q], f); v4u o; o.x = pk2(f[0] * a, f[1] * a); o.y = pk2(f[2] * a, f[3] * a); o.z = pk2(f[4] * a, f[5] * a); o.w = pk2(f[6] * a, f[7] * a);
                  *(LAS v4u*)(Vs + s * PT + c0 + 8 * q) = o; } }
            __syncthreads();
            if (tid < 256) { float s = 0.f;
                for (int ss = 0; ss < 64; ++ss) s += av[ss] * bf2f(Ks[ss * PT + tid]);
                NST[(size_t)u * 256 + tid] = s; }
            f32x4 acc[16][2];
#pragma unroll
            for (int m = 0; m < 16; ++m) { acc[m][0] = (f32x4){0.f, 0.f, 0.f, 0.f}; acc[m][1] = (f32x4){0.f, 0.f, 0.f, 0.f}; }
#pragma unroll
            for (int ks = 0; ks < 2; ++ks) {
                const bf16x8 b0 = frag_tr(Vs, PT, 32 * ks, 32 * w, lane), b1 = frag_tr(Vs, PT, 32 * ks, 32 * w + 16, lane);
#pragma unroll
                for (int m = 0; m < 16; ++m) { const bf16x8 a = frag_tr(Ks, PT, 32 * ks, 16 * m, lane); acc[m][0] = MMA16(a, b0, acc[m][0]); acc[m][1] = MMA16(a, b1, acc[m][1]); }
            }
            { char* cp = (char*)(CST + (size_t)u * 65536 + (size_t)(32 * w) * 256);
              const unsigned lo0 = (unsigned)(((lane & 15) * 256 + 4 * (lane >> 4)) * 2);
#pragma unroll
              for (int m = 0; m < 16; ++m)
#pragma unroll
                  for (int n = 0; n < 2; ++n) { v2u o; o.x = pk2(acc[m][n][0], acc[m][n][1]); o.y = pk2(acc[m][n][2], acc[m][n][3]); *(v2u*)(cp + (lo0 + (unsigned)((16 * n * 256 + 16 * m) * 2))) = o; } }
            __syncthreads();
        } else {
            const int uu = u - NU_ML, bh = uu / NCH, j = uu - bh * NCH, b = bh >> 3, hh = bh & 7, t0 = b * SEQ + j * CL;
            constexpr int PT = 136;
            LAS float* bS = (LAS float*)lds;
            LAS bf16_t* Kt = (LAS bf16_t*)(bS + 64 * 128);
            LAS bf16_t* Vt = Kt + 64 * PT;
            float k2r[16];
            { const int s = tid >> 3, c0 = (tid & 7) * 16; const bf16_t* pp = P + (size_t)(t0 + s) * AB_N + hh * 128 + c0;
#pragma unroll
              for (int q = 0; q < 2; ++q) { float hf[8]; unpack8(*(const v4u*)(pp + 4096 + 8 * q), hf);
                  *(LAS v4u*)(Vt + s * PT + c0 + 8 * q) = *(const v4u*)(pp + 5120 + 8 * q);
#pragma unroll
                  for (int e = 0; e < 8; ++e) { const int cg = hh * 128 + c0 + 8 * q + e;
                      const float oml = jpair == 0 ? 1.0f : 1.0f - sigmoidf_(lb_logits[1024 + cg] - lb_logits[cg]);
                      float k2, lf; hg_gate(hf[e], oml, k2, lf);
                      k2r[8 * q + e] = k2; bS[s * 128 + c0 + 8 * q + e] = lf; } } }
            __syncthreads();
            { const int c = tid & 127, p = tid >> 7; LAS float* tot = (LAS float*)(Vt + 64 * PT);
              float acc = 0.f;
#pragma unroll
              for (int s = 0; s < 16; ++s) { acc += bS[(16 * p + s) * 128 + c]; bS[(16 * p + s) * 128 + c] = acc; }
              tot[p * 128 + c] = acc;
              __syncthreads();
              float off = 0.f;
#pragma unroll
              for (int pp = 0; pp < 3; ++pp) off += pp < p ? tot[pp * 128 + c] : 0.f;
              if (p > 0) {
#pragma unroll
                  for (int s = 0; s < 16; ++s) bS[(16 * p + s) * 128 + c] += off; }
              if (p == 3) HDEC[(size_t)uu * 128 + c] = __expf(off + acc); }
            __syncthreads();
            { const int s = tid >> 3, c0 = (tid & 7) * 16;
#pragma unroll
              for (int q = 0; q < 2; ++q) { float r[8];
#pragma unroll
                  for (int e = 0; e < 8; ++e) { const int c = c0 + 8 * q + e; r[e] = k2r[8 * q + e] * __expf(bS[63 * 128 + c] - bS[s * 128 + c]); }
                  v4u o; o.x = pk2(r[0], r[1]); o.y = pk2(r[2], r[3]); o.z = pk2(r[4], r[5]); o.w = pk2(r[6], r[7]); *(LAS v4u*)(Kt + s * PT + c0 + 8 * q) = o; } }
            __syncthreads();
            f32x4 acc[8];
#pragma unroll
            for (int m = 0; m < 8; ++m) acc[m] = (f32x4){0.f, 0.f, 0.f, 0.f};
#pragma unroll
            for (int ks = 0; ks < 2; ++ks) { const bf16x8 bb = frag_tr(Vt, PT, 32 * ks, 16 * w, lane);
#pragma unroll
                for (int m = 0; m < 8; ++m) { const bf16x8 a = frag_tr(Kt, PT, 32 * ks, 16 * m, lane); acc[m] = MMA16(a, bb, acc[m]); } }
            { char* sp = (char*)(SST + (size_t)uu * 16384 + (size_t)(16 * w) * 128);
              const unsigned lo0 = (unsigned)(((lane & 15) * 128 + 4 * (lane >> 4)) * 2);
#pragma unroll
              for (int m = 0; m < 8; ++m) { v2u o; o.x = pk2(acc[m][0], acc[m][1]); o.y = pk2(acc[m][2], acc[m][3]); *(v2u*)(sp + (lo0 + (unsigned)(16 * m * 2))) = o; } }
            __syncthreads();
        }
    }
}

__device__ __forceinline__ void ph_chunk_r2(Frame& F, bf16_t* CST, float* NST, float* SCL, bf16_t* SST, const float* HDEC) {
    using namespace ck;
    for (int vb = F.bx; vb < 200; vb += F.G) {
    const int gt = vb * NTHREADS + F.tid;
    if (gt < 65536) {
        const int bh = gt >> 13; const size_t e8 = (size_t)(gt & 8191) * 8;
        float C[8]; float m = 0.f;
#pragma unroll
        for (int e = 0; e < 8; ++e) C[e] = 0.f;
        bf16_t* base = CST + (size_t)bh * NCH * 65536 + e8;
        for (int j0 = 0; j0 < NCH; j0 += 4) {
            v4u d[4]; float gg[4], ml[4];
#pragma unroll
            for (int q = 0; q < 4; ++q) { d[q] = *(const v4u*)(base + (size_t)(j0 + q) * 65536); gg[q] = SCL[(bh * NCH + j0 + q) * 4 + 0]; ml[q] = SCL[(bh * NCH + j0 + q) * 4 + 1]; }
#pragma unroll
            for (int q = 0; q < 4; ++q) {
                v4u o; o.x = pk2(C[0], C[1]); o.y = pk2(C[2], C[3]); o.z = pk2(C[4], C[5]); o.w = pk2(C[6], C[7]);
                *(v4u*)(base + (size_t)(j0 + q) * 65536) = o;
                if ((gt & 8191) == 0) SCL[(bh * NCH + j0 + q) * 4 + 2] = m;
                const float mn = fmaxf(gg[q] + m, ml[q]), a = __expf(gg[q] + m - mn), bc = __expf(ml[q] - mn);
                float f[8]; unpack8(d[q], f);
#pragma unroll
                for (int e = 0; e < 8; ++e) C[e] = a * C[e] + bc * f[e];
                m = mn; }
        }
    } else if (gt < 65536 + 2048) {
        const int idx = gt - 65536, bh = idx >> 8, k = idx & 255; float n = 0.f, m = 0.f;
        for (int j = 0; j < NCH; ++j) { const int u = bh * NCH + j; const float d = NST[(size_t)u * 256 + k], gg = SCL[u * 4 + 0], ml = SCL[u * 4 + 1];
            NST[(size_t)u * 256 + k] = n;
            const float mn = fmaxf(gg + m, ml); n = __expf(gg + m - mn) * n + __expf(ml - mn) * d; m = mn; }
    } else if (gt >= 136 * NTHREADS && gt < 136 * NTHREADS + 32768) {
        const int i = gt - 136 * NTHREADS, bh = i >> 11; const size_t e8 = (size_t)(i & 2047) * 8; const int c0 = (int)(e8 & 127);
        float S[8];
#pragma unroll
        for (int e = 0; e < 8; ++e) S[e] = 0.f;
        bf16_t* base = SST + (size_t)bh * NCH * 16384 + e8; const float* hd = HDEC + (size_t)bh * NCH * 128 + c0;
        for (int j0 = 0; j0 < NCH; j0 += 4) {
            v4u d[4]; f32x4 da[4], db[4];
#pragma unroll
            for (int q = 0; q < 4; ++q) { d[q] = *(const v4u*)(base + (size_t)(j0 + q) * 16384); da[q] = *(const f32x4*)(hd + (size_t)(j0 + q) * 128); db[q] = *(const f32x4*)(hd + (size_t)(j0 + q) * 128 + 4); }
#pragma unroll
            for (int q = 0; q < 4; ++q) {
                v4u o; o.x = pk2(S[0], S[1]); o.y = pk2(S[2], S[3]); o.z = pk2(S[4], S[5]); o.w = pk2(S[6], S[7]);
                *(v4u*)(base + (size_t)(j0 + q) * 16384) = o;
                float f[8]; unpack8(d[q], f);
#pragma unroll
                for (int e = 0; e < 4; ++e) { S[e] = da[q][e] * S[e] + f[e]; S[4 + e] = db[q][e] * S[4 + e] + f[4 + e]; } }
        }
    }
    }
}

__device__ __forceinline__ void ph_chunk_r3(Frame& F, const bf16_t* P, const bf16_t* QK, const bf16_t* cbuf, const float* gif, const float* i_bias, const float* f_bias, const float* lb_logits, int jpair,
                                            const bf16_t* CST, const float* NST, const float* SCL, const bf16_t* SST,
                                            const float* ml_norm, const float* ml_skip, const float* hg_norm, bf16_t* Y) {
    using namespace ck;
    LAS unsigned char* lds = F.lds;
    for (int u = F.bx; u < NU_ML + NU_HG; u += F.G) {
        int tid = F.tid; asm volatile("" : "+v"(tid));
        const int lane = tid & 63, w = __builtin_amdgcn_readfirstlane(tid >> 6), quad = lane >> 4, l15 = lane & 15;
        if (u < NU_ML) { for (int rep_ = 0; rep_ < 1 + CK_DUP_ML3; ++rep_) {
            const int bh = u / NCH, j = u - bh * NCH, b = bh >> 2, hh = bh & 3, t0 = b * SEQ + j * CL;
            constexpr int PT = 264, PW = 72;
            LAS bf16_t* Qs = (LAS bf16_t*)lds; LAS bf16_t* Ks = Qs + 64 * PT; LAS bf16_t* Vs = Ks + 64 * PT; LAS bf16_t* Ws = Vs + 64 * PT;
            LAS float* vec = (LAS float*)(Ws + 64 * PW);
            LAS float* bv = vec, *uv = vec + 64, *rv = vec + 128, *wl = vec + 192, *emt = vec + 256, *qnv = vec + 320, *tmp = vec + 384, *rstd = vec + 448, *part = vec + 512;
            const float mj = SCL[u * 4 + 2];
            bf16x8 cfr[8][2];
            { const bf16_t* Cj = CST + (size_t)u * 65536;
#pragma unroll
              for (int ks = 0; ks < 8; ++ks) { cfr[ks][0] = frag_rowk_g(Cj, 256, 32 * w, 32 * ks, lane); cfr[ks][1] = frag_rowk_g(Cj, 256, 32 * w + 16, 32 * ks, lane); } }
            LAS float* nsl = part + 512;
            if (tid < 64) *(LAS f32x4*)(nsl + 4 * tid) = *(const f32x4*)(NST + (size_t)u * 256 + 4 * tid);
            float ig_raw = 0.f, fg_raw = 0.f;
            if (w == 0) { ig_raw = gif[(size_t)(t0 + lane) * 8 + hh]; fg_raw = gif[(size_t)(t0 + lane) * 8 + 4 + hh]; }
            { const int s = tid >> 3, c0 = (tid & 7) * 32;
              const bf16_t* qp = QK + (size_t)(t0 + s) * 2048 + hh * 256 + c0; const bf16_t* vp = P + (size_t)(t0 + s) * AB_N + 1024 + hh * 256 + c0;
#pragma unroll
              for (int q = 0; q < 4; ++q) { *(LAS v4u*)(Qs + s * PT + c0 + 8 * q) = *(const v4u*)(qp + 8 * q); *(LAS v4u*)(Ks + s * PT + c0 + 8 * q) = *(const v4u*)(qp + 1024 + 8 * q);
                  *(LAS v4u*)(Vs + s * PT + c0 + 8 * q) = *(const v4u*)(vp + 8 * q); }
              { unsigned z0 = 0u; asm volatile("" : "+v"(z0)); *(LAS v4u*)(Ws + s * PW + (tid & 7) * 8) = (v4u){z0, z0, z0, z0}; } }
            if (w == 0) {
                const float ig = ig_raw + i_bias[hh];
                const float lf = log_sig(fg_raw + f_bias[hh]);
                const float bsum = wave_scan_add(lf, tmp, lane);
                const float uu = ig - bsum;
                const float cm = wave_scan_max(uu, tmp, lane);
                const float r = -fmaxf(mj, cm);
                bv[lane] = bsum; uv[lane] = uu; rv[lane] = r; wl[lane] = expf(mj + r); emt[lane] = expf(r - bsum);
            }
            __syncthreads();
            { const int l = tid >> 3, k0 = (tid & 7) * 32; float acc = 0.f;
#pragma unroll 8
              for (int k = 0; k < 32; ++k) acc += nsl[k0 + k] * bf2f(Qs[l * PT + k0 + k]);
              acc += DPP_F(acc, 0xB1); acc += DPP_F(acc, 0x4E); acc += DPP_F(acc, 0x141);
              if ((tid & 7) == 0) qnv[l] = acc; }
            for (int ti = w; ti < 10; ti += 8) {
                const int lt = ti < 1 ? 0 : ti < 3 ? 1 : ti < 6 ? 2 : 3, st = ti - (lt * (lt + 1)) / 2;
                f32x4 acc = (f32x4){0.f, 0.f, 0.f, 0.f};
#pragma unroll
                for (int ks = 0; ks < 8; ++ks) acc = MMA16(frag_rowk(Ks, PT, 16 * st, 32 * ks, lane), frag_rowk(Qs, PT, 16 * lt, 32 * ks, lane), acc);
                const int l = 16 * lt + l15, s0 = 16 * st + 4 * quad; const float rl = rv[l]; float wv[4];
#pragma unroll
                for (int e = 0; e < 4; ++e) wv[e] = (s0 + e <= l) ? acc[e] * __expf(rl + uv[s0 + e]) : 0.f;
                v2u o; o.x = pk2(wv[0], wv[1]); o.y = pk2(wv[2], wv[3]); *(LAS v2u*)(Ws + l * PW + s0) = o;
            }
            __syncthreads();
            f32x4 ai[4][2], ax[4][2], ad[4];
#pragma unroll
            for (int m = 0; m < 4; ++m) { ad[m] = (f32x4){0.f, 0.f, 0.f, 0.f};
#pragma unroll
                for (int n = 0; n < 2; ++n) { ai[m][n] = (f32x4){0.f, 0.f, 0.f, 0.f}; ax[m][n] = (f32x4){0.f, 0.f, 0.f, 0.f}; } }
            { unsigned o1 = 0x3F803F80u; asm volatile("" : "+v"(o1)); const v4u ow = {o1, o1, o1, o1}; const bf16x8 ones = __builtin_bit_cast(bf16x8, ow);
#pragma unroll
              for (int ks = 0; ks < 2; ++ks) { const bf16x8 b0 = frag_tr(Vs, PT, 32 * ks, 32 * w, lane), b1 = frag_tr(Vs, PT, 32 * ks, 32 * w + 16, lane);
#pragma unroll
                  for (int m = 0; m < 4; ++m) { const bf16x8 a = frag_rowk(Ws, PW, 16 * m, 32 * ks, lane); ai[m][0] = MMA16(a, b0, ai[m][0]); ai[m][1] = MMA16(a, b1, ai[m][1]); ad[m] = MMA16(a, ones, ad[m]); } } }
            {
#pragma unroll
              for (int ks = 0; ks < 8; ++ks) { const bf16x8 b0 = cfr[ks][0], b1 = cfr[ks][1];
#pragma unroll
                  for (int m = 0; m < 4; ++m) { const bf16x8 a = frag_rowk(Qs, PT, 16 * m, 32 * ks, lane); ax[m][0] = MMA16(a, b0, ax[m][0]); ax[m][1] = MMA16(a, b1, ax[m][1]); } } }
            v4u gcc[4], gop[4];
            { const int l = tid >> 3, v0 = (tid & 7) * 32; const size_t tk = (size_t)(t0 + l); const int col0 = hh * 256 + v0;
#pragma unroll
              for (int q = 0; q < 4; ++q) { gcc[q] = *(const v4u*)(cbuf + tk * 1024 + col0 + 8 * q); gop[q] = *(const v4u*)(P + tk * AB_N + 2048 + col0 + 8 * q); } }
            float hv[4][2][4];
#pragma unroll
            for (int m = 0; m < 4; ++m)
#pragma unroll
                for (int e = 0; e < 4; ++e) { const int l = 16 * m + 4 * quad + e; const float wi = wl[l], den = fmaxf(fabsf(ad[m][e] + wi * qnv[l]), emt[l]), inv = __builtin_amdgcn_rcpf(den);
                    hv[m][0][e] = (ai[m][0][e] + wi * ax[m][0][e]) * inv; hv[m][1][e] = (ai[m][1][e] + wi * ax[m][1][e]) * inv;
                    const float ss = row16_sum(hv[m][0][e] * hv[m][0][e] + hv[m][1][e] * hv[m][1][e]);
                    if (l15 == 0) part[w * 64 + l] = ss; }
            __syncthreads();
            if (tid < 64) { float t = 0.f;
#pragma unroll
                for (int ww = 0; ww < 8; ++ww) t += part[ww * 64 + tid];
                rstd[tid] = 1.0f / sqrtf(t * (1.0f / 256.0f) + NORM_EPS); }
            __syncthreads();
            { constexpr int PH = 264; LAS float* hs = (LAS float*)lds;
#pragma unroll
              for (int m = 0; m < 4; ++m)
#pragma unroll
                  for (int e = 0; e < 4; ++e) { const int l = 16 * m + 4 * quad + e; const float rs = rstd[l];
                      hs[l * PH + 32 * w + l15] = hv[m][0][e] * rs; hs[l * PH + 32 * w + 16 + l15] = hv[m][1][e] * rs; }
              __syncthreads();
              const int l = tid >> 3, v0 = (tid & 7) * 32; const size_t tk = (size_t)(t0 + l); const int col0 = hh * 256 + v0;
#pragma unroll
              for (int q = 0; q < 4; ++q) { float cc[8], op[8]; unpack8(gcc[q], cc); unpack8(gop[q], op);
                  const f32x4 h0 = *(const LAS f32x4*)(hs + l * PH + v0 + 8 * q), h1 = *(const LAS f32x4*)(hs + l * PH + v0 + 8 * q + 4);
                  const f32x4 n0 = *(const f32x4*)(ml_norm + col0 + 8 * q), n1 = *(const f32x4*)(ml_norm + col0 + 8 * q + 4), k0 = *(const f32x4*)(ml_skip + col0 + 8 * q), k1 = *(const f32x4*)(ml_skip + col0 + 8 * q + 4);
                  float r[8];
#pragma unroll
                  for (int e = 0; e < 4; ++e) { r[e] = sigmoidf_(op[e]) * (h0[e] * n0[e] + k0[e] * cc[e]); r[4 + e] = sigmoidf_(op[4 + e]) * (h1[e] * n1[e] + k1[e] * cc[4 + e]); }
                  v4u o; o.x = pk2(r[0], r[1]); o.y = pk2(r[2], r[3]); o.z = pk2(r[4], r[5]); o.w = pk2(r[6], r[7]); *(v4u*)(Y + tk * 2048 + col0 + 8 * q) = o; } }
            __syncthreads(); }
        } else { for (int rep_ = 0; rep_ < 1 + CK_DUP_HG3; ++rep_) {
            const int uu = u - NU_ML, bh = uu / NCH, j = uu - bh * NCH, b = bh >> 3, hh = bh & 7, t0 = b * SEQ + j * CL;
            constexpr int PT = 136, PA = 72;
            constexpr int BP = 65;
            LAS float* bT = (LAS float*)lds;
            constexpr int QP = 129;
            LAS float* qf = bT + 128 * BP;
            LAS bf16_t* kT = (LAS bf16_t*)(qf + 64 * QP);
            LAS bf16_t* qh = kT + 128 * 64;
            LAS bf16_t* Vt = qh + 64 * PT;
            LAS bf16_t* At = Vt + 64 * PT;
            LAS float* part = (LAS float*)(At + 64 * PA);
            LAS float* rstd = part + 512;
            bf16x8 sfr[4];
            { const bf16_t* Sj = SST + (size_t)uu * 16384;
#pragma unroll
              for (int ks = 0; ks < 4; ++ks) sfr[ks] = frag_rowk_g(Sj, 128, 16 * w, 32 * ks, lane); }
            { const int s = tid >> 3, c0 = (tid & 7) * 16; const bf16_t* pp = P + (size_t)(t0 + s) * AB_N + hh * 128 + c0;
#pragma unroll
              for (int q = 0; q < 2; ++q) { float hq[8], hf[8]; unpack8(*(const v4u*)(pp + 3072 + 8 * q), hq); unpack8(*(const v4u*)(pp + 4096 + 8 * q), hf);
                  *(LAS v4u*)(Vt + s * PT + c0 + 8 * q) = *(const v4u*)(pp + 5120 + 8 * q);
                  if (q == 0) { unsigned z0 = 0u; asm volatile("" : "+v"(z0)); *(LAS v4u*)(At + s * PA + (tid & 7) * 8) = (v4u){z0, z0, z0, z0}; }
#pragma unroll
                  for (int e = 0; e < 8; ++e) { const int c = c0 + 8 * q + e, cg = hh * 128 + c;
                      const float oml = jpair == 0 ? 1.0f : 1.0f - sigmoidf_(lb_logits[1024 + cg] - lb_logits[cg]);
                      float k2, lf; hg_gate(hf[e], oml, k2, lf);
                      bT[c * BP + s] = lf * 1.4426950408889634f; kT[c * 64 + s] = (bf16_t)f2bf(k2);        qf[s * QP + c] = hq[e] * __builtin_amdgcn_rcpf(1.0f + __expf(-hq[e])); } } }
            __syncthreads();
            { const int c = tid & 127, p = tid >> 7; LAS float* tot = part;
              float acc = 0.f;
#pragma unroll
              for (int s = 0; s < 16; ++s) { acc += bT[c * BP + 16 * p + s]; bT[c * BP + 16 * p + s] = acc; }
              tot[p * 128 + c] = acc;
              __syncthreads();
              float off = 0.f;
#pragma unroll
              for (int pp = 0; pp < 3; ++pp) off += pp < p ? tot[pp * 128 + c] : 0.f;
              if (p > 0) {
#pragma unroll
                  for (int s = 0; s < 16; ++s) bT[c * BP + 16 * p + s] += off; } }
            __syncthreads();
            { const int l = tid >> 3, c0 = (tid & 7) * 16;
              float dg = 0.f;
#pragma unroll
              for (int q = 0; q < 2; ++q) { float r[8];
#pragma unroll
                  for (int e = 0; e < 8; ++e) { const int c = c0 + 8 * q + e; const float qv = qf[l * QP + c]; r[e] = qv * __builtin_amdgcn_exp2f(bT[c * BP + l]); dg += qv * bf2f(kT[c * 64 + l]); }
                  v4u o; o.x = pk2(r[0], r[1]); o.y = pk2(r[2], r[3]); o.z = pk2(r[4], r[5]); o.w = pk2(r[6], r[7]); *(LAS v4u*)(qh + l * PT + c0 + 8 * q) = o; }
              dg += DPP_F(dg, 0xB1); dg += DPP_F(dg, 0x4E); dg += DPP_F(dg, 0x141);
              if ((tid & 7) == 0) At[l * PA + l] = (bf16_t)f2bf(dg); }
            if (tid < 480) { const int I = tid / 120, p = tid - I * 120; int lr = (int)((1.0f + sqrtf(1.0f + 8.0f * (float)p)) * 0.5f);
              lr = (lr * (lr - 1)) / 2 > p ? lr - 1 : lr; lr = ((lr + 1) * lr) / 2 <= p ? lr + 1 : lr;
              const int lA = 16 * I + lr, sA = 16 * I + (p - (lr * (lr - 1)) / 2); float a0 = 0.f;
#pragma unroll 4
              for (int c = 0; c < 128; ++c) a0 += qf[lA * QP + c] * bf2f(kT[c * 64 + sA]) * __builtin_amdgcn_exp2f(bT[c * BP + lA] - bT[c * BP + sA]);
              At[lA * PA + sA] = (bf16_t)f2bf(a0); }
            if (w < 6) { const int I = w < 3 ? w + 1 : (w < 5 ? w - 1 : 3), J = w < 3 ? 0 : (w < 5 ? 1 : 2);
                const int sA = 16 * J + l15, lB = 16 * I + l15, eJ = 16 * J + 15;
                f32x4 acc = (f32x4){0.f, 0.f, 0.f, 0.f};
#pragma unroll
                for (int ks = 0; ks < 4; ++ks) { float fa[8], fb[8];
#pragma unroll
                    for (int e = 0; e < 8; ++e) { const int c = 32 * ks + 8 * quad + e; const float Bc = bT[c * BP + eJ];
                        fa[e] = bf2f(kT[c * 64 + sA]) * __builtin_amdgcn_exp2f(Bc - bT[c * BP + sA]); fb[e] = qf[lB * QP + c] * __builtin_amdgcn_exp2f(bT[c * BP + lB] - Bc); }
                    v4u ua, ub; ua.x = pk2(fa[0], fa[1]); ua.y = pk2(fa[2], fa[3]); ua.z = pk2(fa[4], fa[5]); ua.w = pk2(fa[6], fa[7]); ub.x = pk2(fb[0], fb[1]); ub.y = pk2(fb[2], fb[3]); ub.z = pk2(fb[4], fb[5]); ub.w = pk2(fb[6], fb[7]);
                    acc = MMA16(__builtin_bit_cast(bf16x8, ua), __builtin_bit_cast(bf16x8, ub), acc); }
                v2u o; o.x = pk2(acc[0], acc[1]); o.y = pk2(acc[2], acc[3]); *(LAS v2u*)(At + lB * PA + 16 * J + 4 * quad) = o; }
            __syncthreads();
            f32x4 ao[4];
#pragma unroll
            for (int m = 0; m < 4; ++m) ao[m] = (f32x4){0.f, 0.f, 0.f, 0.f};
#pragma unroll
            for (int ks = 0; ks < 2; ++ks) { const bf16x8 bb = frag_tr(Vt, PT, 32 * ks, 16 * w, lane);
#pragma unroll
                for (int m = 0; m < 4; ++m) ao[m] = MMA16(frag_rowk(At, PA, 16 * m, 32 * ks, lane), bb, ao[m]); }
            {
#pragma unroll
              for (int ks = 0; ks < 4; ++ks) { const bf16x8 bb = sfr[ks];
#pragma unroll
                  for (int m = 0; m < 4; ++m) ao[m] = MMA16(frag_rowk(qh, PT, 16 * m, 32 * ks, lane), bb, ao[m]); } }
            v4u ggr[2];
            { const int l = tid >> 3, v0 = (tid & 7) * 16; const size_t tk = (size_t)(t0 + l); const int col0 = hh * 128 + v0;
#pragma unroll
              for (int q = 0; q < 2; ++q) ggr[q] = *(const v4u*)(P + tk * AB_N + 6144 + col0 + 8 * q); }
#pragma unroll
            for (int m = 0; m < 4; ++m)
#pragma unroll
                for (int e = 0; e < 4; ++e) { const int l = 16 * m + 4 * quad + e; const float ss = row16_sum(ao[m][e] * ao[m][e]); if (l15 == 0) part[w * 64 + l] = ss; }
            __syncthreads();
            if (tid < 64) { float t = 0.f;
#pragma unroll
                for (int ww = 0; ww < 8; ++ww) t += part[ww * 64 + tid];
                rstd[tid] = 1.0f / sqrtf(t * (1.0f / 128.0f) + NORM_EPS); }
            __syncthreads();
            { constexpr int PH = 132; LAS float* hs = (LAS float*)lds;
#pragma unroll
              for (int m = 0; m < 4; ++m)
#pragma unroll
                  for (int e = 0; e < 4; ++e) { const int l = 16 * m + 4 * quad + e; hs[l * PH + 16 * w + l15] = ao[m][e] * rstd[l]; }
              __syncthreads();
              const int l = tid >> 3, v0 = (tid & 7) * 16; const size_t tk = (size_t)(t0 + l); const int col0 = hh * 128 + v0;
#pragma unroll
              for (int q = 0; q < 2; ++q) { float gg[8]; unpack8(ggr[q], gg);
                  const f32x4 h0 = *(const LAS f32x4*)(hs + l * PH + v0 + 8 * q), h1 = *(const LAS f32x4*)(hs + l * PH + v0 + 8 * q + 4);
                  const f32x4 n0 = *(const f32x4*)(hg_norm + col0 + 8 * q), n1 = *(const f32x4*)(hg_norm + col0 + 8 * q + 4);
                  float r[8];
#pragma unroll
                  for (int e = 0; e < 4; ++e) { r[e] = h0[e] * n0[e] * siluf_(gg[e]); r[4 + e] = h1[e] * n1[e] * siluf_(gg[4 + e]); }
                  v4u o; o.x = pk2(r[0], r[1]); o.y = pk2(r[2], r[3]); o.z = pk2(r[4], r[5]); o.w = pk2(r[6], r[7]); *(v4u*)(Y + tk * 2048 + 1024 + col0 + 8 * q) = o; } }
            __syncthreads(); }
        }
    }
}


__device__ __forceinline__ void ph_qknorm_rope(Frame& F, bf16_t* slots, const float* q_norm, const float* k_norm, const float* rope) {
    const int sub = F.lane & 15, rsel = F.lane >> 4;
    const int skip = F.G == 256 ? 32 : 0;
    if (F.bx < skip) return;
    const int gw = (F.bx - skip) * 8 + F.wave, ngw = (F.G - skip) * 8;
    constexpr int NIT = 24 * T / 4;
    for (int it0 = gw; it0 < NIT; it0 += 4 * ngw) {
        v4u xin[4]; f32x4 cs[4][4];
#pragma unroll
        for (int u = 0; u < 4; ++u) { const int it = it0 + u * ngw;
            if (it < NIT) { const int rowi = it * 4 + rsel, sl = rowi / T, m = rowi - sl * T, pos = m & (SEQ - 1);
                const int slot = sl < 16 ? sl : (sl < 20 ? 24 + (sl - 16) : 32 + (sl - 20));
                xin[u] = *(const v4u*)(slots + ((size_t)slot * T + m) * 128 + 8 * sub);
                const f32x4* cp = (const f32x4*)(rope + ((size_t)pos * 64 + 8 * (sub & 7)) * 2);
#pragma unroll
                for (int q = 0; q < 4; ++q) cs[u][q] = cp[q]; } }
#pragma unroll
        for (int u = 0; u < 4; ++u) { const int it = it0 + u * ngw;
            if (it < NIT) { const int rowi = it * 4 + rsel, sl = rowi / T, m = rowi - sl * T;
                const int slot = sl < 16 ? sl : (sl < 20 ? 24 + (sl - 16) : 32 + (sl - 20));
                const float* w = (sl < 16 ? q_norm : (sl < 20 ? k_norm + 128 : k_norm + 256)) + 8 * sub;
                bf16_t* p = slots + ((size_t)slot * T + m) * 128 + 8 * sub;
                float x[8]; unpack8(xin[u], x);
                float ss = 0.f;
#pragma unroll
                for (int e = 0; e < 8; ++e) ss += x[e] * x[e];
                const float rstd = __builtin_amdgcn_rsqf(row16_sum(ss) * (1.0f / 128.0f) + NORM_EPS);
                const f32x4 w0 = *(const f32x4*)w, w1 = *(const f32x4*)(w + 4);
                float a[8], bpart[8];
#pragma unroll
                for (int e = 0; e < 8; ++e) { a[e] = x[e] * rstd * (e < 4 ? w0[e] : w1[e - 4]); bpart[e] = DPP_F(a[e], 0x128); }
                const float sgn = sub < 8 ? -1.0f : 1.0f;
                float y[8];
#pragma unroll
                for (int q = 0; q < 4; ++q) { const f32x4 c2 = cs[u][q]; y[2 * q] = a[2 * q] * c2.x + sgn * bpart[2 * q] * c2.y; y[2 * q + 1] = a[2 * q + 1] * c2.z + sgn * bpart[2 * q + 1] * c2.w; }
                v4u o; o.x = pk2(y[0], y[1]); o.y = pk2(y[2], y[3]); o.z = pk2(y[4], y[5]); o.w = pk2(y[6], y[7]);
                *(v4u*)p = o; } }
    }
}
__device__ __forceinline__ void ph_compress2(Frame& F, const bf16_t* hid, const float* w2  , const float* k_norm0, const float* rope, bf16_t* kcmp, bf16_t* vcmp) {
    for (int g4 = F.gw; g4 < 2 * 1024; g4 += F.NGW) {
        const int kv = g4 >> 10, r0 = 4 * (g4 & 1023);
        float h[4][4];
#pragma unroll
        for (int i = 0; i < 4; ++i) { const v2u hu = *(const v2u*)(hid + ((size_t)kv * 4096 + r0 + i) * 256 + 4 * F.lane); h[i][0] = bflo(hu.x); h[i][1] = bfhi(hu.x); h[i][2] = bflo(hu.y); h[i][3] = bfhi(hu.y); }
        const float* w = w2 + (size_t)kv * 256 * 128;
        float a0[4] = {0.f, 0.f, 0.f, 0.f}, a1[4] = {0.f, 0.f, 0.f, 0.f};
        for (int c4 = 0; c4 < 64; ++c4) {
            const float* wr = w + (size_t)(4 * c4) * 128 + F.lane;
            const float w00 = wr[0], w01 = wr[128], w02 = wr[256], w03 = wr[384], w10 = wr[64], w11 = wr[192], w12 = wr[320], w13 = wr[448];
#pragma unroll
            for (int i = 0; i < 4; ++i) {
                const float x0 = __builtin_bit_cast(float, __builtin_amdgcn_readlane(__builtin_bit_cast(int, h[i][0]), c4)), x1 = __builtin_bit_cast(float, __builtin_amdgcn_readlane(__builtin_bit_cast(int, h[i][1]), c4));
                const float x2 = __builtin_bit_cast(float, __builtin_amdgcn_readlane(__builtin_bit_cast(int, h[i][2]), c4)), x3 = __builtin_bit_cast(float, __builtin_amdgcn_readlane(__builtin_bit_cast(int, h[i][3]), c4));
                a0[i] += x0 * w00 + x1 * w01 + x2 * w02 + x3 * w03;
                a1[i] += x0 * w10 + x1 * w11 + x2 * w12 + x3 * w13; }
        }
#pragma unroll
        for (int i = 0; i < 4; ++i) { const int r = r0 + i;
            if (kv == 0) {
                const float rstd = 1.0f / sqrtf(wave_sum(a0[i] * a0[i] + a1[i] * a1[i]) * (1.0f / 128.0f) + NORM_EPS);
                const float a = a0[i] * rstd * k_norm0[F.lane], b = a1[i] * rstd * k_norm0[64 + F.lane];
                const int pos = 16 * (r & 511) + 31;
                const f32x2 cs = *(const f32x2*)(rope + ((size_t)pos * 64 + F.lane) * 2);
                kcmp[(size_t)r * 128 + F.lane] = (bf16_t)f2bf(a * cs.x - b * cs.y); kcmp[(size_t)r * 128 + 64 + F.lane] = (bf16_t)f2bf(b * cs.x + a * cs.y);
            } else { vcmp[(size_t)r * 128 + F.lane] = (bf16_t)f2bf(a0[i]); vcmp[(size_t)r * 128 + 64 + F.lane] = (bf16_t)f2bf(a1[i]); } }
    }
}

namespace nsa {
typedef short s16x4 __attribute__((ext_vector_type(4)));
typedef float f32x16 __attribute__((ext_vector_type(16)));
#define KSWZ(row, colB) ((row) * 256 + ((colB) ^ (((row) & 7) << 4)))
#define SBAR() __builtin_amdgcn_sched_barrier(0)
constexpr float SCALE = 0.08838834764831845f, CLOG = SCALE * 1.4426950408889634f;
constexpr int SHM_T = 64 * 128 * 2;
constexpr int L_V = 0, L_K = 2 * SHM_T, L_WREG = 4 * SHM_T, WREG = 8192, IMP_LD = 144, L_SELW = 132096, L_SCR = 133120, L_END = L_SCR + 8 * 64 * 4;
static_assert(L_WREG + 8 * WREG <= RING_BYTES && 8 * IMP_LD * 4 <= WREG && L_END <= LDS_BYTES && L_SELW >= MISC_OFF + 128, "attention LDS map");
__device__ __forceinline__ int crow(int r, int hi) { return (r & 3) + 8 * (r >> 2) + 4 * hi; }
__device__ __forceinline__ unsigned cvtpk(float lo, float hi) { return pk2(lo, hi); }
__device__ __forceinline__ void qkt(f32x16& p0, f32x16& p1, const LAS char* Ks, const bf16x8* qr, int r32, int hi) {
    p0 = f32x16{}; p1 = f32x16{};
#pragma unroll
    for (int d0 = 0; d0 < 8; ++d0) { const int cb = (d0 * 16 + hi * 8) * 2;
        const bf16x8 b0 = *(const LAS bf16x8*)(Ks + KSWZ(r32, cb)), b1 = *(const LAS bf16x8*)(Ks + KSWZ(32 + r32, cb));
        p0 = __builtin_amdgcn_mfma_f32_32x32x16_bf16(b0, qr[d0], p0, 0, 0, 0);
        p1 = __builtin_amdgcn_mfma_f32_32x32x16_bf16(b1, qr[d0], p1, 0, 0, 0); }
}
__device__ __forceinline__ int v_st(int k, int c) { const int kk = (k & ~0xC) | ((k & 4) << 1) | ((k & 8) >> 1); return ((kk >> 3) * 4 + (c >> 5)) * 512 + ((kk & 7) * 32 + (c & 31)) * 2; }
__device__ __forceinline__ int v_rd_base(int lane) { return ((lane & 3) << 3) | (((lane >> 2) & 3) << 6) | (((lane >> 4) & 1) << 5) | (((lane >> 5) & 1) << 8); }
constexpr int v_rd_off(int d0, int ks, int half) { return d0 * 512 + ks * 4096 + half * 2048; }
template <int OFF> __device__ __forceinline__ s16x4 tr_read(int vb) { s16x4 r; asm volatile("ds_read_b64_tr_b16 %0, %1 offset:%2" : "=&v"(r) : "v"(vb), "i"(OFF) : "memory"); return r; }
template <int D0> __device__ __forceinline__ void pv_one(f32x16& od, int vb, bf16x8 pa0, bf16x8 pa1, bf16x8 pa2, bf16x8 pa3) {
    const s16x4 l0 = tr_read<v_rd_off(D0, 0, 0)>(vb), h0 = tr_read<v_rd_off(D0, 0, 1)>(vb), l1 = tr_read<v_rd_off(D0, 1, 0)>(vb), h1 = tr_read<v_rd_off(D0, 1, 1)>(vb);
    const s16x4 l2 = tr_read<v_rd_off(D0, 2, 0)>(vb), h2 = tr_read<v_rd_off(D0, 2, 1)>(vb), l3 = tr_read<v_rd_off(D0, 3, 0)>(vb), h3 = tr_read<v_rd_off(D0, 3, 1)>(vb);
    asm volatile("s_waitcnt lgkmcnt(0)" ::: "memory"); SBAR();
#define PK(L, H) (bf16x8){L[0], L[1], L[2], L[3], H[0], H[1], H[2], H[3]}
    od = __builtin_amdgcn_mfma_f32_32x32x16_bf16(pa0, PK(l0, h0), od, 0, 0, 0);
    od = __builtin_amdgcn_mfma_f32_32x32x16_bf16(pa1, PK(l1, h1), od, 0, 0, 0);
    od = __builtin_amdgcn_mfma_f32_32x32x16_bf16(pa2, PK(l2, h2), od, 0, 0, 0);
    od = __builtin_amdgcn_mfma_f32_32x32x16_bf16(pa3, PK(l3, h3), od, 0, 0, 0);
#undef PK
}
__device__ __forceinline__ void pack_p(const f32x16& p0, const f32x16& p1, bf16x8& pa0, bf16x8& pa1, bf16x8& pa2, bf16x8& pa3) {
#define PK4(P, BASE, OUT) do { const unsigned a0 = cvtpk(P[BASE + 0], P[BASE + 1]), a1 = cvtpk(P[BASE + 2], P[BASE + 3]), b0 = cvtpk(P[BASE + 4], P[BASE + 5]), b1 = cvtpk(P[BASE + 6], P[BASE + 7]); \
    auto r0 = __builtin_amdgcn_permlane32_swap(a0, b0, false, false); auto r1 = __builtin_amdgcn_permlane32_swap(a1, b1, false, false); \
    v4u w = {r0[0], r1[0], r0[1], r1[1]}; OUT = __builtin_bit_cast(bf16x8, w); } while (0)
    PK4(p0, 0, pa0); PK4(p0, 8, pa1); PK4(p1, 0, pa2); PK4(p1, 8, pa3);
#undef PK4
}
__device__ __forceinline__ void qk_half(f32x16& p, const LAS char* Ks, const bf16x8* qr, int row, int hi) {
#pragma unroll
    for (int d0 = 0; d0 < 8; ++d0) { const int cb = (d0 * 16 + hi * 8) * 2; const bf16x8 b = *(const LAS bf16x8*)(Ks + KSWZ(row, cb)); p = __builtin_amdgcn_mfma_f32_32x32x16_bf16(b, qr[d0], p, 0, 0, 0); }
}
template <bool RANGE>
__device__ __forceinline__ float exp_half(f32x16& p, float bias, int klo, int khi, int hi, int koff) {
    float ps = 0.f;
#pragma unroll
    for (int r = 0; r < 16; ++r) { const int k = koff + crow(r, hi); float x = fmaf(p[r], CLOG, bias);
        if (RANGE) x = (k >= klo && k <= khi) ? x : -INFINITY;
        p[r] = __builtin_amdgcn_exp2f(x); ps += p[r]; }
    return ps;
}
__device__ __forceinline__ void pack_half(const f32x16& p, bf16x8& pa, bf16x8& pb) {
#define PK4(P, BASE, OUT) do { const unsigned a0 = cvtpk(P[BASE + 0], P[BASE + 1]), a1 = cvtpk(P[BASE + 2], P[BASE + 3]), b0 = cvtpk(P[BASE + 4], P[BASE + 5]), b1 = cvtpk(P[BASE + 6], P[BASE + 7]); \
    auto r0 = __builtin_amdgcn_permlane32_swap(a0, b0, false, false); auto r1 = __builtin_amdgcn_permlane32_swap(a1, b1, false, false); \
    v4u w = {r0[0], r1[0], r0[1], r1[1]}; OUT = __builtin_bit_cast(bf16x8, w); } while (0)
    PK4(p, 0, pa); PK4(p, 8, pb);
#undef PK4
}
template <int KH>
__device__ __forceinline__ void pv_half(f32x16 (&o)[4], int vb, bf16x8 pa, bf16x8 pb) {
    s16x4 l00 = tr_read<v_rd_off(0, 2 * KH, 0)>(vb), h00 = tr_read<v_rd_off(0, 2 * KH, 1)>(vb), l01 = tr_read<v_rd_off(0, 2 * KH + 1, 0)>(vb), h01 = tr_read<v_rd_off(0, 2 * KH + 1, 1)>(vb);
    const s16x4 l10 = tr_read<v_rd_off(1, 2 * KH, 0)>(vb), h10 = tr_read<v_rd_off(1, 2 * KH, 1)>(vb), l11 = tr_read<v_rd_off(1, 2 * KH + 1, 0)>(vb), h11 = tr_read<v_rd_off(1, 2 * KH + 1, 1)>(vb);
    const s16x4 l20 = tr_read<v_rd_off(2, 2 * KH, 0)>(vb), h20 = tr_read<v_rd_off(2, 2 * KH, 1)>(vb), l21 = tr_read<v_rd_off(2, 2 * KH + 1, 0)>(vb), h21 = tr_read<v_rd_off(2, 2 * KH + 1, 1)>(vb);
    const s16x4 l30 = tr_read<v_rd_off(3, 2 * KH, 0)>(vb), h30 = tr_read<v_rd_off(3, 2 * KH, 1)>(vb), l31 = tr_read<v_rd_off(3, 2 * KH + 1, 0)>(vb), h31 = tr_read<v_rd_off(3, 2 * KH + 1, 1)>(vb);
    asm volatile("s_waitcnt lgkmcnt(0)" ::: "memory"); SBAR();
#define PK(L, H) (bf16x8){L[0], L[1], L[2], L[3], H[0], H[1], H[2], H[3]}
    o[0] = __builtin_amdgcn_mfma_f32_32x32x16_bf16(pa, PK(l00, h00), o[0], 0, 0, 0); o[1] = __builtin_amdgcn_mfma_f32_32x32x16_bf16(pa, PK(l10, h10), o[1], 0, 0, 0);
    o[2] = __builtin_amdgcn_mfma_f32_32x32x16_bf16(pa, PK(l20, h20), o[2], 0, 0, 0); o[3] = __builtin_amdgcn_mfma_f32_32x32x16_bf16(pa, PK(l30, h30), o[3], 0, 0, 0);
    o[0] = __builtin_amdgcn_mfma_f32_32x32x16_bf16(pb, PK(l01, h01), o[0], 0, 0, 0); o[1] = __builtin_amdgcn_mfma_f32_32x32x16_bf16(pb, PK(l11, h11), o[1], 0, 0, 0);
    o[2] = __builtin_amdgcn_mfma_f32_32x32x16_bf16(pb, PK(l21, h21), o[2], 0, 0, 0); o[3] = __builtin_amdgcn_mfma_f32_32x32x16_bf16(pb, PK(l31, h31), o[3], 0, 0, 0);
#undef PK
}
template <bool RANGE>
__device__ __forceinline__ float exp_tile(f32x16& p0, f32x16& p1, float bias, int klo, int khi, int hi) {
    float ps = 0.f;
#pragma unroll
    for (int r = 0; r < 16; ++r) { const int k0 = crow(r, hi), k1 = 32 + k0;
        float x0 = fmaf(p0[r], CLOG, bias), x1 = fmaf(p1[r], CLOG, bias);
        if (RANGE) { x0 = (k0 >= klo && k0 <= khi) ? x0 : -INFINITY; x1 = (k1 >= klo && k1 <= khi) ? x1 : -INFINITY; }
        p0[r] = __builtin_amdgcn_exp2f(x0); p1[r] = __builtin_amdgcn_exp2f(x1); ps += p0[r] + p1[r]; }
    return ps;
}
struct Stg { bf16x8 k0, k1, v0, v1; };
__device__ __forceinline__ void tile_load(Stg& s, const bf16_t* Kg, const bf16_t* Vg, unsigned loff) {
    const char* kb = (const char*)Kg; const char* vb = (const char*)Vg;
    s.k0 = *(const bf16x8*)(kb + loff); s.k1 = *(const bf16x8*)(kb + loff + 8192u);
    s.v0 = *(const bf16x8*)(vb + loff); s.v1 = *(const bf16x8*)(vb + loff + 8192u);
}
__device__ __forceinline__ void tile_write(const Stg& s, LAS char* lds, int buf, int sr, int sc, int vst0, int vst1) {
    *(LAS bf16x8*)(lds + L_V + buf * SHM_T + vst0) = s.v0; *(LAS bf16x8*)(lds + L_V + buf * SHM_T + vst1) = s.v1;
    *(LAS bf16x8*)(lds + L_K + buf * SHM_T + KSWZ(sr, sc * 2)) = s.k0; *(LAS bf16x8*)(lds + L_K + buf * SHM_T + KSWZ(32 + sr, sc * 2)) = s.k1;
}
__device__ __forceinline__ void tile_dma(const bf16_t* Kg, const bf16_t* Vg, LAS char* lds, int buf, int w, unsigned dk0, unsigned dv0, unsigned dv1) {
    LAS char* kd = lds + L_K + buf * SHM_T + w * 1024; LAS char* vd = lds + L_V + buf * SHM_T + w * 1024;
    __builtin_amdgcn_global_load_lds((const unsigned*)((const char*)Kg + dk0), (LAS unsigned*)kd, 16, 0, 0);
    __builtin_amdgcn_global_load_lds((const unsigned*)((const char*)Kg + dk0 + 8192u), (LAS unsigned*)(kd + 8192), 16, 0, 0);
    __builtin_amdgcn_global_load_lds((const unsigned*)((const char*)Vg + dv0), (LAS unsigned*)vd, 16, 0, 0);
    __builtin_amdgcn_global_load_lds((const unsigned*)((const char*)Vg + dv1), (LAS unsigned*)(vd + 8192), 16, 0, 0);
}
__device__ __forceinline__ unsigned grp8_max(unsigned v) {
    v = max(v, (unsigned)__builtin_amdgcn_mov_dpp((int)v, 0xB1, 0xf, 0xf, true));
    v = max(v, (unsigned)__builtin_amdgcn_mov_dpp((int)v, 0x4E, 0xf, 0xf, true));
    v = max(v, (unsigned)__builtin_amdgcn_mov_dpp((int)v, 0x141, 0xf, 0xf, true));
    return v;
}
enum { BR_CMP1 = 0, BR_CMP2 = 1, BR_SEL = 2, BR_WIN = 3 };
}


struct NsaLane { int lane, w, r32, hi, tl, vb0; unsigned dk0, dv0, dv1; };
__device__ __forceinline__ NsaLane nsa_lane(int tid_in, LAS char* lds) {
    using namespace nsa;
    int tid = tid_in; asm volatile("" : "+v"(tid));
    NsaLane L; L.lane = tid & 63; L.w = __builtin_amdgcn_readfirstlane(tid >> 6); L.r32 = L.lane & 31; L.hi = L.lane >> 5; L.tl = 8 * L.w + (L.r32 >> 2);
    { const int r = L.w * 4 + (L.lane >> 4), x = L.lane & 15; L.dk0 = (unsigned)(r * 256 + ((x ^ (r & 7)) << 4));
#pragma unroll
      for (int i = 0; i < 2; ++i) { const int P = i * 512 + L.w * 64 + L.lane, blk = P >> 5, kk = (blk >> 2) * 8 + ((P & 31) >> 2), c = (blk & 3) * 32 + (P & 3) * 8;
          const int k = (kk & ~0xC) | ((kk & 4) << 1) | ((kk & 8) >> 1); const unsigned d = (unsigned)(k * 256 + c * 2); if (i == 0) L.dv0 = d; else L.dv1 = d; } }
    L.vb0 = (int)(uintptr_t)(lds + L_V) + v_rd_base(L.lane);
    return L;
}
__device__ __forceinline__ float nsa_load_q(bf16x8 (&qr)[8], const bf16_t* slots, int g, size_t mrow, int r32, int hi, LAS float* scr, int lane) {
    const bf16_t* qp = slots + ((size_t)(g * 4 + (r32 & 3)) * T + mrow) * 128 + hi * 8;
#pragma unroll
    for (int d0 = 0; d0 < 8; ++d0) qr[d0] = *(const bf16x8*)(qp + d0 * 16);
    float ss = 0.f;
#pragma unroll
    for (int d0 = 0; d0 < 8; ++d0) {
#pragma unroll
        for (int e = 0; e < 8; ++e) { const float x = bf2f((unsigned short)qr[d0][e]); ss += x * x; } }
    ss = half_swap_sum(ss, scr, lane);
    return sqrtf(ss) * nsa::CLOG;
}
__device__ __forceinline__ float nsa_kbound(const float* k_norm_br, int lane) {
    const float a = fmaxf(fabsf(k_norm_br[lane]), fabsf(k_norm_br[64 + lane]));
    return __builtin_bit_cast(float, __builtin_amdgcn_readfirstlane(__builtin_bit_cast(int, wave_max(a)))) * 11.54f;
}

__device__ __forceinline__ void ph_attn_mfma(Frame& F, const bf16_t* slots, const float* gp, const float* gbias, const float* k_norm, const bf16_t* kcmp, const bf16_t* vcmp, bf16_t* O) {
    using namespace nsa;
    LAS char* lds = (LAS char*)F.lds;
    const int vcu = (F.G % 8 == 0) ? (F.bx % 8) * (F.G / 8) + F.bx / 8 : F.bx;
    const int NU = BATCH * 4 * (SEQ / 64);
    for (int ui = 0; ui < (NU + F.G - 1) / F.G; ++ui) {
        if (ui * F.G + vcu >= NU) break;
        int bg, qb;
        if (F.G == 256) { const int v = vcu & 31; bg = vcu >> 5; qb = ui == 0 ? v : ui == 1 ? 63 - v : ui == 2 ? 64 + v : 127 - v; }
        else { const int u = ui * F.G + vcu; bg = u >> 7; qb = u & 127; }
        const int b = bg >> 2, g = bg & 3, q0 = qb * 64;

#define TILE_LOOP(BR, Kg, Vg, kt0, kt1) do { \
        int buf = 0; \
        __syncthreads(); \
        tile_dma((Kg) + (size_t)(kt0) * 64 * 128, (Vg) + (size_t)(kt0) * 64 * 128, lds, 0, L.w, L.dk0, L.dv0, L.dv1); \
        asm volatile("s_waitcnt vmcnt(0)" ::: "memory"); __syncthreads(); \
        for (int kt = (kt0); kt <= (kt1); ++kt) { \
            if (kt < (kt1)) tile_dma((Kg) + (size_t)(kt + 1) * 64 * 128, (Vg) + (size_t)(kt + 1) * 64 * 128, lds, buf ^ 1, L.w, L.dk0, L.dv0, L.dv1);        \
            float bias = -qn * kb; int klo = 0, khi = 63; bool rng = false, wave_on = true; \
            if (BR == BR_CMP1 || BR == BR_CMP2) { khi = nmax_t - 64 * kt; rng = (64 * kt + 63 > 4 * qb - 2); } \
            else if (BR == BR_SEL) { const unsigned wsel = selw[(L.r32 >> 2) * 4 + (kt >> 5)]; const bool on = ((wsel >> (kt & 31)) & 1u) != 0u; bias = on ? bias : -INFINITY; if (kt == qb) { khi = L.tl; rng = true; } \
                wave_on = __builtin_amdgcn_ballot_w64(on) != 0ull; }        \
            else { if (kt == qb) { khi = L.tl; rng = true; } else if (kt == qb - 8) { klo = L.tl + 1; rng = true; } } \
            { \
            const LAS char* Kt_ = lds + L_K + buf * SHM_T; const int vb = L.vb0 + buf * SHM_T; \
            f32x16 p0 = f32x16{}, p1 = f32x16{}; \
            qk_half(p0, Kt_, qr, L.r32, L.hi); qk_half(p1, Kt_, qr, 32 + L.r32, L.hi); \
            float ps = rng ? exp_half<true>(p0, bias, klo, khi, L.hi, 0) : exp_half<false>(p0, bias, klo, khi, L.hi, 0); \
            if (BR == BR_CMP1) { ps += rng ? exp_half<true>(p1, bias, klo, khi, L.hi, 32) : exp_half<false>(p1, bias, klo, khi, L.hi, 32); lsum += ps; } \
            else { \
                bf16x8 pa0, pa1, pa2, pa3; \
                if (BR == BR_CMP2) { _Pragma("unroll") for (int r = 0; r < 16; ++r) p0[r] *= inv_lc; } \
                pack_half(p0, pa0, pa1); \
                if (wave_on) pv_half<0>(o, vb, pa0, pa1); \
                ps += rng ? exp_half<true>(p1, bias, klo, khi, L.hi, 32) : exp_half<false>(p1, bias, klo, khi, L.hi, 32); \
                if (BR == BR_CMP2) { _Pragma("unroll") for (int r = 0; r < 16; ++r) p1[r] *= inv_lc; } else lsum += ps; \
                pack_half(p1, pa2, pa3); \
                if (wave_on) pv_half<1>(o, vb, pa2, pa3); \
                if (BR == BR_CMP2) { \
                      \
                    f32x16 d2 = f32x16{}; \
                    int r32o = L.r32, hio = L.hi; asm volatile("" : "+v"(r32o), "+v"(hio)); \
                    _Pragma("unroll") for (int s = 0; s < 4; ++s) { const int c = r32o - 4 * s; bf16x8 cv; \
                        _Pragma("unroll") for (int jj = 0; jj < 8; ++jj) { const int k = 8 * hio + jj; cv[jj] = (c >= 0 && c <= 4 && k >= 4 * c - 1 && k <= 4 * c + 3) ? (short)0x3F80 : (short)0; } \
                        d2 = __builtin_amdgcn_mfma_f32_32x32x16_bf16(s == 0 ? pa0 : s == 1 ? pa1 : s == 2 ? pa2 : pa3, cv, d2, 0, 0, 0); } \
                    if (L.r32 <= 16) { \
                        _Pragma("unroll") for (int q4 = 0; q4 < 4; ++q4) { const float sum = (d2[4 * q4] + d2[4 * q4 + 1]) + (d2[4 * q4 + 2] + d2[4 * q4 + 3]); \
                            LAS float* ip = imp + (2 * q4 + L.hi) * IMP_LD + 16 * kt + L.r32; *ip = *ip + sum; } } \
                    asm volatile("s_waitcnt lgkmcnt(0)" ::: "memory"); \
                } \
            } \
            } \
            asm volatile("s_waitcnt vmcnt(0)" ::: "memory"); \
            __syncthreads(); buf ^= 1; \
        } } while (0)
#define ROW_FACTORS(f) do { if (L.hi == 0) scr[L.r32] = (f); asm volatile("s_waitcnt lgkmcnt(0)" ::: "memory"); } while (0)

        {
            const NsaLane L = nsa_lane(F.tid, lds);
            LAS float* imp = (LAS float*)(lds + L_WREG + L.w * WREG); LAS bf16_t* park = (LAS bf16_t*)imp; LAS float* scr = (LAS float*)(lds + L_SCR) + L.w * 64; LAS unsigned* selw = nullptr; (void)selw;
            const int t = q0 + L.tl; const size_t mrow = (size_t)b * SEQ + t;
            bf16x8 qr[8]; const float qn = nsa_load_q(qr, slots, g, mrow, L.r32, L.hi, scr, L.lane);
            const float kb = nsa_kbound(k_norm, L.lane);
            for (int i = L.lane; i < 8 * IMP_LD; i += 64) imp[i] = 0.f;
            const bf16_t* Kc = kcmp + (size_t)(g * 1024 + b * 512) * 128; const bf16_t* Vc = vcmp + (size_t)(g * 1024 + b * 512) * 128;
            const int nmax_t = t >= 31 ? (t - 31) >> 4 : -1;
            const int nct = ((4 * qb + 2) >> 6) + 1;
            float lsum = 0.f, inv_lc = 0.f;
            { f32x16 o[4]; (void)o; TILE_LOOP(BR_CMP1, Kc, Vc, 0, nct - 1); }
            lsum = half_swap_sum(lsum, scr, L.lane); inv_lc = lsum > 0.f ? 1.0f / lsum : 0.f;
            f32x16 o[4];
#pragma unroll
            for (int d = 0; d < 4; ++d) o[d] = f32x16{};
            TILE_LOOP(BR_CMP2, Kc, Vc, 0, nct - 1);
            unsigned key[16];
            { const int tok = L.lane >> 3, sub = L.lane & 7;
#pragma unroll
              for (int e4 = 0; e4 < 4; ++e4) { const f32x4 vv = *(const LAS f32x4*)(imp + tok * IMP_LD + 16 * sub + 4 * e4);
#pragma unroll
                  for (int e = 0; e < 4; ++e) { const int s = 16 * sub + 4 * e4 + e; const bool forced = (s == 0) || (s == qb) || (s == qb - 1);
                      const float f = vv[e];
                      key[4 * e4 + e] = (s <= qb && !forced) ? ((__builtin_bit_cast(unsigned, f) & 0xFFFFFF80u) | (unsigned)(127 - s)) : 0u; } }
              asm volatile("s_waitcnt lgkmcnt(0)" ::: "memory"); }
            { const int hd = g * 4 + (L.r32 & 3); const float g0 = sigmoidf_(gp[mrow * 48 + hd * 3 + 0] + gbias[hd * 3 + 0]);
              ROW_FACTORS(g0);
#pragma unroll
              for (int r = 0; r < 16; ++r) { const int row = crow(r, L.hi); const float fr = scr[row];
#pragma unroll
                  for (int h2 = 0; h2 < 2; ++h2) ((LAS unsigned*)park)[row * 64 + h2 * 32 + L.r32] = pk2(o[2 * h2][r] * fr, o[2 * h2 + 1][r] * fr); }
              asm volatile("s_waitcnt lgkmcnt(0)" ::: "memory"); }
            { LAS unsigned* sw = (LAS unsigned*)(lds + L_SELW) + L.w * 32; const int tok = L.lane >> 3, sub = L.lane & 7;
              unsigned m0 = 0u, m1 = 0u, m2 = 0u, m3 = 0u;
              { const int fs[3] = {0, qb, qb > 0 ? qb - 1 : 0};
#pragma unroll
                for (int i = 0; i < 3; ++i) { const unsigned s = (unsigned)fs[i], bit = 1u << (s & 31u); m0 |= (s >> 5) == 0u ? bit : 0u; m1 |= (s >> 5) == 1u ? bit : 0u; m2 |= (s >> 5) == 2u ? bit : 0u; m3 |= (s >> 5) == 3u ? bit : 0u; } }
              const int npick = 16 - (qb >= 2 ? 3 : qb + 1);
              for (int k = 0; k < npick; ++k) {
                  unsigned mx = key[0];
#pragma unroll
                  for (int e = 1; e < 16; ++e) mx = max(mx, key[e]);
                  mx = grp8_max(mx);
                  if (mx != 0u) { const unsigned s = 127u - (mx & 127u); const unsigned bit = 1u << (s & 31u);
                      m0 |= (s >> 5) == 0u ? bit : 0u; m1 |= (s >> 5) == 1u ? bit : 0u; m2 |= (s >> 5) == 2u ? bit : 0u; m3 |= (s >> 5) == 3u ? bit : 0u; }
#pragma unroll
                  for (int e = 0; e < 16; ++e) key[e] = key[e] == mx ? 0u : key[e];
              }
              if (sub == 0) { sw[tok * 4 + 0] = m0; sw[tok * 4 + 1] = m1; sw[tok * 4 + 2] = m2; sw[tok * 4 + 3] = m3; }
              asm volatile("s_waitcnt lgkmcnt(0)" ::: "memory"); }
        }
        {
            const NsaLane L = nsa_lane(F.tid, lds);
            LAS float* imp = nullptr; (void)imp; LAS bf16_t* park = (LAS bf16_t*)(lds + L_WREG + L.w * WREG); LAS float* scr = (LAS float*)(lds + L_SCR) + L.w * 64; LAS unsigned* selw = (LAS unsigned*)(lds + L_SELW) + L.w * 32;
            const int t = q0 + L.tl; const size_t mrow = (size_t)b * SEQ + t;
            bf16x8 qr[8]; const float qn = nsa_load_q(qr, slots, g, mrow, L.r32, L.hi, scr, L.lane);
            const float kb = nsa_kbound(k_norm + 128, L.lane);
            const bf16_t* Ks = slots + ((size_t)(24 + g) * T + (size_t)b * SEQ) * 128; const bf16_t* Vs = slots + ((size_t)(28 + g) * T + (size_t)b * SEQ) * 128;
            const int nmax_t = 0; (void)nmax_t; float lsum = 0.f; const float inv_lc = 0.f; (void)inv_lc;
            f32x16 o[4];
#pragma unroll
            for (int d = 0; d < 4; ++d) o[d] = f32x16{};
            TILE_LOOP(BR_SEL, Ks, Vs, 0, qb);
            lsum = half_swap_sum(lsum, scr, L.lane);
            { const int hd = g * 4 + (L.r32 & 3); const float g1 = sigmoidf_(gp[mrow * 48 + hd * 3 + 1] + gbias[hd * 3 + 1]);
              ROW_FACTORS(lsum > 0.f ? g1 / lsum : 0.f);
#pragma unroll
              for (int r = 0; r < 16; ++r) { const int row = crow(r, L.hi); const float fr = scr[row];
#pragma unroll
                  for (int h2 = 0; h2 < 2; ++h2) { LAS unsigned* pw = (LAS unsigned*)park + row * 64 + h2 * 32 + L.r32; const unsigned w = *pw; *pw = pk2(bflo(w) + o[2 * h2][r] * fr, bfhi(w) + o[2 * h2 + 1][r] * fr); } }
              asm volatile("s_waitcnt lgkmcnt(0)" ::: "memory"); }
        }
        {
            const NsaLane L = nsa_lane(F.tid, lds);
            LAS float* imp = nullptr; (void)imp; LAS bf16_t* park = (LAS bf16_t*)(lds + L_WREG + L.w * WREG); LAS float* scr = (LAS float*)(lds + L_SCR) + L.w * 64; LAS unsigned* selw = nullptr; (void)selw;
            const int t = q0 + L.tl; const size_t mrow = (size_t)b * SEQ + t;
            bf16x8 qr[8]; const float qn = nsa_load_q(qr, slots, g, mrow, L.r32, L.hi, scr, L.lane);
            const float kb = nsa_kbound(k_norm + 256, L.lane);
            const bf16_t* Kw = slots + ((size_t)(32 + g) * T + (size_t)b * SEQ) * 128; const bf16_t* Vw = slots + ((size_t)(36 + g) * T + (size_t)b * SEQ) * 128;
            const int nmax_t = 0; (void)nmax_t; float lsum = 0.f; const float inv_lc = 0.f; (void)inv_lc;
            f32x16 o[4];
#pragma unroll
            for (int d = 0; d < 4; ++d) o[d] = f32x16{};
            TILE_LOOP(BR_WIN, Kw, Vw, (qb - 8 < 0 ? 0 : qb - 8), qb);
            lsum = half_swap_sum(lsum, scr, L.lane);
            { const int hd = g * 4 + (L.r32 & 3); const float g2 = sigmoidf_(gp[mrow * 48 + hd * 3 + 2] + gbias[hd * 3 + 2]);
              ROW_FACTORS(lsum > 0.f ? g2 / lsum : 0.f);
              char* Ow = (char*)(O + ((size_t)b * SEQ + q0 + 8 * L.w) * 2048 + g * 512);
#pragma unroll
              for (int r = 0; r < 16; ++r) { const int row = crow(r, L.hi); const float fr = scr[row];
#pragma unroll
                  for (int h2 = 0; h2 < 2; ++h2) { const unsigned w = ((LAS unsigned*)park)[row * 64 + h2 * 32 + L.r32];
                      *(bf16_t*)(Ow + (unsigned)(((row >> 2) * 2048 + (row & 3) * 128 + (2 * h2) * 32 + L.r32) * 2)) = (bf16_t)f2bf(bflo(w) + o[2 * h2][r] * fr);
                      *(bf16_t*)(Ow + (unsigned)(((row >> 2) * 2048 + (row & 3) * 128 + (2 * h2 + 1) * 32 + L.r32) * 2)) = (bf16_t)f2bf(bfhi(w) + o[2 * h2 + 1][r] * fr); } }
              asm volatile("s_waitcnt lgkmcnt(0)" ::: "memory"); }
        }
#undef TILE_LOOP
#undef ROW_FACTORS
    }
}

#ifndef MK_MULTI_LAUNCH
#define MK_MULTI_LAUNCH 0
#endif
constexpr int NPS = 8, NSLOTS_PH = 1 + 12 * NPS;
__global__ void __launch_bounds__(NTHREADS, 2) fwd_kernel(Args a) {
    extern __shared__ __attribute__((aligned(16))) unsigned char lds_raw[];
    volatile LAS unsigned* MISC = (volatile LAS unsigned*)((LAS unsigned char*)lds_raw + MISC_OFF);
    if (threadIdx.x < 32) MISC[threadIdx.x] = 0u;
    const int g_wave = __builtin_amdgcn_readfirstlane((int)(threadIdx.x >> 6));
    __syncthreads();
    const int lo = a.ph_lo, hi = a.ph_hi;
    const bool use_bar = (hi - lo) > 1;
    XcdBarrier bar; bar.bar = (unsigned*)(a.ws + WS_CTL) + CW_BAR; bar.x = 0; bar.st = MISC + 8; bar.wv = g_wave;
    if (use_bar) bar = xcd_barrier_post((unsigned*)(a.ws + WS_CTL) + CW_BAR, MISC + 8, g_wave);
#define IN(k) (lo <= (k) && (k) < hi)
#define SEAM(k) do { if (IN((k) + 1) && use_bar) xcd_barrier(bar); } while (0)
#define PH_ENTER() Frame F = make_frame(lds_raw, g_wave); CArgsP ap = get_args(); unsigned char* ws = ap->ws; float* h = ap->out; bf16_t* HN = (bf16_t*)(ws + WS_HN); bf16_t* ACT = (bf16_t*)(ws + WS_ACT); float* SSQ = (float*)(ws + WS_SSQP); LAS float* RED = (LAS float*)(F.lds + RED_OFF); (void)h; (void)HN; (void)ACT; LAS float* RSL = RED + 3072; (void)SSQ; (void)RED; (void)RSL

    if (IN(0)) { PH_ENTER(); ph_prologue(F, ap); }
    SEAM(0);

    for (int step = 0; step < 12; ++step) {
        const int layer = step / 3, sub = step - 3 * layer, base = 1 + NPS * step, jp = layer >> 1;
        if (sub != 1) {
            const int half = sub >> 1, f = layer * 2 + half;
            const int vin = 3 * layer + 2 * half;
            if (IN(base + 1)) { PH_ENTER(); Gemm g{HN, (const bf16_t*)(ws + WS_WGU + (size_t)f * GU_BYTES), T, 2 * FF, D, D, D, 0, 0}; StaticOrder S; S.init(T, 2 * FF, F.G, F.bx);
                pg8::Unit u0; const bool any = S.next(0, u0); const int pm0 = any ? u0.pm : 0; const float* sq = SSQ + (size_t)vin * T * 32; panel_rstd(F, sq, pm0, RSL);
                pg8::EpiSwiGLU E{ACT, FF, pg8::RowScale{RSL, pm0, sq}}; gemm_phase<pg8::EpiSwiGLU, StaticOrder>(F.lds, g, S, E, nullptr, F.tid); }
            SEAM(base + 1);
            if (IN(base + 2)) { PH_ENTER(); Gemm g{ACT, (const bf16_t*)(ws + WS_WD + (size_t)f * DN_BYTES), T, D, FF, FF, FF, 0, 0}; StaticOrder S; S.init(T, D, F.G, F.bx);
                pg8::EpiResid E{h, D, HN, SSQ + (size_t)(vin + 1) * T * 32, RED, step == 11}; gemm_phase<pg8::EpiResid, StaticOrder>(F.lds, g, S, E, nullptr, F.tid); }
            SEAM(base + 2);
        } else if ((layer & 1) == 0) {
#define AB_PTRS() bf16_t* P = ACT; unsigned char* mx = ws + WS_MIX; bf16_t* CB = (bf16_t*)(mx + MX_C); bf16_t* QK = (bf16_t*)(mx + MX_QK); bf16_t* CST = (bf16_t*)(mx + MX_CST); bf16_t* SST = (bf16_t*)(mx + MX_SST); float* GIF = (float*)(mx + MX_GIF); float* NST = (float*)(mx + MX_NST); float* SCL = (float*)(mx + MX_SCL); float* HDEC = (float*)(mx + MX_HDEC); bf16_t* Y = (bf16_t*)(mx + MX_Y); (void)P; (void)CB; (void)QK; (void)CST; (void)SST; (void)GIF; (void)NST; (void)SCL; (void)HDEC; (void)Y
            if (IN(base + 1)) { PH_ENTER(); AB_PTRS(); const float* ssq = SSQ + (size_t)(3 * layer + 1) * T * 32;
                { Gemm g{HN, (const bf16_t*)(ws + WS_WABIN + (size_t)jp * ABIN_BYTES), T, AB_N, D, D, D, 0, 0}; StaticOrder S; S.init(T, AB_N, F.G, F.bx);
                  pg8::Unit u0; const bool any = S.next(0, u0); const int pm0 = any ? u0.pm : 0; panel_rstd(F, ssq, pm0, RSL);
                  pg8::EpiPlainBf16 E{P, AB_N, pg8::RowScale{RSL, pm0, ssq}, true}; gemm_phase<pg8::EpiPlainBf16, StaticOrder>(F.lds, g, S, E, nullptr, F.tid); }
                ph_skinny<8>(F, HN, ssq, (const bf16_t*)(ws + WS_WSK) + (size_t)jp * 64 * D, GIF); }
            SEAM(base + 1);
            if (IN(base + 2)) { PH_ENTER(); AB_PTRS(); ph_conv(F, P, ap->in[12] + (size_t)jp * 4096, ap->in[13] + (size_t)jp * 1024, CB); }
            SEAM(base + 2);
            if (IN(base + 3)) { PH_ENTER(); AB_PTRS(); Gemm g{CB, (const bf16_t*)(ws + WS_WQK + (size_t)jp * WQK_BYTES), T, 2048, 256, 1024, 256, 3, 256}; StaticOrder S; S.init(T, 2048, F.G, F.bx);
                pg8::EpiPlainBf16 E{QK, 2048, pg8::RowScale{nullptr, -1, nullptr}, false}; gemm_phase<pg8::EpiPlainBf16, StaticOrder>(F.lds, g, S, E, nullptr, F.tid); }
            SEAM(base + 3);
            if (IN(base + 4)) { PH_ENTER(); AB_PTRS(); ph_chunk_r1(F, P, QK, GIF, ap->in[16] + jp * 4, ap->in[17] + jp * 4, ap->in[20], jp, CST, NST, SCL, SST, HDEC); }
            SEAM(base + 4);
            if (IN(base + 5)) { PH_ENTER(); AB_PTRS(); ph_chunk_r2(F, CST, NST, SCL, SST, HDEC); }
            SEAM(base + 5);
            if (IN(base + 6)) { PH_ENTER(); AB_PTRS(); ph_chunk_r3(F, P, QK, CB, GIF, ap->in[16] + jp * 4, ap->in[17] + jp * 4, ap->in[20], jp, CST, NST, SCL, SST, ap->in[18] + (size_t)jp * 1024, ap->in[19] + (size_t)jp * 1024, ap->in[21] + (size_t)jp * 1024, Y); }
            SEAM(base + 6);
            if (IN(base + 7)) { PH_ENTER(); AB_PTRS(); Gemm g{Y, (const bf16_t*)(ws + WS_WABOUT + (size_t)jp * SQ_BYTES), T, D, D, D, D, 0, 0}; StaticOrder S; S.init(T, D, F.G, F.bx);
                pg8::EpiResid E{h, D, HN, SSQ + (size_t)(3 * layer + 2) * T * 32, RED, false}; gemm_phase<pg8::EpiResid, StaticOrder>(F.lds, g, S, E, nullptr, F.tid); }
            SEAM(base + 7);
        } else {
#define C_PTRS() bf16_t* SL = ACT; unsigned char* mx = ws + WS_MIX; float* GP = (float*)(mx + MX_GP); bf16_t* HID = (bf16_t*)(mx + MX_HID); bf16_t* KC = (bf16_t*)(mx + MX_KCMP); bf16_t* VC = (bf16_t*)(mx + MX_VCMP); bf16_t* O = (bf16_t*)(mx + MX_O); const float* rope = (const float*)(ws + WS_ROPE); (void)SL; (void)GP; (void)HID; (void)KC; (void)VC; (void)O; (void)rope
            if (IN(base + 1)) { PH_ENTER(); C_PTRS(); const float* ssq = SSQ + (size_t)(3 * layer + 1) * T * 32;
                { Gemm g{HN, (const bf16_t*)(ws + WS_WCIN + (size_t)jp * CIN_BYTES), T, C_N, D, D, D, 0, 0}; StaticOrder S; S.init(T, C_N, F.G, F.bx);
                  pg8::Unit u0; const bool any = S.next(0, u0); const int pm0 = any ? u0.pm : 0; panel_rstd(F, ssq, pm0, RSL);
                  pg8::EpiSlots E{SL, T, pg8::RowScale{RSL, pm0, ssq}}; gemm_phase<pg8::EpiSlots, StaticOrder>(F.lds, g, S, E, nullptr, F.tid); }
                ph_skinny<48>(F, HN, ssq, (const bf16_t*)(ws + WS_WSK) + (size_t)(2 + jp) * 64 * D, GP); }
            SEAM(base + 1);
            if (IN(base + 2)) {
                { PH_ENTER(); C_PTRS(); const int kv = F.bx >= 16 ? 1 : 0;
                  const float* cbias = (const float*)(ws + WS_CB) + (size_t)jp * 512 + kv * 256;
                  Gemm g{SL + (size_t)(16 + 4 * kv) * T * 128, (const bf16_t*)(ws + WS_WCMP1 + (size_t)(jp * 2 + kv) * CMP1_BYTES), 4096, 256, 4096, 2048, 4096, 0, 0};
                  StaticOrder S; S.init(4096, 256, F.G, kv ? F.bx - 16 : F.bx);
                  pg8::EpiSiluBias E{HID + (size_t)kv * 4096 * 256, 256, cbias}; gemm_phase<pg8::EpiSiluBias, StaticOrder>(F.lds, g, S, E, nullptr, F.tid); }
                { PH_ENTER(); C_PTRS(); ph_qknorm_rope(F, SL, ap->in[24] + (size_t)jp * 128, ap->in[25] + (size_t)jp * 384, rope); } }
            SEAM(base + 2);
            if (IN(base + 3)) { PH_ENTER(); C_PTRS(); ph_compress2(F, HID, ap->in[29] + (size_t)jp * 2 * 256 * 128, ap->in[25] + (size_t)jp * 384, rope, KC, VC); }
            SEAM(base + 3);
            if (IN(base + 4)) { PH_ENTER(); C_PTRS(); ph_attn_mfma(F, SL, GP, ap->in[30] + (size_t)jp * 48, ap->in[25] + (size_t)jp * 384, KC, VC, O); }
            SEAM(base + 4);
            if (IN(base + 6)) { PH_ENTER(); C_PTRS(); Gemm g{O, (const bf16_t*)(ws + WS_WCOUT + (size_t)jp * SQ_BYTES), T, D, D, D, D, 0, 0}; StaticOrder S; S.init(T, D, F.G, F.bx);
                pg8::EpiResid E{h, D, HN, SSQ + (size_t)(3 * layer + 2) * T * 32, RED, false}; gemm_phase<pg8::EpiResid, StaticOrder>(F.lds, g, S, E, nullptr, F.tid); }
            SEAM(base + 6);
        }
    }
#undef IN
#undef SEAM
}

extern "C" void kernel_launch(void* const* d_in, const int* in_sizes, int n_in, void* d_out, int out_size, void* d_ws, size_t ws_size, hipStream_t stream) {
    static int grid = 0;
    if (grid == 0) {
        if (n_in != 31 || in_sizes[0] != T * D || out_size != T * D || ws_size < WS_END) { fprintf(stderr, "kernel_launch: unexpected problem shape (n_in %d, in0 %d, out %d, ws %zu < %zu)\n", n_in, n_in > 0 ? in_sizes[0] : -1, out_size, ws_size, (size_t)WS_END); grid = -1; return; }
        int dev = 0, cus = 0, per_cu = 0;
        if (hipGetDevice(&dev) != hipSuccess || hipDeviceGetAttribute(&cus, hipDeviceAttributeMultiprocessorCount, dev) != hipSuccess) { grid = -1; return; }
        if (hipFuncSetAttribute((const void*)fwd_kernel, hipFuncAttributeMaxDynamicSharedMemorySize, LDS_BYTES) != hipSuccess) { fprintf(stderr, "kernel_launch: hipFuncSetAttribute failed\n"); grid = -1; return; }
        if (hipOccupancyMaxActiveBlocksPerMultiprocessor(&per_cu, (const void*)fwd_kernel, NTHREADS, LDS_BYTES) != hipSuccess || per_cu < 1) { fprintf(stderr, "kernel_launch: occupancy query reports %d workgroups per CU\n", per_cu); }
        (void)hipGetLastError();
        grid = cus;
    }
    if (grid < 0) return;
    if (hipMemsetAsync((char*)d_ws + WS_CTL, 0, CTL_ZERO_BYTES, stream) != hipSuccess) return;
    Args a{};
    for (int i = 0; i < 31; ++i) a.in[i] = (const float*)d_in[i];
    a.out = (float*)d_out; a.ws = (unsigned char*)d_ws;
#if MK_MULTI_LAUNCH
    for (int p = 0; p < NSLOTS_PH; ++p) {
        if (p > 0) { const int step = (p - 1) / NPS, q = (p - 1) % NPS, sub = step % 3, layer = step / 3;
            if (q == 0) continue; if (sub != 1 && q > 2) continue; if (sub == 1 && (layer & 1) == 1 && (q == 5 || q == 7)) continue; }
        a.ph_lo = p; a.ph_hi = p + 1;
        hipLaunchKernelGGL(fwd_kernel, dim3(grid), dim3(NTHREADS), LDS_BYTES, stream, a);
    }
#else
    a.ph_lo = 0; a.ph_hi = NSLOTS_PH;
    hipLaunchKernelGGL(fwd_kernel, dim3(grid), dim3(NTHREADS), LDS_BYTES, stream, a);
#endif
}
```
